# Optimizing an MI355X kernel written in HIP

```python
import math
import jax, jax.numpy as jnp
from jax import lax
import numpy as np

D_MODEL = 1024
BATCH = 4
SEQ = 4096
DEPTH = 2
DEC_BATCH = 32
DEC_SEQ = 4
PAST_LEN = 8192
PAGE_SIZE = 128

N_MIXERS = 2
N_NSA = (DEPTH + 1) // 2
N_ML = DEPTH // 2
NSA_HEADS = 16
NSA_KV_HEADS = 4
NSA_HPG = NSA_HEADS // NSA_KV_HEADS
HEAD_DIM = D_MODEL // NSA_HEADS
CMP_LEN = 32
CMP_STRIDE = 16
CMP_HID = HEAD_DIM
SEL_BLK = 64
SEL_TOPK = 16
WINDOW = 512
Q_BLK = 128
FORCE_BONUS = 1e4
NSA_Q_W = NSA_HEADS * HEAD_DIM
NSA_KV_W = NSA_KV_HEADS * HEAD_DIM
NSA_IN = NSA_Q_W + 6 * NSA_KV_W + 3 * NSA_HEADS
ML_HEADS = 8
ML_DQK = D_MODEL // (2 * ML_HEADS)
ML_DV = D_MODEL // ML_HEADS
ML_CHUNK = 64
ML_QK_W = ML_HEADS * ML_DQK
ML_V_W = ML_HEADS * ML_DV
ML_IN = 2 * ML_QK_W + 2 * ML_V_W + 2 * ML_HEADS
D_FF = 4 * D_MODEL
CONV_W = 3
RMS_EPS = 1e-6
MASK_NEG = -1e30

kernel_name = "nsa_mlstm_hybrid_decode_step"


def rmsnorm(x, g):
    xf = x.astype(jnp.float32)
    y = xf * lax.rsqrt(jnp.mean(xf * xf, axis=-1, keepdims=True) + RMS_EPS)
    return (y * g.astype(jnp.float32)).astype(x.dtype)


def masked_softmax(s, mask):
    s = jnp.where(mask, s.astype(jnp.float32), MASK_NEG)
    e = jnp.exp(s - jnp.max(s, axis=-1, keepdims=True)) * mask
    return e / jnp.maximum(jnp.sum(e, axis=-1, keepdims=True), 1e-30)


def alibi_slopes():
    h = jnp.arange(1, NSA_HEADS + 1, dtype=jnp.float32)
    return jnp.exp2(-8.0 * h / NSA_HEADS).reshape(NSA_KV_HEADS, NSA_HPG)


def nsa_project(h, w_in):
    B, T, _ = h.shape
    p = jnp.einsum('btd,de->bte', h, w_in)
    q = p[..., :NSA_Q_W].reshape(B, T, NSA_KV_HEADS, NSA_HPG, HEAD_DIM)
    kv = p[..., NSA_Q_W:NSA_Q_W + 6 * NSA_KV_W].reshape(B, T, 6, NSA_KV_HEADS, HEAD_DIM)
    gates = p[..., NSA_Q_W + 6 * NSA_KV_W:].reshape(B, T, NSA_KV_HEADS, NSA_HPG, 3)
    return q, kv, gates


def nsa_context(kv, w_cmp1, w_cmp2, cmp_pos):
    B, T = kv.shape[:2]
    ratio = CMP_LEN // CMP_STRIDE
    n_chunk = T // CMP_STRIDE
    nc = n_chunk - ratio + 1
    ch = kv[:, :n_chunk * CMP_STRIDE, :2].reshape(B, n_chunk, CMP_STRIDE, 2, NSA_KV_HEADS, HEAD_DIM)
    pre = None
    for r in range(ratio):
        sl = slice(r * CMP_STRIDE, (r + 1) * CMP_STRIDE)
        part = jnp.einsum('bjlcgd,cldh->bjcgh', ch + cmp_pos[None, None, sl, :, None, :], w_cmp1[:, sl])
        part = part[:, r:r + nc]
        pre = part if pre is None else pre + part
    kvc = jnp.einsum('bjcgh,chd->bjcgd', jax.nn.gelu(pre, approximate=True), w_cmp2)
    kc, vc = kvc[:, :, 0], kvc[:, :, 1]
    c_start = jnp.arange(nc) * CMP_STRIDE
    c_end = c_start + CMP_LEN - 1
    n_sel = -(-T // SEL_BLK)
    sel = jnp.pad(kv[:, :, 2:4], ((0, 0), (0, n_sel * SEL_BLK - T), (0, 0), (0, 0), (0, 0)))
    sel = sel.reshape(B, n_sel, SEL_BLK, 2, NSA_KV_HEADS, HEAD_DIM).transpose(3, 0, 4, 1, 2, 5)
    ks, vs = sel[0], sel[1]
    s_start = jnp.arange(n_sel) * SEL_BLK
    ov = ((c_start[:, None] < s_start[None, :] + SEL_BLK) &
          (c_start[:, None] + CMP_LEN > s_start[None, :])).astype(jnp.float32)
    return kc, vc, c_end, ks, vs, ov


def nsa_core(q, gates, tq, kc, vc, c_end, ks, vs, ov, kw, vw, sw, slopes):
    B, Tq = q.shape[:2]
    scale = HEAD_DIM ** -0.5
    sl5 = slopes[None, :, :, None, None]
    dist_c = tq[:, None] - c_end[None, :]
    sc = jnp.einsum('btghd,bjgd->bghtj', q, kc).astype(jnp.float32) * scale - sl5 * dist_c.astype(jnp.float32)
    pc = masked_softmax(sc, dist_c >= 0)
    oc = jnp.einsum('bghtj,bjgd->btghd', pc.astype(vc.dtype), vc)
    imp = jnp.einsum('bghtj,jn->bgtn', pc, ov)
    n_sel = ks.shape[2]
    bid = jnp.arange(n_sel)
    cur = tq // SEL_BLK
    valid = bid[None, :] * SEL_BLK <= tq[:, None]
    forced = (bid[None, :] == 0) | (bid[None, :] == cur[:, None]) | (bid[None, :] == cur[:, None] - 1)
    score = jnp.where(valid, imp + jnp.where(forced, FORCE_BONUS, 0.0), MASK_NEG)
    k_eff = min(SEL_TOPK, n_sel)
    _, idx = lax.top_k(score, k_eff)
    bi = jnp.arange(B)[:, None, None, None]
    gi = jnp.arange(NSA_KV_HEADS)[None, :, None, None]
    kg = ks[bi, gi, idx].reshape(B, NSA_KV_HEADS, Tq, k_eff * SEL_BLK, HEAD_DIM)
    vg = vs[bi, gi, idx].reshape(B, NSA_KV_HEADS, Tq, k_eff * SEL_BLK, HEAD_DIM)
    s_pos = (idx[..., None] * SEL_BLK + jnp.arange(SEL_BLK)).reshape(B, NSA_KV_HEADS, Tq, k_eff * SEL_BLK)
    dist_s = (tq[None, None, :, None] - s_pos)[:, :, None]
    ss = jnp.einsum('btghd,bgtnd->bghtn', q, kg).astype(jnp.float32) * scale - sl5 * dist_s.astype(jnp.float32)
    ps = masked_softmax(ss, dist_s >= 0)
    osel = jnp.einsum('bghtn,bgtnd->btghd', ps.astype(vg.dtype), vg)
    dist_w = tq[:, None] - sw[None, :]
    swin = jnp.einsum('btghd,bsgd->bghts', q, kw).astype(jnp.float32) * scale - sl5 * dist_w.astype(jnp.float32)
    pw = masked_softmax(swin, (dist_w >= 0) & (dist_w < WINDOW) & (sw[None, :] >= 0))
    ow = jnp.einsum('bghts,bsgd->btghd', pw.astype(vw.dtype), vw)
    g = jax.nn.sigmoid(gates.astype(jnp.float32))
    return g[..., 0:1] * oc + g[..., 1:2] * osel + g[..., 2:3] * ow


def nsa_prompt(h, w_in, w_out, w_cmp1, w_cmp2, cmp_pos, slopes):
    B, T, _ = h.shape
    q, kv, gates = nsa_project(h, w_in)
    kc, vc, c_end, ks, vs, ov = nsa_context(kv[:, :, :4], w_cmp1, w_cmp2, cmp_pos)
    win = kv[:, :, 4:]
    winp = jnp.pad(win, ((0, 0), (WINDOW, 0), (0, 0), (0, 0), (0, 0)))
    qb_len = math.gcd(T, Q_BLK)

    def body(n):
        s0 = n * qb_len
        qb = lax.dynamic_slice_in_dim(q, s0, qb_len, axis=1)
        gb = lax.dynamic_slice_in_dim(gates, s0, qb_len, axis=1)
        wb = lax.dynamic_slice_in_dim(winp, s0, WINDOW + qb_len, axis=1)
        tq = s0 + jnp.arange(qb_len)
        sw = s0 - WINDOW + jnp.arange(WINDOW + qb_len)
        return nsa_core(qb, gb, tq, kc, vc, c_end, ks, vs, ov, wb[:, :, 0], wb[:, :, 1], sw, slopes)

    o = lax.map(body, jnp.arange(T // qb_len))
    o = o.transpose(1, 0, 2, 3, 4, 5).reshape(B, T, NSA_Q_W).astype(h.dtype)
    w_keep = min(WINDOW, T)
    return o @ w_out, kv[:, :, :4], win[:, T - w_keep:]


def nsa_sample(h, cache_kv, page_table, win_buf, w_in, w_out, w_cmp1, w_cmp2, cmp_pos, slopes):
    B, T, _ = h.shape
    q, kv, gates = nsa_project(h, w_in)
    n_pages = page_table.shape[1]
    past_len = n_pages * PAGE_SIZE
    past = cache_kv[page_table].reshape(B, past_len, 4, NSA_KV_HEADS, HEAD_DIM)
    full = jnp.concatenate([past.astype(kv.dtype), kv[:, :, :4]], axis=1)
    kc, vc, c_end, ks, vs, ov = nsa_context(full, w_cmp1, w_cmp2, cmp_pos)
    wfull = jnp.concatenate([win_buf.astype(kv.dtype), kv[:, :, 4:]], axis=1)
    wb_len = win_buf.shape[1]
    sw = past_len - wb_len + jnp.arange(wb_len + T)
    tq = past_len + jnp.arange(T)
    o = nsa_core(q, gates, tq, kc, vc, c_end, ks, vs, ov, wfull[:, :, 0], wfull[:, :, 1], sw, slopes)
    o = o.reshape(B, T, NSA_Q_W).astype(h.dtype)
    return o @ w_out, kv[:, :, :4], wfull[:, T:]


def mlstm_mixer(h, C0, n0, m0, w_in, b_gate, head_norm, w_out):
    B, T, _ = h.shape
    p = jnp.einsum('btd,de->bte', h, w_in)
    f32 = jnp.float32
    q = p[..., :ML_QK_W].reshape(B, T, ML_HEADS, ML_DQK).transpose(0, 2, 1, 3).astype(f32)
    k = p[..., ML_QK_W:2 * ML_QK_W].reshape(B, T, ML_HEADS, ML_DQK).transpose(0, 2, 1, 3).astype(f32) * ML_DQK ** -0.5
    v = p[..., 2 * ML_QK_W:2 * ML_QK_W + ML_V_W].reshape(B, T, ML_HEADS, ML_DV).transpose(0, 2, 1, 3).astype(f32)
    o = p[..., 2 * ML_QK_W + ML_V_W:2 * ML_QK_W + 2 * ML_V_W]
    gp = p[..., 2 * ML_QK_W + 2 * ML_V_W:].reshape(B, T, 2, ML_HEADS).astype(f32) + b_gate.astype(f32)
    ig = gp[:, :, 0].transpose(0, 2, 1)
    logf = jax.nn.log_sigmoid(gp[:, :, 1]).transpose(0, 2, 1)
    L = math.gcd(T, ML_CHUNK)
    nc = T // L

    def chunks(a):
        return jnp.moveaxis(a.reshape(B, ML_HEADS, nc, L, *a.shape[3:]), 2, 0)

    causal = jnp.tril(jnp.ones((L, L), dtype=bool))

    def step(carry, xs):
        C, n, m = carry
        qc, kc, vc, ic, fc = xs
        b = jnp.cumsum(fc, axis=-1)
        D = jnp.where(causal, b[..., :, None] - b[..., None, :] + ic[..., None, :], -jnp.inf)
        inter = b + m[..., None]
        mt = jnp.maximum(inter, jnp.max(D, axis=-1))
        S = jnp.einsum('bhtd,bhsd->bhts', qc, kc) * jnp.exp(D - mt[..., None])
        wi = jnp.exp(inter - mt)
        num = wi[..., None] * jnp.einsum('bhvd,bhtd->bhtv', C, qc) + jnp.einsum('bhts,bhsv->bhtv', S, vc)
        den = wi * jnp.einsum('bhd,bhtd->bht', n, qc) + jnp.sum(S, axis=-1)
        hc = num / jnp.maximum(jnp.abs(den), jnp.exp(-mt))[..., None]
        mL = mt[..., -1]
        decay = jnp.exp(b[..., -1] + m - mL)
        ws = jnp.exp(b[..., -1:] - b + ic - mL[..., None])
        C = decay[..., None, None] * C + jnp.einsum('bhs,bhsv,bhsd->bhvd', ws, vc, kc)
        n = decay[..., None] * n + jnp.einsum('bhs,bhsd->bhd', ws, kc)
        return (C, n, mL), hc

    (C, n, m), hs = lax.scan(step, (C0.astype(f32), n0.astype(f32), m0.astype(f32)),
                             (chunks(q), chunks(k), chunks(v), chunks(ig), chunks(logf)))
    hseq = jnp.moveaxis(hs, 0, 2).reshape(B, ML_HEADS, T, ML_DV).transpose(0, 2, 1, 3)
    hseq = hseq * lax.rsqrt(jnp.mean(hseq * hseq, axis=-1, keepdims=True) + RMS_EPS)
    hseq = hseq.reshape(B, T, ML_V_W) * head_norm.astype(f32) * jax.nn.sigmoid(o.astype(f32))
    return hseq.astype(h.dtype) @ w_out, C, n, m


def conv_ffn(h, buf, w_up, conv_w, conv_b, w_down):
    T = h.shape[1]
    u = h @ w_up
    full = jnp.concatenate([buf.astype(u.dtype), u], axis=1)
    c = conv_b + sum(conv_w[j] * full[:, j:j + T] for j in range(CONV_W))
    y = jax.nn.gelu(c[..., :D_FF], approximate=True) * c[..., D_FF:]
    return y @ w_down, full[:, T:]


def setup_inputs(seed: int = 0) -> dict:
    key = jax.random.key(seed)
    ks = jax.random.split(key, 24)
    n_pages = PAST_LEN // PAGE_SIZE
    n_used = DEC_BATCH * n_pages
    n_phys = n_used + max(1, n_used // 4)
    win_buf = min(WINDOW, PAST_LEN)

    def nrm(k, shape, s=1.0):
        return s * jax.random.normal(k, shape, jnp.float32)

    page_table = jax.random.permutation(ks[8], n_phys)[:n_used].reshape(DEC_BATCH, n_pages).astype(jnp.int32)
    b_gate = jnp.stack([nrm(ks[16], (N_ML, ML_HEADS), 0.1), 3.0 + nrm(ks[17], (N_ML, ML_HEADS), 0.5)], axis=1)
    return {
        "x_prompt": nrm(ks[0], (BATCH, SEQ, D_MODEL)),
        "x_sample": nrm(ks[1], (DEC_BATCH, DEC_SEQ, D_MODEL)),
        "cache_nsa_kv": nrm(ks[2], (N_NSA, n_phys, PAGE_SIZE, 4, NSA_KV_HEADS, HEAD_DIM)),
        "cache_nsa_win": nrm(ks[3], (N_NSA, DEC_BATCH, win_buf, 2, NSA_KV_HEADS, HEAD_DIM)),
        "state_mlstm_C": nrm(ks[4], (N_ML, DEC_BATCH, ML_HEADS, ML_DV, ML_DQK), 0.3),
        "state_mlstm_n": jnp.abs(nrm(ks[5], (N_ML, DEC_BATCH, ML_HEADS, ML_DQK), 0.5)),
        "state_mlstm_m": nrm(ks[6], (N_ML, DEC_BATCH, ML_HEADS)),
        "state_ffn_conv": nrm(ks[7], (DEPTH, DEC_BATCH, CONV_W - 1, 2 * D_FF)),
        "page_table": page_table,
        "norm_g": 1.0 + nrm(ks[9], (DEPTH, 4, D_MODEL), 0.1),
        "w_nsa_in": nrm(ks[10], (N_NSA, D_MODEL, NSA_IN), D_MODEL ** -0.5),
        "w_nsa_out": nrm(ks[11], (N_NSA, NSA_Q_W, D_MODEL), NSA_Q_W ** -0.5),
        "w_cmp1": nrm(ks[12], (N_NSA, 2, CMP_LEN, HEAD_DIM, CMP_HID), (CMP_LEN * HEAD_DIM) ** -0.5),
        "w_cmp2": nrm(ks[13], (N_NSA, 2, CMP_HID, HEAD_DIM), CMP_HID ** -0.5),
        "cmp_pos": nrm(ks[14], (N_NSA, CMP_LEN, 2, HEAD_DIM), 0.5),
        "w_ml_in": nrm(ks[15], (N_ML, D_MODEL, ML_IN), D_MODEL ** -0.5),
        "b_ml_gate": b_gate,
        "ml_head_norm": 1.0 + nrm(ks[18], (N_ML, ML_V_W), 0.1),
        "w_ml_out": nrm(ks[19], (N_ML, ML_V_W, D_MODEL), ML_V_W ** -0.5),
        "w_ffn_up": nrm(ks[20], (DEPTH, D_MODEL, 2 * D_FF), D_MODEL ** -0.5),
        "ffn_conv_w": nrm(ks[21], (DEPTH, CONV_W, 2 * D_FF), CONV_W ** -0.5),
        "ffn_conv_b": nrm(ks[22], (DEPTH, 2 * D_FF), 0.02),
        "w_ffn_down": nrm(ks[23], (DEPTH, D_FF, D_MODEL), D_FF ** -0.5),
    }


def reference(x_prompt, x_sample, cache_nsa_kv, cache_nsa_win, state_mlstm_C, state_mlstm_n, state_mlstm_m,
              state_ffn_conv, page_table, norm_g, w_nsa_in, w_nsa_out, w_cmp1, w_cmp2, cmp_pos, w_ml_in,
              b_ml_gate, ml_head_norm, w_ml_out, w_ffn_up, ffn_conv_w, ffn_conv_b, w_ffn_down):
    slopes = alibi_slopes()
    xp, xs = x_prompt, x_sample
    kv_p, kv_s, win_p, win_s = [], [], [], []
    C_p, C_s, n_p, n_s, m_p, m_s = [], [], [], [], [], []
    cv_p, cv_s = [], []
    for i in range(DEPTH):
        j = i // N_MIXERS
        hp = rmsnorm(xp, norm_g[i, 0])
        hs = rmsnorm(xs, norm_g[i, 0])
        if i % N_MIXERS == 0:
            yp, a, b = nsa_prompt(hp, w_nsa_in[j], w_nsa_out[j], w_cmp1[j], w_cmp2[j], cmp_pos[j], slopes)
            kv_p.append(a); win_p.append(b)
            ys, a, b = nsa_sample(hs, cache_nsa_kv[j], page_table, cache_nsa_win[j], w_nsa_in[j], w_nsa_out[j],
                                  w_cmp1[j], w_cmp2[j], cmp_pos[j], slopes)
            kv_s.append(a); win_s.append(b)
        else:
            Bp = hp.shape[0]
            zC = jnp.zeros((Bp, ML_HEADS, ML_DV, ML_DQK), jnp.float32)
            zn = jnp.zeros((Bp, ML_HEADS, ML_DQK), jnp.float32)
            zm = jnp.zeros((Bp, ML_HEADS), jnp.float32)
            yp, c, n, m = mlstm_mixer(hp, zC, zn, zm, w_ml_in[j], b_ml_gate[j], ml_head_norm[j], w_ml_out[j])
            C_p.append(c); n_p.append(n); m_p.append(m)
            ys, c, n, m = mlstm_mixer(hs, state_mlstm_C[j], state_mlstm_n[j], state_mlstm_m[j], w_ml_in[j],
                                      b_ml_gate[j], ml_head_norm[j], w_ml_out[j])
            C_s.append(c); n_s.append(n); m_s.append(m)
        xp = xp + rmsnorm(yp, norm_g[i, 1])
        xs = xs + rmsnorm(ys, norm_g[i, 1])
        zbuf = jnp.zeros((xp.shape[0], CONV_W - 1, 2 * D_FF), xp.dtype)
        fp, bp = conv_ffn(rmsnorm(xp, norm_g[i, 2]), zbuf, w_ffn_up[i], ffn_conv_w[i], ffn_conv_b[i], w_ffn_down[i])
        fs, bs = conv_ffn(rmsnorm(xs, norm_g[i, 2]), state_ffn_conv[i], w_ffn_up[i], ffn_conv_w[i], ffn_conv_b[i],
                          w_ffn_down[i])
        cv_p.append(bp); cv_s.append(bs)
        xp = xp + rmsnorm(fp, norm_g[i, 3])
        xs = xs + rmsnorm(fs, norm_g[i, 3])
    return (xp, xs, jnp.stack(kv_p), jnp.stack(kv_s), jnp.stack(win_p), jnp.stack(win_s),
            jnp.stack(C_p), jnp.stack(C_s), jnp.stack(n_p), jnp.stack(n_s), jnp.stack(m_p), jnp.stack(m_s),
            jnp.stack(cv_p), jnp.stack(cv_s))
```

```cpp
#ifndef EMU
#include <hip/hip_runtime.h>
#endif
#include <cstdio>
#include <cstdint>
#ifdef EMU
#define LAS
#define GAS
#define ASMV(...) ((void)0)
#else
#define LAS __attribute__((address_space(3)))
#define GAS __attribute__((address_space(1)))
#define ASMV(...) asm volatile(__VA_ARGS__)
#endif

#ifdef EMU_CFG_SMALL
constexpr int BATCH = 1, SEQ = 512, DEC_BATCH = 2, PAST_LEN = 512, SEL_TOPK = 4, WINDOW = 128, D_FF = 512;
#else
constexpr int BATCH = 4, SEQ = 4096, DEC_BATCH = 32, PAST_LEN = 8192, SEL_TOPK = 16, WINDOW = 512, D_FF = 4096;
#endif
constexpr int DEC_SEQ = 4, PAGE_SIZE = 128, D = 1024, FF2 = 2 * D_FF;
constexpr int MPR = BATCH * SEQ, MSA = DEC_BATCH * DEC_SEQ, MT = MPR + MSA, MPAD = (MT + 255) / 256 * 256;
constexpr int NSA_IN = 2608, NSA_IN_PAD = 2816, ML_IN = 3088, ML_IN_PAD = 3328;
constexpr int N_PAGES = PAST_LEN / PAGE_SIZE, N_USED = DEC_BATCH * N_PAGES, N_PHYS = N_USED + (N_USED / 4 > 1 ? N_USED / 4 : 1);
constexpr int WB_LEN = WINDOW < PAST_LEN ? WINDOW : PAST_LEN, WKEEP = WINDOW < SEQ ? WINDOW : SEQ;
constexpr int NCH_P = SEQ / 16, NC_P = NCH_P - 1, TS = PAST_LEN + DEC_SEQ, NCH_S = TS / 16, NC_S = NCH_S - 1;
constexpr int NSEL_P = SEQ / 64, NSEL_S = (TS + 63) / 64;
constexpr float RMS_EPS = 1e-6f;
constexpr float QSCALE = 0.125f * 1.4426950408889634f;
static_assert(PAST_LEN % 64 == 0 && SEQ % 64 == 0 && DEC_SEQ == 4, "shape assumptions");

constexpr size_t O_Y = 0, O_KV = O_Y + (size_t)MT * D, O_WINP = O_KV + (size_t)MT * D, O_WINS = O_WINP + (size_t)BATCH * WKEEP * 512,
    O_CP = O_WINS + (size_t)DEC_BATCH * WB_LEN * 512, O_CS = O_CP + (size_t)BATCH * 8 * 128 * 64, O_NP = O_CS + (size_t)DEC_BATCH * 8 * 128 * 64,
    O_NS = O_NP + (size_t)BATCH * 8 * 64, O_MP = O_NS + (size_t)DEC_BATCH * 8 * 64, O_MS = O_MP + (size_t)BATCH * 8, O_CVP = O_MS + (size_t)DEC_BATCH * 8,
    O_CVS = O_CVP + (size_t)2 * BATCH * 2 * FF2, O_END = O_CVS + (size_t)2 * DEC_BATCH * 2 * FF2;

constexpr size_t al4k(size_t x) { return (x + 4095) & ~(size_t)4095; }
constexpr size_t WS_CTL = 0, CTL_ZERO_BYTES = 1u << 20;
constexpr size_t WS_WNSAIN = CTL_ZERO_BYTES;
constexpr size_t WS_WNSAOUT = WS_WNSAIN + al4k((size_t)NSA_IN_PAD * D * 2);
constexpr size_t WS_WMLIN = WS_WNSAOUT + al4k((size_t)D * D * 2);
constexpr size_t WS_WMLOUT = WS_WMLIN + al4k((size_t)ML_IN_PAD * D * 2);
constexpr size_t WS_WUP = WS_WMLOUT + al4k((size_t)D * D * 2);
constexpr size_t WS_WDOWN = WS_WUP + al4k((size_t)2 * FF2 * D * 2);
constexpr size_t WS_H = WS_WDOWN + al4k((size_t)2 * D * D_FF * 2);
constexpr size_t WS_Q = WS_H + al4k((size_t)MPAD * D * 2);
constexpr size_t WS_KVB = WS_Q + al4k((size_t)MPAD * D * 2);
constexpr size_t WS_WINB = WS_KVB + al4k((size_t)MPAD * D * 2);
constexpr size_t WS_GATES = WS_WINB + al4k((size_t)MPAD * 512 * 2);
constexpr size_t WS_AO = WS_GATES + al4k((size_t)MPAD * 48 * 4);
constexpr size_t WS_Y = WS_AO + al4k((size_t)MPAD * D * 2);
constexpr size_t WS_U = WS_Y + al4k((size_t)MPAD * D * 4);
constexpr size_t WS_ACT = WS_U + al4k((size_t)MPAD * FF2 * 2);
constexpr size_t WS_KC = WS_ACT + al4k((size_t)MPAD * D_FF * 2);
constexpr size_t KC_P_ELEMS = (size_t)BATCH * 4 * 256 * 64 * (NC_P + 255) / 256 * 1;
constexpr size_t WS_MQ = WS_KC + al4k((size_t)64 << 20);
constexpr size_t WS_MK = WS_MQ + al4k((size_t)MPAD * 512 * 2);
constexpr size_t WS_MV = WS_MK + al4k((size_t)MPAD * 512 * 2);
constexpr size_t WS_MO = WS_MV + al4k((size_t)MPAD * D * 2);
constexpr size_t WS_MG = WS_MO + al4k((size_t)MPAD * D * 2);
constexpr size_t WS_MISC = WS_MG + al4k((size_t)MPAD * 16 * 4);
constexpr size_t WS_END = WS_MISC + ((size_t)512 << 20);
constexpr int CW_TMO = 0, CW_BAR = 4096;
namespace pg8 {
typedef unsigned short bf16_t;
typedef short bf16x8 __attribute__((ext_vector_type(8)));
typedef float f32x4 __attribute__((ext_vector_type(4)));
typedef unsigned u32x4 __attribute__((ext_vector_type(4)));
constexpr int BM = 256, BK = 64, HALF = 128, HTB = HALF * BK * 2  , STAGE_BYTES = 8 * HTB, NXCD = 8, WGM = 8;

__host__ __device__ __forceinline__ int lds_byte(int r, int c) { const int st = (r >> 4) * 2 + (c >> 5), rr = r & 15, cc = c & 31, ob = rr * 64 + cc * 2; return st * 1024 + (ob ^ (((ob >> 9) & 1) << 5)); }
__host__ __device__ __forceinline__ void stage_rc(int b, int& R, int& C) { const int st = b / 1024, sb = b % 1024, swz = sb ^ (((sb >> 9) & 1) << 5); R = (st >> 1) * 16 + swz / 64; C = (st & 1) * 32 + (swz % 64) / 2; }
__host__ __device__ __forceinline__ int perm32(int rho) { const int n = rho >> 4, i = rho & 15; return 8 * (i >> 2) + 4 * n + (i & 3); }

struct Unit { int pm, pn; };
struct Gemm { const bf16_t* A; const bf16_t* Bt; int M, N, K; };

struct StaticOrder {
    int nM, nN, nwg, G, c;
    __host__ __device__ void init(int M, int N, int G_, int c_) { nM = M / BM; nN = N / BM; nwg = nM * nN; G = G_; c = c_; }
    __host__ __device__ bool next(int i, Unit& u) const {
        const long L = (long)i * G + c; if (L >= nwg) return false;
        int wgid = (int)L; { const int q = nwg / NXCD, r = nwg % NXCD, xcd = wgid % NXCD, off = wgid / NXCD; wgid = (xcd < r ? xcd * (q + 1) : r * (q + 1) + (xcd - r) * q) + off; }
        const int nig = WGM * nN, gid = wgid / nig, fm = gid * WGM, gsz = (nM - fm) < WGM ? (nM - fm) : WGM;
        u.pm = fm + ((wgid % nig) % gsz); u.pn = (wgid % nig) / gsz; return true;
    }
    __device__ __forceinline__ void a_ready(const Unit&) const {}
    __device__ __forceinline__ void done(const Unit&) const {}
};

#ifdef EMU
__device__ __forceinline__ unsigned cvt_pk_bf16(float lo, float hi) { unsigned a = __builtin_bit_cast(unsigned, lo), b = __builtin_bit_cast(unsigned, hi);
    a = (a + 0x7fffu + ((a >> 16) & 1u)) >> 16; b = (b + 0x7fffu + ((b >> 16) & 1u)) >> 16; return a | (b << 16); }
#else
__device__ __forceinline__ unsigned cvt_pk_bf16(float lo, float hi) { unsigned r; asm volatile("v_cvt_pk_bf16_f32 %0, %1, %2" : "=v"(r) : "v"(lo), "v"(hi)); return r; }
#endif
template <class Epi, class Sched, bool ALIGN_EPI = false, bool SP2 = false>
__device__ __forceinline__ void gemm_phase(LAS unsigned char* lds, const Gemm g, const Sched& S, const Epi& E) {
    int tid_ = threadIdx.x; ASMV("" : "+v"(tid_));
    const int tid = tid_, wid = __builtin_amdgcn_readfirstlane(tid >> 6), lane = tid & 63, wr = wid >> 2, wc = wid & 3, fr = lane & 15, fq = lane >> 4;
    const int K = g.K, nt = K / BK;
    unsigned voffA[2], voffB[2];
#pragma unroll
    for (int i = 0; i < 2; ++i) { int R, C; stage_rc(tid * 16 + i * 8192, R, C); const int Rb = Epi::PERM ? ((R & ~31) + perm32(R & 31)) : R;
        voffA[i] = (unsigned)(R * K + C) * 2u; voffB[i] = (unsigned)(Rb * K + C) * 2u; }
    const size_t kstep = (size_t)(BK * 2);
    const size_t hstep = (size_t)HALF * K * 2;
    const size_t tstep = 2 * hstep;
    const unsigned ldsw = (unsigned)wid * 1024u;
    const int aoff = lds_byte(wr * 64 + fr, fq * 8), boff = lds_byte(wc * 32 + fr, fq * 8);
#define PG8_SA(b, h) (((b) * 2 + (h)) * HTB)
#define PG8_SB(b, h) ((4 + (b) * 2 + (h)) * HTB)
#define PG8_STAGE(bufoff, gbase, voff) do { _Pragma("unroll") for (int _i = 0; _i < 2; ++_i) \
        __builtin_amdgcn_global_load_lds((const unsigned*)((const char*)(gbase) + (voff)[_i]), (LAS unsigned*)(lds + (bufoff) + ldsw + _i * 8192), 16, 0, 0); } while (0)
#define PG8_LDA(dst, b, h) do { _Pragma("unroll") for (int m = 0; m < 4; ++m) _Pragma("unroll") for (int k = 0; k < 2; ++k) dst[m][k] = *(const LAS bf16x8*)(lds + PG8_SA(b, h) + aoff + m * 2048 + k * 1024); } while (0)
#define PG8_LDB(dst, b, h) do { _Pragma("unroll") for (int n = 0; n < 2; ++n) _Pragma("unroll") for (int k = 0; k < 2; ++k) dst[n][k] = *(const LAS bf16x8*)(lds + PG8_SB(b, h) + boff + n * 2048 + k * 1024); } while (0)
#define PG8_MMA(ai, bj, At, Bt) do { __builtin_amdgcn_s_setprio(1); _Pragma("unroll") for (int m = 0; m < 4; ++m) _Pragma("unroll") for (int n = 0; n < 2; ++n) _Pragma("unroll") for (int k = 0; k < 2; ++k) \
        acc[ai][bj][m][n] = __builtin_amdgcn_mfma_f32_16x16x32_bf16(Bt[n][k], At[m][k], acc[ai][bj][m][n], 0, 0, 0); __builtin_amdgcn_s_setprio(0); } while (0)
#define PG8_WAIT_V(n) ASMV("s_waitcnt vmcnt(" #n ")" ::: "memory")
#define PG8_WAIT_L(n) ASMV("s_waitcnt lgkmcnt(" #n ")" ::: "memory")
#define PG8_BAR __builtin_amdgcn_s_barrier()
#define PG8_SCHED __builtin_amdgcn_sched_barrier(0)
    Unit cur, nxt; int ui = 0;
    if (!S.next(0, cur)) return;
    f32x4 acc[2][2][4][2];
#pragma unroll
    for (int a = 0; a < 2; ++a)
#pragma unroll
        for (int b = 0; b < 2; ++b)
#pragma unroll
            for (int m = 0; m < 4; ++m)
#pragma unroll
                for (int n = 0; n < 2; ++n) acc[a][b][m][n] = (f32x4){0.f, 0.f, 0.f, 0.f};
    bf16x8 At[4][2], B0[2][2], B1[2][2];
    const char* cA = (const char*)g.A + (size_t)cur.pm * tstep; const char* cB = (const char*)g.Bt + (size_t)cur.pn * tstep;
    S.a_ready(cur);
    if constexpr (SP2) {
        PG8_STAGE(PG8_SB(0, 0), cB, voffB); PG8_STAGE(PG8_SB(0, 1), cB + hstep, voffB); PG8_STAGE(PG8_SA(0, 0), cA, voffA); PG8_STAGE(PG8_SA(0, 1), cA + hstep, voffA);
        if (wr == 1) PG8_BAR;
        PG8_WAIT_V(2); PG8_BAR;
        PG8_STAGE(PG8_SB(1, 0), cB + kstep, voffB); PG8_STAGE(PG8_SA(1, 0), cA + kstep, voffA); PG8_STAGE(PG8_SB(1, 1), cB + hstep + kstep, voffB);
        PG8_WAIT_V(6); PG8_BAR;
    } else {
        PG8_STAGE(PG8_SB(0, 0), cB, voffB); PG8_STAGE(PG8_SA(0, 0), cA, voffA); PG8_STAGE(PG8_SB(0, 1), cB + hstep, voffB); PG8_STAGE(PG8_SA(0, 1), cA + hstep, voffA);
        if (wr == 1) PG8_BAR;
        PG8_WAIT_V(4); PG8_BAR;
        PG8_STAGE(PG8_SB(1, 0), cB + kstep, voffB); PG8_STAGE(PG8_SA(1, 0), cA + kstep, voffA); PG8_STAGE(PG8_SB(1, 1), cB + hstep + kstep, voffB);
        PG8_WAIT_V(6); PG8_BAR;
    }
    for (;;) {
        const bool has_next = S.next(ui + 1, nxt);
        const char* nA = has_next ? (const char*)g.A + (size_t)nxt.pm * tstep : cA; const char* nB = has_next ? (const char*)g.Bt + (size_t)nxt.pn * tstep : cB;
        for (int t = 0; t < nt; t += 2) {
            const bool last = (t == nt - 2);
            const char* a1 = cA + (size_t)(t + 1) * kstep;
            const char* a2 = last ? nA : cA + (size_t)(t + 2) * kstep; const char* b2 = last ? nB : cB + (size_t)(t + 2) * kstep;
            const char* a3 = a2 + kstep; const char* b3 = b2 + kstep;
            if (last && has_next) S.a_ready(nxt);
            if constexpr (SP2) {
            PG8_LDB(B0, 0, 0); PG8_LDB(B1, 0, 1); PG8_SCHED; PG8_LDA(At, 0, 0); PG8_STAGE(PG8_SA(1, 1), a1 + hstep, voffA);
            PG8_WAIT_V(8); PG8_WAIT_L(0); PG8_BAR; PG8_MMA(0, 0, At, B0); PG8_MMA(0, 1, At, B1); PG8_BAR; PG8_SCHED;
            PG8_LDA(At, 0, 1); PG8_STAGE(PG8_SB(0, 0), b2, voffB); PG8_STAGE(PG8_SB(0, 1), b2 + hstep, voffB); PG8_STAGE(PG8_SA(0, 0), a2, voffA);
            PG8_WAIT_V(8); PG8_WAIT_L(0); PG8_BAR; PG8_MMA(1, 0, At, B0); PG8_MMA(1, 1, At, B1); PG8_BAR; PG8_SCHED;
            PG8_LDB(B0, 1, 0); PG8_LDB(B1, 1, 1); PG8_SCHED; PG8_LDA(At, 1, 0); PG8_STAGE(PG8_SA(0, 1), a2 + hstep, voffA);
            PG8_WAIT_V(8); PG8_WAIT_L(0); PG8_BAR; PG8_MMA(0, 0, At, B0); PG8_MMA(0, 1, At, B1); PG8_BAR; PG8_SCHED;
            PG8_LDA(At, 1, 1); PG8_STAGE(PG8_SB(1, 0), b3, voffB); PG8_STAGE(PG8_SB(1, 1), b3 + hstep, voffB); PG8_STAGE(PG8_SA(1, 0), a3, voffA);
            PG8_WAIT_V(8); PG8_WAIT_L(0); PG8_BAR; PG8_MMA(1, 0, At, B0); PG8_MMA(1, 1, At, B1); PG8_BAR; PG8_SCHED;
            } else {
            PG8_LDB(B0, 0, 0); PG8_SCHED; PG8_LDA(At, 0, 0); PG8_STAGE(PG8_SA(1, 1), a1 + hstep, voffA);
            PG8_WAIT_L(8); PG8_BAR; PG8_WAIT_L(0); PG8_MMA(0, 0, At, B0); PG8_BAR; PG8_SCHED;
            PG8_LDB(B1, 0, 1); PG8_STAGE(PG8_SB(0, 0), b2, voffB);
            PG8_BAR; PG8_WAIT_L(0); PG8_MMA(0, 1, At, B1); PG8_BAR;
            PG8_LDA(At, 0, 1); PG8_STAGE(PG8_SA(0, 0), a2, voffA);
            PG8_BAR; PG8_WAIT_L(0); PG8_MMA(1, 0, At, B0); PG8_BAR; PG8_SCHED;
            PG8_STAGE(PG8_SB(0, 1), b2 + hstep, voffB);
            PG8_WAIT_V(6); PG8_BAR; PG8_MMA(1, 1, At, B1); PG8_BAR;
            PG8_LDB(B0, 1, 0); PG8_SCHED; PG8_LDA(At, 1, 0); PG8_STAGE(PG8_SA(0, 1), a2 + hstep, voffA);
            PG8_WAIT_L(8); PG8_BAR; PG8_WAIT_L(0); PG8_MMA(0, 0, At, B0); PG8_BAR; PG8_SCHED;
            PG8_LDB(B1, 1, 1); PG8_STAGE(PG8_SB(1, 0), b3, voffB);
            PG8_BAR; PG8_WAIT_L(0); PG8_MMA(0, 1, At, B1); PG8_BAR;
            PG8_LDA(At, 1, 1); PG8_STAGE(PG8_SA(1, 0), a3, voffA);
            PG8_BAR; PG8_WAIT_L(0); PG8_MMA(1, 0, At, B0); PG8_BAR; PG8_SCHED;
            PG8_STAGE(PG8_SB(1, 1), b3 + hstep, voffB);
            PG8_WAIT_V(6); PG8_BAR; PG8_MMA(1, 1, At, B1); PG8_BAR;
            }
        }
        if constexpr (ALIGN_EPI) { if (wr == 0) PG8_BAR; }
        if constexpr (!Epi::AFTER_DRAIN) { E(acc, cur, wr, wc, fr, fq); S.done(cur); }
        if (!has_next) break;
#pragma unroll
        for (int a = 0; a < 2; ++a)
#pragma unroll
            for (int b = 0; b < 2; ++b)
#pragma unroll
                for (int m = 0; m < 4; ++m)
#pragma unroll
                    for (int n = 0; n < 2; ++n) acc[a][b][m][n] = (f32x4){0.f, 0.f, 0.f, 0.f};
        cur = nxt; cA = nA; cB = nB; ++ui;
        if constexpr (ALIGN_EPI) { if (wr == 1) PG8_BAR; }
    }
    PG8_WAIT_V(0);
    if constexpr (!ALIGN_EPI) { if (wr == 0) PG8_BAR; }
    PG8_BAR;
    if constexpr (Epi::AFTER_DRAIN) { E.fused(acc, cur, wr, wc, fr, fq, lds, wid, lane); S.done(cur); }
#undef PG8_SA
#undef PG8_SB
#undef PG8_STAGE
#undef PG8_LDA
#undef PG8_LDB
#undef PG8_MMA
#undef PG8_WAIT_V
#undef PG8_WAIT_L
#undef PG8_BAR
#undef PG8_SCHED
}
}
typedef unsigned short bf16;
typedef unsigned v4u __attribute__((ext_vector_type(4)));
typedef unsigned v2u __attribute__((ext_vector_type(2)));
typedef float f32x4 __attribute__((ext_vector_type(4)));
typedef float f32x2 __attribute__((ext_vector_type(2)));
typedef float f32x16 __attribute__((ext_vector_type(16)));
typedef short bf16x8 __attribute__((ext_vector_type(8)));
typedef GAS unsigned gu32;
#define RLX_AGENT __ATOMIC_RELAXED, __HIP_MEMORY_SCOPE_AGENT
#ifdef EMU
#define LDS_WAIT() emu_wave_sync()
#else
#define LDS_WAIT() ASMV("s_waitcnt lgkmcnt(0)" ::: "memory")
#endif
#define VM_WAIT() ASMV("s_waitcnt vmcnt(0)" ::: "memory")
using pg8::cvt_pk_bf16;
__device__ __forceinline__ float bf2f(unsigned short h) { return __builtin_bit_cast(float, (unsigned)h << 16); }
__device__ __forceinline__ float bflo(unsigned w) { return __builtin_bit_cast(float, w << 16); }
__device__ __forceinline__ float bfhi(unsigned w) { return __builtin_bit_cast(float, w & 0xffff0000u); }
__device__ __forceinline__ float wave_sum(float v) {
#pragma unroll
    for (int o = 1; o < 64; o <<= 1) v += __shfl_xor(v, o);
    return v;
}
__device__ __forceinline__ float wave_max(float v) {
#pragma unroll
    for (int o = 1; o < 64; o <<= 1) v = fmaxf(v, __shfl_xor(v, o));
    return v;
}
__device__ __forceinline__ float gelu_tanh(float x) {
    const float u = 0.7978845608028654f * (x + 0.044715f * x * x * x);
    return x / (1.0f + __builtin_amdgcn_exp2f(-2.0f * 1.4426950408889634f * u));
}
__device__ __forceinline__ float sigmoidf_(float x) { return 1.0f / (1.0f + __builtin_amdgcn_exp2f(-1.4426950408889634f * x)); }
#define XB_TMO      128
#define XB_XCNT(j)  (256  + 64 * (j))
#define XB_XSUB(j)  (1280 + 64 * (j))
#define XB_XGEN(j)  (2304 + 64 * (j))
#define XB_TOP      3328
#define XB_TOPGEN   3392
#define XCD_BAR_WORDS 3456
#define XB_SPIN_CAP (1u << 18)

__device__ __forceinline__ unsigned xb_ld(unsigned* p)              { return __hip_atomic_load(p, __ATOMIC_RELAXED, __HIP_MEMORY_SCOPE_AGENT); }
__device__ __forceinline__ unsigned xb_add(unsigned* p, unsigned v) { return __hip_atomic_fetch_add(p, v, __ATOMIC_RELAXED, __HIP_MEMORY_SCOPE_AGENT); }
__device__ __forceinline__ unsigned xb_xcc_id() { return (unsigned)__builtin_amdgcn_s_getreg((3 << 11) | 20) & 0xFu; }
#define XB_SPIN(cond, bar) do { unsigned _sp = 0; while (cond) { __builtin_amdgcn_s_sleep(1); \
    if ((++_sp & 255u) == 0u) { if (xb_ld(&(bar)[XB_TMO])) break; if (_sp > XB_SPIN_CAP) { atomicAdd(&(bar)[XB_TMO], 1u); break; } } } } while (0)

struct XcdBarrier {
    unsigned* bar; unsigned x;
    volatile LAS unsigned* st;
};

__device__ __forceinline__ XcdBarrier xcd_barrier_post(unsigned* bar, volatile LAS unsigned* st) {
    XcdBarrier b; b.bar = bar; b.x = xb_xcc_id(); b.st = st;
    if (threadIdx.x == 0) (void)xb_add(&bar[XB_XCNT(b.x)], 1u);
    return b;
}
__device__ __forceinline__ void xcd_barrier_complete(unsigned* bar, unsigned x, unsigned& nloc, unsigned& nx) {
    const unsigned G = gridDim.x * gridDim.y * gridDim.z;
    unsigned sum, cnt, mine, sp = 0u;
    for (;;) {
        sum = 0u; cnt = 0u; mine = 0u;
#pragma unroll
        for (unsigned j = 0; j < 16; ++j) { const unsigned c = xb_ld(&bar[XB_XCNT(j)]); sum += c; cnt += (c > 0u) ? 1u : 0u; mine = (j == x) ? c : mine; }
        if (sum == G) break;
        __builtin_amdgcn_s_sleep(1);
        if ((++sp & 255u) == 0u) { if (xb_ld(&bar[XB_TMO])) break; if (sp > XB_SPIN_CAP) { atomicAdd(&bar[XB_TMO], 1u); break; } }
    }
    nloc = mine > 0u ? mine : 1u; nx = cnt > 0u ? cnt : 1u;
}

__device__ __forceinline__ void xcd_barrier(const XcdBarrier& b) {
    ASMV("s_waitcnt vmcnt(0)" ::: "memory");
    __syncthreads();
    if (threadIdx.x == 0) {
        unsigned* bar = b.bar;
        __builtin_amdgcn_s_waitcnt(0);
        unsigned nloc = b.st[0], nx = b.st[1];
        if (nloc == 0u) { xcd_barrier_complete(bar, b.x, nloc, nx); b.st[0] = nloc; b.st[1] = nx; }
        const unsigned old = xb_add(&bar[XB_XSUB(b.x)], 1u);
        const unsigned gen = old / nloc;
        if (old + 1u == (gen + 1u) * nloc) {
            __builtin_amdgcn_fence(__ATOMIC_RELEASE, "agent");
            ASMV("s_waitcnt vmcnt(0)" ::: "memory");
            const unsigned og = xb_add(&bar[XB_TOP], 1u);
            const unsigned tg = og / nx;
            if (og + 1u == (tg + 1u) * nx) xb_add(&bar[XB_TOPGEN], 1u);
            else XB_SPIN(xb_ld(&bar[XB_TOPGEN]) == tg, bar);
            __builtin_amdgcn_fence(__ATOMIC_ACQUIRE, "agent");
            xb_add(&bar[XB_XGEN(b.x)], 1u);
            ASMV("s_waitcnt vmcnt(0)" ::: "memory");
        } else {
            XB_SPIN(xb_ld(&bar[XB_XGEN(b.x)]) == gen, bar);
            __builtin_amdgcn_fence(__ATOMIC_ACQUIRE, "agent");
            ASMV("s_waitcnt vmcnt(0)" ::: "memory");
        }
    }
    __syncthreads();
}
constexpr int NWAVES = 8, NTHREADS = 512;
constexpr int RING_OFF = 0, RING_BYTES = 147456;
constexpr int LDSCTL_OFF = RING_BYTES, MISC_OFF = LDSCTL_OFF + 320;
constexpr int LDS_BYTES = 149504;
static_assert(MISC_OFF + 128 <= LDS_BYTES, "LDS map");
struct Frame {
    LAS unsigned char* lds;
    volatile LAS unsigned* MISC;
    gu32* ctl;
    int tid, lane, wave, vcu, G;
    const float* const* in;
    float* out;
    unsigned char* ws;
};
template <class T> __device__ __forceinline__ T* wsp(const Frame& F, size_t off) { return (T*)(F.ws + off); }

__device__ __forceinline__ void st_bf16x8(bf16* p, const f32x4& a, const f32x4& b, float s) {
    v4u w; w.x = cvt_pk_bf16(a[0] * s, a[1] * s); w.y = cvt_pk_bf16(a[2] * s, a[3] * s); w.z = cvt_pk_bf16(b[0] * s, b[1] * s); w.w = cvt_pk_bf16(b[2] * s, b[3] * s);
    *(v4u*)p = w;
}
#define EPI_LOOP_BEGIN \
    _Pragma("unroll") for (int ai = 0; ai < 2; ++ai) _Pragma("unroll") for (int m = 0; m < 4; ++m) { const int row = u.pm * 256 + ai * 128 + wr * 64 + m * 16 + fr; if (row < MT) { \
    _Pragma("unroll") for (int bj = 0; bj < 2; ++bj) { const int col = u.pn * 256 + bj * 128 + wc * 32 + 8 * fq; const f32x4 v0 = acc[ai][bj][m][0], v1 = acc[ai][bj][m][1];
#define EPI_LOOP_END } } }

struct EpiNsaIn {
    static constexpr bool PERM = true, AFTER_DRAIN = false;
    bf16* Q; bf16* KVB; bf16* WINB; float* GATES; float* out;
    __device__ __forceinline__ void operator()(const f32x4 (&acc)[2][2][4][2], const pg8::Unit& u, int wr, int wc, int fr, int fq) const {
        EPI_LOOP_BEGIN
            if (u.pn < 4) { st_bf16x8(Q + (size_t)row * 1024 + col, v0, v1, QSCALE); }
            else if (u.pn < 8) { const int c = col - 1024; st_bf16x8(KVB + (size_t)row * 1024 + c, v0, v1, 1.f);
                float* o = out + O_KV + (size_t)row * 1024 + c; *(f32x4*)o = v0; *(f32x4*)(o + 4) = v1; }
            else if (u.pn < 10) { const int c = col - 2048; st_bf16x8(WINB + (size_t)row * 512 + c, v0, v1, 1.f);
                float* o = nullptr;
                if (row < MPR) { const int b = row / SEQ, t = row % SEQ; if (t >= SEQ - WKEEP) o = out + O_WINP + ((size_t)b * WKEEP + (t - (SEQ - WKEEP))) * 512 + c; }
                else { const int r = row - MPR, b = r / DEC_SEQ, t = r % DEC_SEQ; o = out + O_WINS + ((size_t)b * WB_LEN + (WB_LEN - DEC_SEQ + t)) * 512 + c; }
                if (o) { *(f32x4*)o = v0; *(f32x4*)(o + 4) = v1; } }
            else { const int c = col - 2560; if (c < 48) { float* o = GATES + (size_t)row * 48 + c; *(f32x4*)o = v0; *(f32x4*)(o + 4) = v1; } }
        EPI_LOOP_END
    }
};
struct EpiF32 {
    static constexpr bool PERM = true, AFTER_DRAIN = false;
    float* Y; int ldc;
    __device__ __forceinline__ void operator()(const f32x4 (&acc)[2][2][4][2], const pg8::Unit& u, int wr, int wc, int fr, int fq) const {
        EPI_LOOP_BEGIN
            float* o = Y + (size_t)row * ldc + col; *(f32x4*)o = v0; *(f32x4*)(o + 4) = v1;
        EPI_LOOP_END
    }
};
struct EpiUp {
    static constexpr bool PERM = true, AFTER_DRAIN = false;
    bf16* U; float* out; int layer;
    __device__ __forceinline__ void operator()(const f32x4 (&acc)[2][2][4][2], const pg8::Unit& u, int wr, int wc, int fr, int fq) const {
        EPI_LOOP_BEGIN
            st_bf16x8(U + (size_t)row * FF2 + col, v0, v1, 1.f);
            float* o = nullptr;
            if (row < MPR) { const int b = row / SEQ, t = row % SEQ; if (t >= SEQ - 2) o = out + O_CVP + (((size_t)layer * BATCH + b) * 2 + (t - (SEQ - 2))) * FF2 + col; }
            else { const int r = row - MPR, b = r / DEC_SEQ, t = r % DEC_SEQ; if (t >= DEC_SEQ - 2) o = out + O_CVS + (((size_t)layer * DEC_BATCH + b) * 2 + (t - (DEC_SEQ - 2))) * FF2 + col; }
            if (o) { *(f32x4*)o = v0; *(f32x4*)(o + 4) = v1; }
        EPI_LOOP_END
    }
};
struct EpiMlIn {
    static constexpr bool PERM = true, AFTER_DRAIN = false;
    bf16* MQ; bf16* MK; bf16* MV; bf16* MO; float* MG;
    __device__ __forceinline__ void operator()(const f32x4 (&acc)[2][2][4][2], const pg8::Unit& u, int wr, int wc, int fr, int fq) const {
        EPI_LOOP_BEGIN
            if (u.pn < 2) st_bf16x8(MQ + (size_t)row * 512 + col, v0, v1, 1.f);
            else if (u.pn < 4) st_bf16x8(MK + (size_t)row * 512 + (col - 512), v0, v1, 0.125f);
            else if (u.pn < 8) st_bf16x8(MV + (size_t)row * 1024 + (col - 1024), v0, v1, 1.f);
            else if (u.pn < 12) st_bf16x8(MO + (size_t)row * 1024 + (col - 2048), v0, v1, 1.f);
            else { const int c = col - 3072; if (c < 16) { float* o = MG + (size_t)row * 16 + c; *(f32x4*)o = v0; *(f32x4*)(o + 4) = v1; } }
        EPI_LOOP_END
    }
};

__device__ __forceinline__ void transpose_item(const float* W, int K, int N, int Npad, bf16* WT, LAS float* scr, int item, int lane) {
    const int nblk = Npad / 32, kb = item / nblk, nb = item % nblk, k0 = 64 * kb, n0 = 32 * nb;
    const int nn = n0 + (lane & 31);
#pragma unroll 8
    for (int i = 0; i < 32; ++i) { const int kk = 2 * i + (lane >> 5); scr[kk * 33 + (lane & 31)] = nn < N ? W[(size_t)(k0 + kk) * N + nn] : 0.f; }
    LDS_WAIT(); ASMV("" ::: "memory");
    const int c = lane & 7;
#pragma unroll
    for (int j = 0; j < 4; ++j) { const int n = (lane >> 3) + 8 * j; const LAS float* s = scr + (8 * c) * 33 + n;
        v4u o; o.x = cvt_pk_bf16(s[0 * 33], s[1 * 33]); o.y = cvt_pk_bf16(s[2 * 33], s[3 * 33]); o.z = cvt_pk_bf16(s[4 * 33], s[5 * 33]); o.w = cvt_pk_bf16(s[6 * 33], s[7 * 33]);
        *(v4u*)(WT + (size_t)(n0 + n) * K + k0 + 8 * c) = o; }
    LDS_WAIT(); ASMV("" ::: "memory");
}
__device__ __forceinline__ const float* x_in_row(const Frame& F, int m) { return m < MPR ? F.in[0] + (size_t)m * D : F.in[1] + (size_t)(m - MPR) * D; }
__device__ __forceinline__ void rms_row_to_bf16(const Frame& F, const float* xrow, const float* g, bf16* orow, float* xcopy) {
    const f32x4* xr = (const f32x4*)xrow + F.lane; const f32x4* gr = (const f32x4*)g + F.lane;
    f32x4 v[4]; float s = 0.f;
#pragma unroll
    for (int j = 0; j < 4; ++j) { v[j] = xr[64 * j]; s += (v[j].x * v[j].x + v[j].y * v[j].y) + (v[j].z * v[j].z + v[j].w * v[j].w); }
    const float rstd = 1.f / sqrtf(wave_sum(s) * (1.f / D) + RMS_EPS);
    v2u* o8 = (v2u*)orow + F.lane;
#pragma unroll
    for (int j = 0; j < 4; ++j) { const f32x4 gg = gr[64 * j]; if (xcopy) ((f32x4*)xcopy + F.lane)[64 * j] = v[j];
        v2u w; w.x = cvt_pk_bf16(v[j].x * rstd * gg.x, v[j].y * rstd * gg.y); w.y = cvt_pk_bf16(v[j].z * rstd * gg.z, v[j].w * rstd * gg.w); o8[64 * j] = w; }
}
__device__ __forceinline__ void p0_prologue(Frame& F) {
    LAS float* scr = (LAS float*)(F.lds + RING_OFF + F.wave * 16384);
    const int gw = F.vcu * NWAVES + F.wave, NGW = F.G * NWAVES;
    constexpr int I_NI = (D / 64) * (NSA_IN_PAD / 32), I_DD = (D / 64) * (D / 32), I_MI = (D / 64) * (ML_IN_PAD / 32), I_UP = (D / 64) * (FF2 / 32), I_DN = (D_FF / 64) * (D / 32);
    constexpr int NITEMS = I_NI + 2 * I_DD + I_MI + 2 * I_UP + 2 * I_DN;
    for (int it = gw; it < NITEMS; it += NGW) {
        int r = it;
        if (r < I_NI) { transpose_item(F.in[10], D, NSA_IN, NSA_IN_PAD, wsp<bf16>(F, WS_WNSAIN), scr, r, F.lane); continue; } r -= I_NI;
        if (r < I_DD) { transpose_item(F.in[11], D, D, D, wsp<bf16>(F, WS_WNSAOUT), scr, r, F.lane); continue; } r -= I_DD;
        if (r < I_MI) { transpose_item(F.in[15], D, ML_IN, ML_IN_PAD, wsp<bf16>(F, WS_WMLIN), scr, r, F.lane); continue; } r -= I_MI;
        if (r < I_DD) { transpose_item(F.in[18], D, D, D, wsp<bf16>(F, WS_WMLOUT), scr, r, F.lane); continue; } r -= I_DD;
        if (r < 2 * I_UP) { const int l = r / I_UP; transpose_item(F.in[19] + (size_t)l * D * FF2, D, FF2, FF2, wsp<bf16>(F, WS_WUP) + (size_t)l * FF2 * D, scr, r % I_UP, F.lane); continue; } r -= 2 * I_UP;
        { const int l = r / I_DN; transpose_item(F.in[22] + (size_t)l * D_FF * D, D_FF, D, D, wsp<bf16>(F, WS_WDOWN) + (size_t)l * D * D_FF, scr, r % I_DN, F.lane); }
    }
    for (int m = gw; m < MT; m += NGW) rms_row_to_bf16(F, x_in_row(F, m), F.in[9], wsp<bf16>(F, WS_H) + (size_t)m * D, F.out + O_Y + (size_t)m * D);
    { const size_t per_b = (size_t)(WB_LEN - DEC_SEQ) * 512 / 4, total = per_b * DEC_BATCH;
      for (size_t i = (size_t)blockIdx.x * NTHREADS + F.tid; i < total; i += (size_t)F.G * NTHREADS) { const size_t b = i / per_b, r = i % per_b;
          ((f32x4*)(F.out + O_WINS + b * WB_LEN * 512))[r] = ((const f32x4*)(F.in[3] + b * WB_LEN * 512 + DEC_SEQ * 512))[r]; } }
}
__device__ __forceinline__ void norm_phase(Frame& F, const float* Y, const float* ga, const float* gb, bf16* H) {
    const int gw = F.vcu * NWAVES + F.wave, NGW = F.G * NWAVES;
    for (int m = gw; m < MT; m += NGW) {
        const f32x4* yr = (const f32x4*)(Y + (size_t)m * D) + F.lane; f32x4* xr = (f32x4*)(F.out + O_Y + (size_t)m * D) + F.lane;
        f32x4 y[4], x[4]; float s = 0.f;
#pragma unroll
        for (int j = 0; j < 4; ++j) { y[j] = yr[64 * j]; x[j] = xr[64 * j]; s += (y[j].x * y[j].x + y[j].y * y[j].y) + (y[j].z * y[j].z + y[j].w * y[j].w); }
        const float r1 = 1.f / sqrtf(wave_sum(s) * (1.f / D) + RMS_EPS); float s2 = 0.f;
#pragma unroll
        for (int j = 0; j < 4; ++j) { const f32x4 g = ((const f32x4*)ga + F.lane)[64 * j]; x[j] = x[j] + y[j] * r1 * g; xr[64 * j] = x[j];
            s2 += (x[j].x * x[j].x + x[j].y * x[j].y) + (x[j].z * x[j].z + x[j].w * x[j].w); }
        if (gb) { const float r2 = 1.f / sqrtf(wave_sum(s2) * (1.f / D) + RMS_EPS); v2u* o8 = (v2u*)(H + (size_t)m * D) + F.lane;
#pragma unroll
            for (int j = 0; j < 4; ++j) { const f32x4 g = ((const f32x4*)gb + F.lane)[64 * j];
                v2u w; w.x = cvt_pk_bf16(x[j].x * r2 * g.x, x[j].y * r2 * g.y); w.y = cvt_pk_bf16(x[j].z * r2 * g.z, x[j].w * r2 * g.w); o8[64 * j] = w; } }
    }
}
__device__ __forceinline__ void conv_phase(Frame& F, int layer) {
    constexpr int CR = 64, NCB = D_FF / 512;
    constexpr int NCHP = SEQ / CR, UNITS_P = BATCH * NCHP * NCB, UNITS_S = DEC_BATCH * NCB;
    const bf16* U = wsp<bf16>(F, WS_U); bf16* ACT = wsp<bf16>(F, WS_ACT);
    const float* cw = F.in[20] + (size_t)layer * 3 * FF2; const float* cb = F.in[21] + (size_t)layer * FF2; const float* sbuf = F.in[7] + (size_t)layer * DEC_BATCH * 2 * FF2;
    const int gw = F.vcu * NWAVES + F.wave, NGW = F.G * NWAVES;
    for (int un = gw; un < UNITS_P + UNITS_S; un += NGW) {
        int row0, nrows, cbk; bool samp; int sb = 0, t0 = 0;
        if (un < UNITS_P) { samp = false; cbk = un % NCB; const int q = un / NCB, b = q / NCHP, ch = q % NCHP; t0 = ch * CR; row0 = b * SEQ + t0; nrows = CR; }
        else { samp = true; const int q = un - UNITS_P; cbk = q % NCB; sb = q / NCB; row0 = MPR + sb * DEC_SEQ; nrows = DEC_SEQ; }
        const int j0 = cbk * 512 + F.lane * 8;
        float w[3][2][8], bb[2][8], p2[2][8], p1[2][8];
#pragma unroll
        for (int h = 0; h < 2; ++h) { const int c0 = j0 + h * D_FF;
#pragma unroll
            for (int e = 0; e < 8; ++e) { bb[h][e] = cb[c0 + e]; w[0][h][e] = cw[c0 + e]; w[1][h][e] = cw[FF2 + c0 + e]; w[2][h][e] = cw[2 * FF2 + c0 + e]; }
            if (samp) {
#pragma unroll
                for (int e = 0; e < 8; ++e) { p2[h][e] = sbuf[((size_t)sb * 2 + 0) * FF2 + c0 + e]; p1[h][e] = sbuf[((size_t)sb * 2 + 1) * FF2 + c0 + e]; } }
            else if (t0 == 0) {
#pragma unroll
                for (int e = 0; e < 8; ++e) { p2[h][e] = 0.f; p1[h][e] = 0.f; } }
            else { const v4u a = *(const v4u*)(U + (size_t)(row0 - 2) * FF2 + c0), b = *(const v4u*)(U + (size_t)(row0 - 1) * FF2 + c0);
#pragma unroll
                for (int e = 0; e < 4; ++e) { p2[h][2 * e] = bflo(a[e]); p2[h][2 * e + 1] = bfhi(a[e]); p1[h][2 * e] = bflo(b[e]); p1[h][2 * e + 1] = bfhi(b[e]); } }
        }
        for (int r = 0; r < nrows; ++r) {
            float cv[2][8];
#pragma unroll
            for (int h = 0; h < 2; ++h) { const v4u a = *(const v4u*)(U + (size_t)(row0 + r) * FF2 + j0 + h * D_FF);
#pragma unroll
                for (int e = 0; e < 4; ++e) { const float u0 = bflo(a[e]), u1 = bfhi(a[e]);
                    cv[h][2 * e] = bb[h][2 * e] + w[0][h][2 * e] * p2[h][2 * e] + w[1][h][2 * e] * p1[h][2 * e] + w[2][h][2 * e] * u0;
                    cv[h][2 * e + 1] = bb[h][2 * e + 1] + w[0][h][2 * e + 1] * p2[h][2 * e + 1] + w[1][h][2 * e + 1] * p1[h][2 * e + 1] + w[2][h][2 * e + 1] * u1;
                    p2[h][2 * e] = p1[h][2 * e]; p2[h][2 * e + 1] = p1[h][2 * e + 1]; p1[h][2 * e] = u0; p1[h][2 * e + 1] = u1; } }
            v4u o;
#pragma unroll
            for (int e = 0; e < 4; ++e) o[e] = cvt_pk_bf16(gelu_tanh(cv[0][2 * e]) * cv[1][2 * e], gelu_tanh(cv[0][2 * e + 1]) * cv[1][2 * e + 1]);
            *(v4u*)(ACT + (size_t)(row0 + r) * D_FF + j0) = o;
        }
    }
}
constexpr int NCPAD_P = (NC_P + 63) / 64 * 64, NCPAD_S = (NC_S + 63) / 64 * 64;
constexpr size_t KC_P_OFF = 0, VC_P_OFF = KC_P_OFF + (size_t)BATCH * 4 * NCPAD_P * 64 * 2, KC_S_OFF = VC_P_OFF + (size_t)BATCH * 4 * NCPAD_P * 64 * 2,
    VC_S_OFF = KC_S_OFF + (size_t)DEC_BATCH * 4 * NCPAD_S * 64 * 2, W1T_OFF = VC_S_OFF + (size_t)DEC_BATCH * 4 * NCPAD_S * 64 * 2,
    W2T_OFF = W1T_OFF + (size_t)2 * 64 * 2048 * 2,
    CB_OFF = W2T_OFF + (size_t)2 * 64 * 64 * 2, KC_END = CB_OFF + 2 * 64 * 4;
static_assert(KC_END <= ((size_t)64 << 20), "KC region");
__device__ __forceinline__ void compress_prologue(Frame& F) {
    LAS float* scr = (LAS float*)(F.lds + RING_OFF + F.wave * 16384);
    const int gw = F.vcu * NWAVES + F.wave, NGW = F.G * NWAVES;
    constexpr int I1 = (2048 / 64) * (64 / 32), I2 = (64 / 64) * (64 / 32);
    for (int it = gw; it < 2 * (I1 + I2); it += NGW) {
        const int c = it / (I1 + I2), r = it % (I1 + I2);
        if (r < I1) transpose_item(F.in[12] + (size_t)c * 2048 * 64, 2048, 64, 64, wsp<bf16>(F, WS_KC + W1T_OFF) + (size_t)c * 64 * 2048, scr, r, F.lane);
        else transpose_item(F.in[13] + (size_t)c * 64 * 64, 64, 64, 64, wsp<bf16>(F, WS_KC + W2T_OFF) + (size_t)c * 64 * 64, scr, r - I1, F.lane);
    }
    if ((int)blockIdx.x == F.G - 1 && F.tid < 128) {
        const int c = F.tid >> 6, h = F.tid & 63; const float* w1 = F.in[12] + (size_t)c * 2048 * 64; const float* pos = F.in[14];
        float s = 0.f;
        for (int l = 0; l < 32; ++l) for (int d = 0; d < 64; ++d) s += pos[(l * 2 + c) * 64 + d] * w1[(size_t)(l * 64 + d) * 64 + h];
        wsp<float>(F, WS_KC + CB_OFF)[c * 64 + h] = s;
    }
}
__device__ __forceinline__ bf16x8 ld_bf8_f32(const float* p) { const f32x4 a = *(const f32x4*)p, b = *(const f32x4*)(p + 4);
    v4u w; w.x = cvt_pk_bf16(a[0], a[1]); w.y = cvt_pk_bf16(a[2], a[3]); w.z = cvt_pk_bf16(b[0], b[1]); w.w = cvt_pk_bf16(b[2], b[3]); return __builtin_bit_cast(bf16x8, w); }
__device__ __forceinline__ void compress_phase(Frame& F) {
    constexpr int NJT_P = NCPAD_P / 32, NJT_S = NCPAD_S / 32, TILES_P = BATCH * 4 * 2 * NJT_P, TILES_S = DEC_BATCH * 4 * 2 * NJT_S;
    const int gw = F.vcu * NWAVES + F.wave, NGW = F.G * NWAVES, lane = F.lane, l32 = lane & 31, hi = lane >> 5;
    const bf16* W1T = wsp<bf16>(F, WS_KC + W1T_OFF); const bf16* W2T = wsp<bf16>(F, WS_KC + W2T_OFF); const float* CB = wsp<float>(F, WS_KC + CB_OFF);
    const bf16* KVB = wsp<bf16>(F, WS_KVB); const float* cache = F.in[2]; const int* pt = (const int*)F.in[8];
    for (int tile = gw; tile < TILES_P + TILES_S; tile += NGW) {
        const bool samp = tile >= TILES_P; int q = samp ? tile - TILES_P : tile;
        const int njt = samp ? NJT_S : NJT_P, nc = samp ? NC_S : NC_P, ncpad = samp ? NCPAD_S : NCPAD_P, tmax = samp ? PAST_LEN : SEQ;
        const int jt = q % njt; q /= njt; const int c = q & 1; q >>= 1; const int g = q & 3, b = q >> 2;
        const int j = jt * 32 + l32;
        int tok0 = 16 * j; if (tok0 > tmax - 32) tok0 = tmax - 32;
        f32x16 acc[2]; acc[0] = (f32x16){}; acc[1] = (f32x16){};
        const bf16* w1c = W1T + (size_t)c * 64 * 2048 + (size_t)l32 * 2048 + hi * 8;
        for (int lp = 0; lp < 32; ++lp) {
            const int tok = tok0 + lp; const bf16* pb = nullptr; const float* pf = nullptr;
            if (!samp) pb = KVB + (size_t)(b * SEQ + tok) * 1024 + c * 256 + g * 64 + hi * 8;
            else { const int page = pt[b * N_PAGES + tok / PAGE_SIZE]; pf = cache + ((size_t)page * PAGE_SIZE + tok % PAGE_SIZE) * 1024 + c * 256 + g * 64 + hi * 8; }
#pragma unroll
            for (int s4 = 0; s4 < 4; ++s4) {
                const bf16x8 kvf = samp ? ld_bf8_f32(pf + s4 * 16) : *(const bf16x8*)(pb + s4 * 16);
                const bf16x8 w0 = *(const bf16x8*)(w1c + lp * 64 + s4 * 16), w1 = *(const bf16x8*)(w1c + 32 * 2048 + lp * 64 + s4 * 16);
                acc[0] = __builtin_amdgcn_mfma_f32_32x32x16_bf16(w0, kvf, acc[0], 0, 0, 0);
                acc[1] = __builtin_amdgcn_mfma_f32_32x32x16_bf16(w1, kvf, acc[1], 0, 0, 0);
            }
        }
        f32x16 o[2]; o[0] = (f32x16){}; o[1] = (f32x16){};
#pragma unroll
        for (int hb = 0; hb < 2; ++hb) {
            float gv[16];
#pragma unroll
            for (int r = 0; r < 16; ++r) { const int h = 32 * hb + (r & 3) + 8 * (r >> 2) + 4 * hi; gv[r] = gelu_tanh(acc[hb][r] + CB[c * 64 + h]); }
#pragma unroll
            for (int s = 0; s < 2; ++s) {
                v4u pw; pw.x = cvt_pk_bf16(gv[8 * s + 0], gv[8 * s + 1]); pw.y = cvt_pk_bf16(gv[8 * s + 2], gv[8 * s + 3]); pw.z = cvt_pk_bf16(gv[8 * s + 4], gv[8 * s + 5]); pw.w = cvt_pk_bf16(gv[8 * s + 6], gv[8 * s + 7]);
                const bf16x8 gf = __builtin_bit_cast(bf16x8, pw);
#pragma unroll
                for (int db = 0; db < 2; ++db) {
                    const bf16* wp = W2T + (size_t)c * 64 * 64 + (size_t)(32 * db + l32) * 64 + 32 * hb + 16 * s + 4 * hi;
                    const v2u a0 = *(const v2u*)wp, a1 = *(const v2u*)(wp + 8); v4u aw; aw.x = a0.x; aw.y = a0.y; aw.z = a1.x; aw.w = a1.y;
                    o[db] = __builtin_amdgcn_mfma_f32_32x32x16_bf16(__builtin_bit_cast(bf16x8, aw), gf, o[db], 0, 0, 0);
                }
            }
        }
        bf16* dst = wsp<bf16>(F, WS_KC + (samp ? (c ? VC_S_OFF : KC_S_OFF) : (c ? VC_P_OFF : KC_P_OFF))) + ((size_t)(b * 4 + g) * ncpad + j) * 64;
        const bool live = j < nc;
#pragma unroll
        for (int db = 0; db < 2; ++db)
#pragma unroll
            for (int r4 = 0; r4 < 4; ++r4) { v2u w; w.x = live ? cvt_pk_bf16(o[db][4 * r4], o[db][4 * r4 + 1]) : 0u; w.y = live ? cvt_pk_bf16(o[db][4 * r4 + 2], o[db][4 * r4 + 3]) : 0u;
                *(v2u*)(dst + 32 * db + 8 * r4 + 4 * hi) = w; }
    }
}
typedef short v4i16 __attribute__((ext_vector_type(4)));
constexpr int AT_KSTR = 144, AT_TILE = 64 * AT_KSTR;
constexpr int AT_K = 0, AT_V = 2 * AT_TILE, AT_IMP = 4 * AT_TILE, IMPW_P = 65, IMPW_S = 132, AT_IMP_BYTES = 64 * IMPW_P * 4 + 256;
constexpr int AT_SEL = AT_IMP + AT_IMP_BYTES, AT_SC = AT_SEL + 64 * 3 * 8, AT_UNI = AT_SC + 8 * 192 * 4, AT_OACC = AT_UNI + 64, AT_END = AT_OACC + 32 * NTHREADS * 4;
static_assert((AT_OACC % 16) == 0 && AT_END <= RING_BYTES && 4 * IMPW_S * 4 <= AT_IMP_BYTES && (AT_IMP % 16) == 0 && (AT_SEL % 8) == 0, "attention LDS map");
constexpr float NEG_BIG = -1.0e30f;
struct AtUnit { bool samp; int b, g, t0, row0, ntok; };

template <int BR> __device__ __forceinline__ v4u at_load_piece(const Frame& F, const AtUnit& u, int ti, int isv) {
    const int row = F.tid >> 3, ch = F.tid & 7; const bf16* pb = nullptr; const float* pf = nullptr;
    if (BR == 0) {
        const size_t base = u.samp ? (isv ? VC_S_OFF : KC_S_OFF) : (isv ? VC_P_OFF : KC_P_OFF); const int ncpad = u.samp ? NCPAD_S : NCPAD_P;
        pb = wsp<bf16>(F, WS_KC + base) + ((size_t)(u.b * 4 + u.g) * ncpad + 64 * ti + row) * 64 + ch * 8;
    } else if (BR == 1) {
        const int co = 512 + isv * 256 + u.g * 64 + ch * 8;
        if (!u.samp) pb = wsp<bf16>(F, WS_KVB) + (size_t)(u.b * SEQ + 64 * ti + row) * 1024 + co;
        else if (ti < PAST_LEN / 64) { const int page = ((const int*)F.in[8])[u.b * N_PAGES + (64 * ti) / PAGE_SIZE]; pf = F.in[2] + ((size_t)page * PAGE_SIZE + (64 * ti) % PAGE_SIZE + row) * 1024 + co; }
        else if (row < DEC_SEQ) pb = wsp<bf16>(F, WS_KVB) + (size_t)(MPR + u.b * DEC_SEQ + row) * 1024 + co;
    } else {
        const int co = isv * 256 + u.g * 64 + ch * 8;
        if (!u.samp) pb = wsp<bf16>(F, WS_WINB) + (size_t)(u.b * SEQ + 64 * ti + row) * 512 + co;
        else { const int i = 64 * ti + row;
            if (i < WB_LEN) pf = F.in[3] + ((size_t)u.b * WB_LEN + i) * 512 + co;
            else if (i < WB_LEN + DEC_SEQ) pb = wsp<bf16>(F, WS_WINB) + (size_t)(MPR + u.b * DEC_SEQ + (i - WB_LEN)) * 512 + co; }
    }
    if (pb) return *(const v4u*)pb;
    if (pf) { const f32x4 a = *(const f32x4*)pf, b = *(const f32x4*)(pf + 4); v4u w; w.x = cvt_pk_bf16(a[0], a[1]); w.y = cvt_pk_bf16(a[2], a[3]); w.z = cvt_pk_bf16(b[0], b[1]); w.w = cvt_pk_bf16(b[2], b[3]); return w; }
    return (v4u){0u, 0u, 0u, 0u};
}
struct AtLane { int t; float slope2; bool rowok; int l32, hi; };
template <int MODE, int KSTEP> __device__ __forceinline__ void at_tile(const LAS unsigned char* Kt, const LAS unsigned char* Vt, const bf16x8 (&qf)[4], const AtLane& L,
        int kpos0, bool selok, int wlimit, float& m, float& l, f32x16 (&o)[2], float inv_l, LAS unsigned* imp_row, int j8base, int impw) {
    const int l32 = L.l32, hi = L.hi; const int pi = (l32 & 19) | ((l32 >> 1) & 4) | ((l32 << 1) & 8);
    f32x16 p[2];
#pragma unroll
    for (int kb = 0; kb < 2; ++kb) { p[kb] = (f32x16){};
        const LAS unsigned char* kr = Kt + (32 * kb + pi) * AT_KSTR + hi * 16;
#pragma unroll
        for (int kc = 0; kc < 4; ++kc) p[kb] = __builtin_amdgcn_mfma_f32_32x32x16_bf16(*(const LAS bf16x8*)(kr + kc * 32), qf[kc], p[kb], 0, 0, 0); }
    float mx = NEG_BIG; const bool rok = selok && L.rowok;
    int dbase = L.t - kpos0 - KSTEP * 8 * hi; ASMV("" : "+v"(dbase));
#pragma unroll
    for (int kb = 0; kb < 2; ++kb)
#pragma unroll
        for (int r = 0; r < 16; ++r) { const int dist = dbase - KSTEP * (32 * kb + 16 * (r >> 3) + (r & 7));
            const bool ok = rok && dist >= 0 && dist < wlimit; const float s = ok ? p[kb][r] - L.slope2 * (float)dist : NEG_BIG; p[kb][r] = s; mx = fmaxf(mx, s); }
    float mref = m;
    if (MODE != 1) { mx = fmaxf(mx, __shfl_xor(mx, 32)); const float mn = fmaxf(m, mx); const float alpha = __builtin_amdgcn_exp2f(m - mn); m = mn; mref = mn; l *= alpha;
        if (MODE == 2) {
#pragma unroll
            for (int db = 0; db < 2; ++db)
#pragma unroll
                for (int r = 0; r < 16; ++r) o[db][r] *= alpha; } }
    float ls = 0.f;
#pragma unroll
    for (int kb = 0; kb < 2; ++kb)
#pragma unroll
        for (int r = 0; r < 16; ++r) { const float s = p[kb][r]; float e = (s > -1.0e29f) ? __builtin_amdgcn_exp2f(s - mref) : 0.f; if (MODE == 1) e *= inv_l; p[kb][r] = e; ls += e; }
    if (MODE != 1) l += ls;
    if (MODE == 0) return;
    if (MODE == 1) {
#pragma unroll
        for (int kb = 0; kb < 2; ++kb)
#pragma unroll
            for (int hf = 0; hf < 2; ++hf) { const int na = (j8base + 32 * kb + 16 * hf + 8 * hi) >> 2; const int r0 = 8 * hf;
                const float a = (p[kb][r0] + p[kb][r0 + 1]) + (p[kb][r0 + 2] + p[kb][r0 + 3]), b = (p[kb][r0 + 4] + p[kb][r0 + 5]) + (p[kb][r0 + 6] + p[kb][r0 + 7]) + p[kb][r0 + 3], c = p[kb][r0 + 7];
                if (L.rowok) { __hip_atomic_fetch_add(imp_row + na, (unsigned)(a * 67108864.f + 0.5f), __ATOMIC_RELAXED, __HIP_MEMORY_SCOPE_WORKGROUP);
                    if (na + 1 < impw) __hip_atomic_fetch_add(imp_row + na + 1, (unsigned)(b * 67108864.f + 0.5f), __ATOMIC_RELAXED, __HIP_MEMORY_SCOPE_WORKGROUP);
                    if (na + 2 < impw) __hip_atomic_fetch_add(imp_row + na + 2, (unsigned)(c * 67108864.f + 0.5f), __ATOMIC_RELAXED, __HIP_MEMORY_SCOPE_WORKGROUP); } }
    }
    const int gi = L.l32 & 15;
    const LAS unsigned char* vbase = Vt + (8 * hi + (gi >> 2)) * AT_KSTR + (16 * ((L.l32 >> 4) & 1) + 4 * (gi & 3)) * 2;
#pragma unroll
    for (int kb = 0; kb < 2; ++kb)
#pragma unroll
        for (int s = 0; s < 2; ++s) { v4u pw; const int r0 = 8 * s;
            pw.x = cvt_pk_bf16(p[kb][r0], p[kb][r0 + 1]); pw.y = cvt_pk_bf16(p[kb][r0 + 2], p[kb][r0 + 3]); pw.z = cvt_pk_bf16(p[kb][r0 + 4], p[kb][r0 + 5]); pw.w = cvt_pk_bf16(p[kb][r0 + 6], p[kb][r0 + 7]);
            const bf16x8 pf = __builtin_bit_cast(bf16x8, pw);
#pragma unroll
            for (int db = 0; db < 2; ++db) { const LAS unsigned char* vp = vbase + (32 * kb + 16 * s) * AT_KSTR + 64 * db;
                const v4i16 lo = __builtin_amdgcn_ds_read_tr16_b64_v4i16((LAS v4i16*)vp), hh = __builtin_amdgcn_ds_read_tr16_b64_v4i16((LAS v4i16*)(vp + 4 * AT_KSTR));
                const bf16x8 vf = (bf16x8){lo[0], lo[1], lo[2], lo[3], hh[0], hh[1], hh[2], hh[3]};
                o[db] = __builtin_amdgcn_mfma_f32_32x32x16_bf16(vf, pf, o[db], 0, 0, 0); } }
}
#define AT_STAGE(bufi, kreg, vreg) do { const int _o = (F.tid >> 3) * AT_KSTR + (F.tid & 7) * 16; *(LAS v4u*)(lds + AT_K + (bufi) * AT_TILE + _o) = (kreg); *(LAS v4u*)(lds + AT_V + (bufi) * AT_TILE + _o) = (vreg); } while (0)

__device__ __forceinline__ void nsa_attn_phase(Frame& F) {
    LAS unsigned char* lds = F.lds + RING_OFF;
    LAS unsigned* imp = (LAS unsigned*)(lds + AT_IMP); LAS unsigned long long* selm = (LAS unsigned long long*)(lds + AT_SEL); LAS unsigned* scw = (LAS unsigned*)(lds + AT_SC) + F.wave * 192;
    constexpr int NQT = SEQ / 64, UNITS_P = BATCH * 4 * NQT, UNITS_S = DEC_BATCH * 4;
    const int lane = F.lane, l32 = lane & 31, hi = lane >> 5, hh = F.wave >> 1, th = F.wave & 1;
    for (int ui = F.vcu; ui < UNITS_S + UNITS_P; ui += F.G) {
        AtUnit u;
        if (ui < UNITS_S) { u.samp = true; u.b = ui >> 2; u.g = ui & 3; u.t0 = PAST_LEN; u.row0 = MPR + u.b * DEC_SEQ; u.ntok = DEC_SEQ; }
        else { const int v = ui - UNITS_S; u.samp = false; const int bg = v % (BATCH * 4), qt = NQT - 1 - v / (BATCH * 4); u.b = bg >> 2; u.g = bg & 3; u.t0 = 64 * qt; u.row0 = u.b * SEQ + u.t0; u.ntok = 64; }
        const int impw = u.samp ? IMPW_S : IMPW_P, nsel = u.samp ? NSEL_S : NSEL_P, keff = SEL_TOPK < nsel ? SEL_TOPK : nsel;
        AtLane L; L.l32 = l32; L.hi = hi; const int tk = 32 * th + l32; L.rowok = tk < u.ntok; L.t = u.t0 + (L.rowok ? tk : 0);
        L.slope2 = __builtin_amdgcn_exp2f(-0.5f * (float)(u.g * 4 + hh + 1)) * 1.4426950408889634f;
        const int qrow = u.row0 + (L.rowok ? tk : 0);
        bf16x8 qf[4];
        { const bf16* qp = wsp<bf16>(F, WS_Q) + (size_t)qrow * 1024 + u.g * 256 + hh * 64 + hi * 8;
#pragma unroll
          for (int kc = 0; kc < 4; ++kc) qf[kc] = *(const bf16x8*)(qp + kc * 16); }
        for (int i = F.tid; i < AT_IMP_BYTES / 4; i += NTHREADS) imp[i] = 0u;
        LAS unsigned* imp_row = imp + (L.rowok ? tk : 0) * impw;
        f32x16 o[2]; LAS float* oacc = (LAS float*)(lds + AT_OACC) + F.wave * 2048 + lane;
        const float* gp = wsp<float>(F, WS_GATES) + (size_t)qrow * 48 + u.g * 12 + hh * 3;
        const float g0 = sigmoidf_(gp[0]), g1 = sigmoidf_(gp[1]), g2 = sigmoidf_(gp[2]);
        const int nct = u.samp ? NCPAD_S / 64 : ((((u.t0 + 32) >> 4) >> 6) + 1 < NCPAD_P / 64 ? (((u.t0 + 32) >> 4) >> 6) + 1 : NCPAD_P / 64);
        float m = NEG_BIG, l = 0.f, inv_l = 0.f;
        for (int pass = 0; pass < 2; ++pass) {
            if (pass == 1) { l += __shfl_xor(l, 32); inv_l = l > 0.f ? 1.0f / l : 0.f; o[0] = (f32x16){}; o[1] = (f32x16){}; }
            v4u kr = at_load_piece<0>(F, u, 0, 0), vr = at_load_piece<0>(F, u, 0, 1);
            __syncthreads();
            AT_STAGE(0, kr, vr); __syncthreads();
            for (int i = 0; i < nct; ++i) {
                if (i + 1 < nct) { kr = at_load_piece<0>(F, u, i + 1, 0); vr = at_load_piece<0>(F, u, i + 1, 1); }
                const LAS unsigned char* Kt = lds + AT_K + (i & 1) * AT_TILE; const LAS unsigned char* Vt = lds + AT_V + (i & 1) * AT_TILE;
                if (pass == 0) at_tile<0, 16>(Kt, Vt, qf, L, 16 * 64 * i + 31, true, 0x7fffffff, m, l, o, 0.f, imp_row, 0, impw);
                else at_tile<1, 16>(Kt, Vt, qf, L, 16 * 64 * i + 31, true, 0x7fffffff, m, l, o, inv_l, imp_row, 64 * i, impw);
                if (i + 1 < nct) AT_STAGE((i + 1) & 1, kr, vr);
                __syncthreads();
            }
        }
#pragma unroll
        for (int db = 0; db < 2; ++db)
#pragma unroll
            for (int r = 0; r < 16; ++r) oacc[(16 * db + r) * 64] = g0 * o[db][r];
        for (int tkk = F.wave; tkk < u.ntok; tkk += NWAVES) {
            const int t = u.t0 + tkk, cur = t >> 6; unsigned sc[3];
#pragma unroll
            for (int i = 0; i < 3; ++i) { const int n = lane + 64 * i; unsigned s = 0u;
                if (n < nsel && 64 * n <= t) { s = imp[tkk * impw + n] + 1u; if (n == 0 || n == cur || n == cur - 1) s += 0x80000000u; }
                sc[i] = s; if (n < 192) scw[n] = s; }
            LDS_WAIT();
            int rank[3] = {0, 0, 0};
            for (int mI = 0; mI < nsel; ++mI) { const unsigned sm = scw[mI];
#pragma unroll
                for (int i = 0; i < 3; ++i) { const int n = lane + 64 * i; rank[i] += (sm > sc[i] || (sm == sc[i] && mI < n)) ? 1 : 0; } }
#pragma unroll
            for (int i = 0; i < 3; ++i) { const int n = lane + 64 * i; const unsigned long long bal = __ballot(n < nsel && sc[i] != 0u && rank[i] < keff); if (lane == 0) selm[tkk * 3 + i] = bal; }
            LDS_WAIT();
        }
        __syncthreads();
        if (F.wave == 0) {
#pragma unroll
            for (int i = 0; i < 3; ++i) { unsigned long long x = lane < u.ntok ? selm[lane * 3 + i] : 0ull; unsigned lo = (unsigned)x, hi32 = (unsigned)(x >> 32);
#pragma unroll
                for (int ofs = 1; ofs < 64; ofs <<= 1) { lo |= __shfl_xor(lo, ofs); hi32 |= __shfl_xor(hi32, ofs); }
                if (lane == 0) ((LAS unsigned long long*)(lds + AT_UNI))[i] = ((unsigned long long)hi32 << 32) | lo; } }
        __syncthreads();
        {
            m = NEG_BIG; l = 0.f; o[0] = (f32x16){}; o[1] = (f32x16){};
            const LAS unsigned long long* uni = (const LAS unsigned long long*)(lds + AT_UNI); int wi = 0; unsigned long long rem = uni[0]; int n = -1;
            auto next_tile = [&]() { while (rem == 0ull && wi < 2) { ++wi; rem = uni[wi]; } if (rem == 0ull) { n = -1; return; } const int bpos = __ffsll(rem) - 1; rem &= rem - 1ull; n = 64 * wi + bpos; };
            next_tile();
            v4u kr, vr; int buf = 0;
            if (n >= 0) { kr = at_load_piece<1>(F, u, n, 0); vr = at_load_piece<1>(F, u, n, 1); AT_STAGE(0, kr, vr); }
            __syncthreads();
            while (n >= 0) {
                const int ncur = n; next_tile();
                if (n >= 0) { kr = at_load_piece<1>(F, u, n, 0); vr = at_load_piece<1>(F, u, n, 1); }
                const bool selok = L.rowok && ((selm[tk * 3 + (ncur >> 6)] >> (ncur & 63)) & 1ull);
                if (__any(selok)) at_tile<2, 1>(lds + AT_K + buf * AT_TILE, lds + AT_V + buf * AT_TILE, qf, L, 64 * ncur, selok, 0x7fffffff, m, l, o, 0.f, imp_row, 0, impw);
                if (n >= 0) AT_STAGE(buf ^ 1, kr, vr);
                buf ^= 1;
                __syncthreads();
            }
            l += __shfl_xor(l, 32); const float sc1 = l > 0.f ? g1 / l : 0.f;
#pragma unroll
            for (int db = 0; db < 2; ++db)
#pragma unroll
                for (int r = 0; r < 16; ++r) oacc[(16 * db + r) * 64] += sc1 * o[db][r];
        }
        {
            m = NEG_BIG; l = 0.f; o[0] = (f32x16){}; o[1] = (f32x16){};
            int tfirst, tlast, kp0;
            if (u.samp) { tfirst = 0; tlast = (WB_LEN + DEC_SEQ + 63) / 64 - 1; kp0 = PAST_LEN - WB_LEN; }
            else { const int lo = u.t0 - WINDOW + 1; tfirst = lo > 0 ? lo >> 6 : 0; tlast = u.t0 >> 6; kp0 = 0; }
            v4u kr = at_load_piece<2>(F, u, tfirst, 0), vr = at_load_piece<2>(F, u, tfirst, 1); AT_STAGE(0, kr, vr);
            __syncthreads();
            for (int ti = tfirst; ti <= tlast; ++ti) { const int buf = (ti - tfirst) & 1;
                if (ti < tlast) { kr = at_load_piece<2>(F, u, ti + 1, 0); vr = at_load_piece<2>(F, u, ti + 1, 1); }
                at_tile<2, 1>(lds + AT_K + buf * AT_TILE, lds + AT_V + buf * AT_TILE, qf, L, kp0 + 64 * ti, true, WINDOW, m, l, o, 0.f, imp_row, 0, impw);
                if (ti < tlast) AT_STAGE(buf ^ 1, kr, vr);
                __syncthreads();
            }
            l += __shfl_xor(l, 32); const float sc2 = l > 0.f ? g2 / l : 0.f;
#pragma unroll
            for (int db = 0; db < 2; ++db)
#pragma unroll
                for (int r = 0; r < 16; ++r) o[db][r] = oacc[(16 * db + r) * 64] + sc2 * o[db][r];
        }
        if (L.rowok) { bf16* op = wsp<bf16>(F, WS_AO) + (size_t)qrow * 1024 + u.g * 256 + hh * 64 + 4 * hi;
#pragma unroll
            for (int db = 0; db < 2; ++db)
#pragma unroll
                for (int r4 = 0; r4 < 4; ++r4) { v2u w; w.x = cvt_pk_bf16(o[db][4 * r4], o[db][4 * r4 + 1]); w.y = cvt_pk_bf16(o[db][4 * r4 + 2], o[db][4 * r4 + 3]); *(v2u*)(op + 32 * db + 8 * r4) = w; } }
        __syncthreads();
    }
}
constexpr int NCK = SEQ / 64, NBH = BATCH * 8;
constexpr size_t MS_M = 0, MS_D = MS_M + al4k((size_t)NBH * (NCK + 1) * 4), MS_DC = MS_D + al4k((size_t)NBH * NCK * 4), MS_DN = MS_DC + al4k((size_t)NBH * NCK * 8192 * 4),
    MS_CST = MS_DN + al4k((size_t)NBH * NCK * 64 * 4), MS_NST = MS_CST + al4k((size_t)NBH * NCK * 8192 * 2), MS_END = MS_NST + al4k((size_t)NBH * NCK * 64 * 4);
static_assert(MS_END <= ((size_t)512 << 20), "mLSTM scratch");
constexpr float LOG2E = 1.4426950408889634f;
__device__ __forceinline__ float log_sigmoidf_(float x) { return fminf(x, 0.f) - 0.6931471805599453f * __builtin_amdgcn_logf(1.0f + __builtin_amdgcn_exp2f(-fabsf(x) * LOG2E)); }
__device__ __forceinline__ float expf_(float x) { return __builtin_amdgcn_exp2f(x * LOG2E); }
__device__ __forceinline__ float wave_incl_sum(float v, int lane) {
#pragma unroll
    for (int o = 1; o < 64; o <<= 1) { const float t = __shfl(v, lane - o < 0 ? 0 : lane - o); if (lane >= o) v += t; }
    return v;
}
__device__ __forceinline__ float wave_incl_max(float v, int lane) {
#pragma unroll
    for (int o = 1; o < 64; o <<= 1) { const float t = __shfl(v, lane - o < 0 ? 0 : lane - o); if (lane >= o) v = fmaxf(v, t); }
    return v;
}
constexpr int ML_KSTR = 144, ML_VSTR = 272;
__device__ __forceinline__ bf16x8 mk8(v4i16 a, v4i16 b) { return (bf16x8){a[0], a[1], a[2], a[3], b[0], b[1], b[2], b[3]}; }
__device__ __forceinline__ void mlstm_phase_a(Frame& F) {
    LAS unsigned char* lds = F.lds + RING_OFF;
    LAS float* sB = (LAS float*)lds; LAS float* sA = sB + NCK; LAS float* sM = sA + NCK;
    LAS unsigned char* Kt = lds + 4096; LAS unsigned char* Vt = Kt + 64 * ML_KSTR;
    static_assert((3 * NCK + 1) * 4 <= 4096 && 4096 + 64 * ML_KSTR + 64 * ML_VSTR <= RING_BYTES, "phase A LDS");
    const float* MG = wsp<float>(F, WS_MG); const bf16* MK = wsp<bf16>(F, WS_MK); const bf16* MV = wsp<bf16>(F, WS_MV);
    float* MSTm = wsp<float>(F, WS_MISC + MS_M); float* MSTd = wsp<float>(F, WS_MISC + MS_D); float* DC = wsp<float>(F, WS_MISC + MS_DC); float* DN = wsp<float>(F, WS_MISC + MS_DN);
    const int lane = F.lane, l32 = lane & 31, hi = lane >> 5;
    constexpr int NCG = NCK / 8, UNITS = NBH * NCG;
    for (int un = F.vcu; un < UNITS; un += F.G) {
        const int bh = un / NCG, cg = un % NCG, b = bh >> 3, h = bh & 7, cend = 8 * cg + 8;
        const float bi = F.in[16][h], bfg = F.in[16][8 + h];
        __syncthreads();
        for (int j = F.wave; j < cend; j += NWAVES) { const size_t row = (size_t)b * SEQ + 64 * j + lane;
            const float ig = MG[row * 16 + h] + bi, fg = log_sigmoidf_(MG[row * 16 + 8 + h] + bfg);
            const float bb = wave_incl_sum(fg, lane), Bj = __shfl(bb, 63), aj = wave_max(Bj - bb + ig);
            if (lane == 0) { sB[j] = Bj; sA[j] = aj; } }
        __syncthreads();
        if (F.tid == 0) { float m = 0.f; sM[0] = 0.f; for (int j = 0; j < cend; ++j) { m = fmaxf(sB[j] + m, sA[j]); sM[j + 1] = m; } }
        __syncthreads();
        if (F.tid < 8) { const int c = 8 * cg + F.tid; MSTm[bh * (NCK + 1) + c] = sM[c]; MSTd[bh * NCK + c] = expf_(sB[c] + sM[c] - sM[c + 1]);
            if (c == NCK - 1) { MSTm[bh * (NCK + 1) + NCK] = sM[NCK]; F.out[O_MP + bh] = sM[NCK]; } }
        for (int cc = 0; cc < 8; ++cc) { const int c = 8 * cg + cc; const size_t row0 = (size_t)b * SEQ + 64 * c;
            const float ig = MG[(row0 + lane) * 16 + h] + bi, fg = log_sigmoidf_(MG[(row0 + lane) * 16 + 8 + h] + bfg);
            const float bb = wave_incl_sum(fg, lane), Bc = __shfl(bb, 63); const float ws = expf_(Bc - bb + ig - sM[c + 1]);
            { const int r = F.tid >> 3, ch = F.tid & 7; const float wr = __shfl(ws, r & 63);
              const v4u kk = *(const v4u*)(MK + (row0 + r) * 512 + h * 64 + ch * 8); v4u o;
#pragma unroll
              for (int e = 0; e < 4; ++e) o[e] = cvt_pk_bf16(bflo(kk[e]) * wr, bfhi(kk[e]) * wr);
              *(LAS v4u*)(Kt + r * ML_KSTR + ch * 16) = o;
#pragma unroll
              for (int i2 = 0; i2 < 2; ++i2) { const int p = F.tid + 512 * i2, rv = p >> 4, cv = p & 15; *(LAS v4u*)(Vt + rv * ML_VSTR + cv * 16) = *(const v4u*)(MV + (row0 + rv) * 1024 + h * 128 + cv * 8); } }
            __syncthreads();
            { const int vb = F.wave >> 1, db = F.wave & 1, gi = l32 & 15; f32x16 acc = (f32x16){};
              const LAS unsigned char* va = Vt + (8 * hi + (gi >> 2)) * ML_VSTR + (32 * vb + 16 * ((l32 >> 4) & 1) + 4 * (gi & 3)) * 2;
              const LAS unsigned char* ka = Kt + (8 * hi + (gi >> 2)) * ML_KSTR + (32 * db + 16 * ((l32 >> 4) & 1) + 4 * (gi & 3)) * 2;
#pragma unroll
              for (int ks = 0; ks < 4; ++ks) {
                  const v4i16 a0 = __builtin_amdgcn_ds_read_tr16_b64_v4i16((LAS v4i16*)(va + 16 * ks * ML_VSTR)), a1 = __builtin_amdgcn_ds_read_tr16_b64_v4i16((LAS v4i16*)(va + (16 * ks + 4) * ML_VSTR));
                  const v4i16 b0 = __builtin_amdgcn_ds_read_tr16_b64_v4i16((LAS v4i16*)(ka + 16 * ks * ML_KSTR)), b1 = __builtin_amdgcn_ds_read_tr16_b64_v4i16((LAS v4i16*)(ka + (16 * ks + 4) * ML_KSTR));
                  acc = __builtin_amdgcn_mfma_f32_32x32x16_bf16(mk8(a0, a1), mk8(b0, b1), acc, 0, 0, 0); }
              float* dc = DC + ((size_t)bh * NCK + c) * 8192 + (32 * vb + 4 * hi) * 64 + 32 * db + l32;
#pragma unroll
              for (int r = 0; r < 16; ++r) dc[((r & 3) + 8 * (r >> 2)) * 64] = acc[r];
              if (F.tid < 64) { float s = 0.f; for (int r = 0; r < 64; ++r) s += bf2f(*(const LAS unsigned short*)(Kt + r * ML_KSTR + F.tid * 2)); DN[((size_t)bh * NCK + c) * 64 + F.tid] = s; } }
            __syncthreads();
        }
    }
}
__device__ __forceinline__ void mlstm_phase_b(Frame& F) {
    LAS float* part = (LAS float*)(F.lds + RING_OFF);
    const float* MG = wsp<float>(F, WS_MG); const bf16* MQ = wsp<bf16>(F, WS_MQ); const bf16* MK = wsp<bf16>(F, WS_MK); const bf16* MV = wsp<bf16>(F, WS_MV); const bf16* MO = wsp<bf16>(F, WS_MO);
    for (int un = F.vcu; un < DEC_BATCH * 8; un += F.G) {
        const int b = un >> 3, h = un & 7, v = F.tid >> 2, dq = F.tid & 3; const size_t r0 = (size_t)MPR + b * DEC_SEQ;
        const float bi = F.in[16][h], bfg = F.in[16][8 + h], m0 = F.in[6][un];
        float ig[4], bb[4], mt[4]; float run = 0.f;
#pragma unroll
        for (int t = 0; t < 4; ++t) { ig[t] = MG[(r0 + t) * 16 + h] + bi; run += log_sigmoidf_(MG[(r0 + t) * 16 + 8 + h] + bfg); bb[t] = run; }
#pragma unroll
        for (int t = 0; t < 4; ++t) { float mx = bb[t] + m0;
#pragma unroll
            for (int s = 0; s <= t; ++s) mx = fmaxf(mx, bb[t] - bb[s] + ig[s]); mt[t] = mx; }
        float qk[4][4], nq[4] = {0.f, 0.f, 0.f, 0.f};
#pragma unroll
        for (int t = 0; t < 4; ++t)
#pragma unroll
            for (int s = 0; s < 4; ++s) qk[t][s] = 0.f;
        const float* n0 = F.in[5] + (size_t)un * 64;
        for (int d = 0; d < 64; ++d) { float q[4], k[4];
#pragma unroll
            for (int t = 0; t < 4; ++t) { q[t] = bf2f(MQ[(r0 + t) * 512 + h * 64 + d]); k[t] = bf2f(MK[(r0 + t) * 512 + h * 64 + d]); }
            const float nn = n0[d];
#pragma unroll
            for (int t = 0; t < 4; ++t) { nq[t] += nn * q[t];
#pragma unroll
                for (int s = 0; s <= t; ++s) qk[t][s] += q[t] * k[s]; } }
        const float* C0 = F.in[4] + ((size_t)un * 128 + v) * 64 + 16 * dq;
        float c0[16], cq[4] = {0.f, 0.f, 0.f, 0.f};
#pragma unroll
        for (int e = 0; e < 16; ++e) c0[e] = C0[e];
#pragma unroll
        for (int t = 0; t < 4; ++t) {
#pragma unroll
            for (int e = 0; e < 16; ++e) cq[t] += c0[e] * bf2f(MQ[(r0 + t) * 512 + h * 64 + 16 * dq + e]);
            cq[t] += __shfl_xor(cq[t], 1); cq[t] += __shfl_xor(cq[t], 2); }
        float vv[4], hv[4], ssq[4];
#pragma unroll
        for (int t = 0; t < 4; ++t) vv[t] = bf2f(MV[(r0 + t) * 1024 + h * 128 + v]);
#pragma unroll
        for (int t = 0; t < 4; ++t) { const float wi = expf_(bb[t] + m0 - mt[t]); float num = wi * cq[t], den = wi * nq[t];
#pragma unroll
            for (int s = 0; s <= t; ++s) { const float S = qk[t][s] * expf_(bb[t] - bb[s] + ig[s] - mt[t]); num += S * vv[s]; den += S; }
            hv[t] = num / fmaxf(fabsf(den), expf_(-mt[t])); float q2 = (dq == 0) ? hv[t] * hv[t] : 0.f;
#pragma unroll
            for (int o = 1; o < 64; o <<= 1) q2 += __shfl_xor(q2, o);
            ssq[t] = q2; }
        __syncthreads();
        if (F.lane == 0) {
#pragma unroll
            for (int t = 0; t < 4; ++t) part[F.wave * 4 + t] = ssq[t]; }
        __syncthreads();
        if (dq == 0) {
#pragma unroll
            for (int t = 0; t < 4; ++t) { float tot = 0.f;
#pragma unroll
                for (int w = 0; w < 8; ++w) tot += part[w * 4 + t];
                const float rn = 1.0f / sqrtf(tot * (1.0f / 128.0f) + RMS_EPS);
                const float o = hv[t] * rn * F.in[17][h * 128 + v] * sigmoidf_(bf2f(MO[(r0 + t) * 1024 + h * 128 + v]));
                wsp<bf16>(F, WS_AO)[(r0 + t) * 1024 + h * 128 + v] = (bf16)(cvt_pk_bf16(o, 0.f) & 0xffffu); } }
        const float mL = mt[3], decay = expf_(bb[3] + m0 - mL); float wsv[4];
#pragma unroll
        for (int s = 0; s < 4; ++s) wsv[s] = expf_(bb[3] - bb[s] + ig[s] - mL);
        float* Co = F.out + O_CS + ((size_t)un * 128 + v) * 64 + 16 * dq;
#pragma unroll
        for (int e = 0; e < 16; ++e) { float a = decay * c0[e];
#pragma unroll
            for (int s = 0; s < 4; ++s) a += wsv[s] * vv[s] * bf2f(MK[(r0 + s) * 512 + h * 64 + 16 * dq + e]);
            Co[e] = a; }
        if (F.tid < 64) { float a = decay * n0[F.tid];
#pragma unroll
            for (int s = 0; s < 4; ++s) a += wsv[s] * bf2f(MK[(r0 + s) * 512 + h * 64 + F.tid]);
            F.out[O_NS + (size_t)un * 64 + F.tid] = a; }
        if (F.tid == 0) F.out[O_MS + un] = mL;
    }
    const float* MSTd = wsp<float>(F, WS_MISC + MS_D); const float* DC = wsp<float>(F, WS_MISC + MS_DC); const float* DN = wsp<float>(F, WS_MISC + MS_DN);
    bf16* CST = wsp<bf16>(F, WS_MISC + MS_CST); float* NST = wsp<float>(F, WS_MISC + MS_NST);
    const int gt = F.vcu * NTHREADS + F.tid, NGT = F.G * NTHREADS;
    for (int it = gt; it < NBH * 4096; it += NGT) { const int bh = it >> 12, e2 = (it & 4095) * 2; f32x2 C = (f32x2){0.f, 0.f};
        for (int c = 0; c < NCK; ++c) { const size_t o = ((size_t)bh * NCK + c) * 8192 + e2; *(unsigned*)(CST + o) = cvt_pk_bf16(C.x, C.y);
            const float dcy = MSTd[bh * NCK + c]; const f32x2 d = *(const f32x2*)(DC + o); C = C * dcy + d; }
        *(f32x2*)(F.out + O_CP + (size_t)bh * 8192 + e2) = C; }
    for (int it = gt; it < NBH * 64; it += NGT) { const int bh = it >> 6, d = it & 63; float n = 0.f;
        for (int c = 0; c < NCK; ++c) { const size_t o = ((size_t)bh * NCK + c) * 64 + d; NST[o] = n; n = n * MSTd[bh * NCK + c] + DN[o]; }
        F.out[O_NP + (size_t)bh * 64 + d] = n; }
}
__device__ __forceinline__ void mlstm_phase_c(Frame& F) {
    constexpr int WAREA = 64 * ML_VSTR + 1024;
    static_assert(WAREA * 8 <= RING_BYTES, "phase C LDS");
    LAS unsigned char* wl = F.lds + RING_OFF + F.wave * WAREA; LAS unsigned char* Vt = wl; LAS float* sU = (LAS float*)(wl + 64 * ML_VSTR); LAS float* sW = sU + 64; LAS float* sBc = sW + 64;
    const float* MG = wsp<float>(F, WS_MG); const bf16* MQ = wsp<bf16>(F, WS_MQ); const bf16* MK = wsp<bf16>(F, WS_MK); const bf16* MV = wsp<bf16>(F, WS_MV); const bf16* MO = wsp<bf16>(F, WS_MO);
    const float* MSTm = wsp<float>(F, WS_MISC + MS_M); const bf16* CST = wsp<bf16>(F, WS_MISC + MS_CST); const float* NST = wsp<float>(F, WS_MISC + MS_NST);
    const int lane = F.lane, l32 = lane & 31, hi = lane >> 5, gw = F.vcu * NWAVES + F.wave, NGW = F.G * NWAVES;
    const int pi = (l32 & 19) | ((l32 >> 1) & 4) | ((l32 << 1) & 8);
    for (int un = gw; un < NBH * NCK; un += NGW) {
        const int bh = un / NCK, c = un % NCK, b = bh >> 3, h = bh & 7; const size_t row0 = (size_t)b * SEQ + 64 * c;
        const float mc = MSTm[bh * (NCK + 1) + c];
        { const float ig = MG[(row0 + lane) * 16 + h] + F.in[16][h], fg = log_sigmoidf_(MG[(row0 + lane) * 16 + 8 + h] + F.in[16][8 + h]);
          const float bb = wave_incl_sum(fg, lane), uu = ig - bb, gg = wave_incl_max(uu, lane);
          sU[lane] = uu * LOG2E; sW[lane] = fmaxf(mc, gg) * LOG2E; sBc[lane] = bb * LOG2E; }
#pragma unroll
        for (int i = 0; i < 16; ++i) { const int p = lane + 64 * i, rv = p >> 4, cv = p & 15; *(LAS v4u*)(Vt + rv * ML_VSTR + cv * 16) = *(const v4u*)(MV + (row0 + rv) * 1024 + h * 128 + cv * 8); }
        LDS_WAIT();
        const float* nst = NST + ((size_t)bh * NCK + c) * 64; const bf16* cst = CST + ((size_t)bh * NCK + c) * 8192;
#pragma unroll 1
        for (int tb = 0; tb < 2; ++tb) {
            const int t = 32 * tb + l32; const float Wt = sW[t], wi = __builtin_amdgcn_exp2f(mc * LOG2E - Wt);
            bf16x8 qf[4]; float nq = 0.f;
#pragma unroll
            for (int kc = 0; kc < 4; ++kc) { qf[kc] = *(const bf16x8*)(MQ + (row0 + t) * 512 + h * 64 + 16 * kc + 8 * hi);
                const f32x4 n0 = *(const f32x4*)(nst + 16 * kc + 8 * hi), n1 = *(const f32x4*)(nst + 16 * kc + 8 * hi + 4); const v4u qw = __builtin_bit_cast(v4u, qf[kc]);
                nq += n0[0] * bflo(qw.x) + n0[1] * bfhi(qw.x) + n0[2] * bflo(qw.y) + n0[3] * bfhi(qw.y) + n1[0] * bflo(qw.z) + n1[1] * bfhi(qw.z) + n1[2] * bflo(qw.w) + n1[3] * bfhi(qw.w); }
            nq += __shfl_xor(nq, 32);
            f32x16 p[2]; float rs = 0.f;
#pragma unroll
            for (int sb = 0; sb < 2; ++sb) { p[sb] = (f32x16){};
                if (sb <= tb) {
#pragma unroll
                    for (int kc = 0; kc < 4; ++kc) p[sb] = __builtin_amdgcn_mfma_f32_32x32x16_bf16(*(const bf16x8*)(MK + (row0 + 32 * sb + pi) * 512 + h * 64 + 16 * kc + 8 * hi), qf[kc], p[sb], 0, 0, 0);
#pragma unroll
                    for (int hf = 0; hf < 2; ++hf) { const int s0 = 32 * sb + 16 * hf + 8 * hi; const f32x4 u0 = *(const LAS f32x4*)(sU + s0), u1 = *(const LAS f32x4*)(sU + s0 + 4);
#pragma unroll
                        for (int e = 0; e < 8; ++e) { const float uu = e < 4 ? u0[e & 3] : u1[e & 3]; const float w = (s0 + e <= t) ? __builtin_amdgcn_exp2f(uu - Wt) : 0.f; const float x = p[sb][8 * hf + e] * w; p[sb][8 * hf + e] = x; rs += x; } } } }
            rs += __shfl_xor(rs, 32);
            const float den = wi * nq + rs, inv = 1.0f / fmaxf(fabsf(den), __builtin_amdgcn_exp2f(-(sBc[t] + Wt)));
            unsigned hp[4][8]; float ssq = 0.f;
            const int gi = l32 & 15;
#pragma unroll
            for (int vq = 0; vq < 4; ++vq) { f32x16 acc = (f32x16){};
#pragma unroll
                for (int kc = 0; kc < 4; ++kc) acc = __builtin_amdgcn_mfma_f32_32x32x16_bf16(*(const bf16x8*)(cst + (32 * vq + l32) * 64 + 16 * kc + 8 * hi), qf[kc], acc, 0, 0, 0);
#pragma unroll
                for (int r = 0; r < 16; ++r) acc[r] *= wi;
                const LAS unsigned char* va = Vt + (8 * hi + (gi >> 2)) * ML_VSTR + (32 * vq + 16 * ((l32 >> 4) & 1) + 4 * (gi & 3)) * 2;
#pragma unroll
                for (int sb = 0; sb < 2; ++sb) if (sb <= tb) {
#pragma unroll
                    for (int ks = 0; ks < 2; ++ks) { const int r0 = 8 * ks; v4u pw;
                        pw.x = cvt_pk_bf16(p[sb][r0], p[sb][r0 + 1]); pw.y = cvt_pk_bf16(p[sb][r0 + 2], p[sb][r0 + 3]); pw.z = cvt_pk_bf16(p[sb][r0 + 4], p[sb][r0 + 5]); pw.w = cvt_pk_bf16(p[sb][r0 + 6], p[sb][r0 + 7]);
                        const v4i16 a0 = __builtin_amdgcn_ds_read_tr16_b64_v4i16((LAS v4i16*)(va + (32 * sb + 16 * ks) * ML_VSTR)), a1 = __builtin_amdgcn_ds_read_tr16_b64_v4i16((LAS v4i16*)(va + (32 * sb + 16 * ks + 4) * ML_VSTR));
                        acc = __builtin_amdgcn_mfma_f32_32x32x16_bf16(mk8(a0, a1), __builtin_bit_cast(bf16x8, pw), acc, 0, 0, 0); } }
#pragma unroll
                for (int r = 0; r < 16; r += 2) { const float h0 = acc[r] * inv, h1 = acc[r + 1] * inv; ssq += h0 * h0 + h1 * h1; hp[vq][r >> 1] = cvt_pk_bf16(h0, h1); } }
            ssq += __shfl_xor(ssq, 32);
            const float rn = 1.0f / sqrtf(ssq * (1.0f / 128.0f) + RMS_EPS);
            const float* hn = F.in[17] + h * 128; const bf16* mo = MO + (row0 + t) * 1024 + h * 128; bf16* ao = wsp<bf16>(F, WS_AO) + (row0 + t) * 1024 + h * 128;
#pragma unroll
            for (int vq = 0; vq < 4; ++vq)
#pragma unroll
                for (int r4 = 0; r4 < 4; ++r4) { const int v = 32 * vq + 8 * r4 + 4 * hi; const f32x4 g = *(const f32x4*)(hn + v); const v2u ow = *(const v2u*)(mo + v);
                    const float y0 = bflo(hp[vq][2 * r4]) * rn * g[0] * sigmoidf_(bflo(ow.x)), y1 = bfhi(hp[vq][2 * r4]) * rn * g[1] * sigmoidf_(bfhi(ow.x));
                    const float y2 = bflo(hp[vq][2 * r4 + 1]) * rn * g[2] * sigmoidf_(bflo(ow.y)), y3 = bfhi(hp[vq][2 * r4 + 1]) * rn * g[3] * sigmoidf_(bfhi(ow.y));
                    v2u w; w.x = cvt_pk_bf16(y0, y1); w.y = cvt_pk_bf16(y2, y3); *(v2u*)(ao + v) = w; }
        }
        LDS_WAIT();
    }
}
struct Args { const float* in[23]; float* out; unsigned char* ws; int ph_lo, ph_hi; };
constexpr int N_PHASES = 20;
__global__ void __launch_bounds__(NTHREADS, 2) mega_fwd(Args args) {
#ifdef EMU
    unsigned char* lds = emu_cur->blk->lds;
#else
    extern __shared__ __attribute__((aligned(16))) unsigned char lds[];
#endif
    Frame F;
    F.lds = (LAS unsigned char*)lds;
    F.MISC = (volatile LAS unsigned*)(F.lds + MISC_OFF);
    F.tid = threadIdx.x; F.lane = F.tid & 63; F.wave = __builtin_amdgcn_readfirstlane(F.tid >> 6);
    F.G = gridDim.x; { const int bx = blockIdx.x; F.vcu = (F.G % 8 == 0) ? (bx % 8) * (F.G / 8) + bx / 8 : bx; }
    F.ws = args.ws; F.out = args.out; F.ctl = (gu32*)(args.ws + WS_CTL);
#ifdef EMU
    F.in = args.in;
#else
    { const unsigned char __attribute__((address_space(4)))* ka = (const unsigned char __attribute__((address_space(4)))*)__builtin_amdgcn_kernarg_segment_ptr();
      F.in = (const float* const*)(const unsigned char*)ka; }
#endif
    for (int u = F.tid; u < (LDS_BYTES - LDSCTL_OFF) / 4; u += NTHREADS) ((LAS unsigned*)(F.lds + LDSCTL_OFF))[u] = 0u;
    __syncthreads();
    XcdBarrier bar = xcd_barrier_post((unsigned*)(F.ctl + CW_BAR), F.MISC + 8);
    const int lo = args.ph_lo, hi = args.ph_hi;
#ifdef EMU
#define LAUNDER() ((void)0)
#else
#define RFL64(x) (((unsigned long long)(unsigned)__builtin_amdgcn_readfirstlane((int)((x) >> 32)) << 32) | (unsigned long long)(unsigned)__builtin_amdgcn_readfirstlane((int)(x)))
#define LAUNDER() do { unsigned long long a_ = (unsigned long long)F.ws, b_ = (unsigned long long)F.out, c_ = (unsigned long long)F.in; int t_ = F.tid; \
    a_ = RFL64(a_); b_ = RFL64(b_); c_ = RFL64(c_); asm volatile("" : "+s"(a_), "+s"(b_), "+s"(c_), "+v"(t_)); F.tid = t_; F.lane = t_ & 63; F.wave = __builtin_amdgcn_readfirstlane(t_ >> 6); \
    F.ws = (unsigned char*)a_; F.out = (float*)b_; F.in = (const float* const*)c_; F.ctl = (gu32*)(F.ws + WS_CTL); } while (0)
#endif
#define IN(k) (lo <= (k) && (k) < hi)
#define SEAM(k) do { if (IN(k) && IN((k) + 1)) xcd_barrier(bar); LAUNDER(); } while (0)
    const float* norm_g = F.in[9];

    if (IN(0)) { p0_prologue(F); compress_prologue(F); } SEAM(0);
    if (IN(1)) {
        pg8::Gemm g{wsp<bf16>(F, WS_H), wsp<bf16>(F, WS_WNSAIN), MPAD, NSA_IN_PAD, D}; pg8::StaticOrder S; S.init(MPAD, NSA_IN_PAD, F.G, (int)blockIdx.x);
        EpiNsaIn E{wsp<bf16>(F, WS_Q), wsp<bf16>(F, WS_KVB), wsp<bf16>(F, WS_WINB), wsp<float>(F, WS_GATES), F.out};
        pg8::gemm_phase<EpiNsaIn, pg8::StaticOrder, true, true>(F.lds + RING_OFF, g, S, E);
    } SEAM(1);
    if (IN(2)) { compress_phase(F); } SEAM(2);
    if (IN(3)) { nsa_attn_phase(F); } SEAM(3);
#pragma unroll 1
    for (int layer = 0; layer < 2; ++layer) {
        const int pb = layer * 10;
        if (layer == 1) {
            if (IN(10)) {
                pg8::Gemm g{wsp<bf16>(F, WS_H), wsp<bf16>(F, WS_WMLIN), MPAD, ML_IN_PAD, D}; pg8::StaticOrder S; S.init(MPAD, ML_IN_PAD, F.G, (int)blockIdx.x);
                EpiMlIn E{wsp<bf16>(F, WS_MQ), wsp<bf16>(F, WS_MK), wsp<bf16>(F, WS_MV), wsp<bf16>(F, WS_MO), wsp<float>(F, WS_MG)};
                pg8::gemm_phase<EpiMlIn, pg8::StaticOrder, true, true>(F.lds + RING_OFF, g, S, E);
            } SEAM(10);
            if (IN(11)) { mlstm_phase_a(F); } SEAM(11);
            if (IN(12)) { mlstm_phase_b(F); } SEAM(12);
            if (IN(13)) { mlstm_phase_c(F); } SEAM(13);
        }
        if (IN(pb + 4)) {
            pg8::Gemm g{wsp<bf16>(F, WS_AO), wsp<bf16>(F, layer ? WS_WMLOUT : WS_WNSAOUT), MPAD, D, D}; pg8::StaticOrder S; S.init(MPAD, D, F.G, (int)blockIdx.x);
            EpiF32 E{wsp<float>(F, WS_Y), D};
            pg8::gemm_phase<EpiF32, pg8::StaticOrder, true, true>(F.lds + RING_OFF, g, S, E);
        } SEAM(pb + 4);
        if (IN(pb + 5)) { norm_phase(F, wsp<float>(F, WS_Y), norm_g + (size_t)(layer * 4 + 1) * D, norm_g + (size_t)(layer * 4 + 2) * D, wsp<bf16>(F, WS_H)); } SEAM(pb + 5);
        if (IN(pb + 6)) {
            pg8::Gemm g{wsp<bf16>(F, WS_H), wsp<bf16>(F, WS_WUP) + (size_t)layer * FF2 * D, MPAD, FF2, D}; pg8::StaticOrder S; S.init(MPAD, FF2, F.G, (int)blockIdx.x);
            EpiUp E{wsp<bf16>(F, WS_U), F.out, layer};
            pg8::gemm_phase<EpiUp, pg8::StaticOrder, true, true>(F.lds + RING_OFF, g, S, E);
        } SEAM(pb + 6);
        if (IN(pb + 7)) { conv_phase(F, layer); } SEAM(pb + 7);
        if (IN(pb + 8)) {
            pg8::Gemm g{wsp<bf16>(F, WS_ACT), wsp<bf16>(F, WS_WDOWN) + (size_t)layer * D * D_FF, MPAD, D, D_FF}; pg8::StaticOrder S; S.init(MPAD, D, F.G, (int)blockIdx.x);
            EpiF32 E{wsp<float>(F, WS_Y), D};
            pg8::gemm_phase<EpiF32, pg8::StaticOrder, true, true>(F.lds + RING_OFF, g, S, E);
        } SEAM(pb + 8);
        if (IN(pb + 9)) { norm_phase(F, wsp<float>(F, WS_Y), norm_g + (size_t)(layer * 4 + 3) * D, layer == 0 ? norm_g + (size_t)4 * D : nullptr, wsp<bf16>(F, WS_H)); }
        if (layer == 0) SEAM(9);
    }
#undef IN
#undef SEAM
}

#ifndef PH_LO
#define PH_LO 0
#endif
#ifndef PH_HI
#define PH_HI N_PHASES
#endif
extern "C" void kernel_launch(void* const* d_in, const int* in_sizes, int n_in, void* d_out, int out_size, void* d_ws, size_t ws_size, hipStream_t stream) {
    static int grid = 0;
    if (grid == 0) {
        if (n_in != 23 || (size_t)out_size != O_END || ws_size < WS_END) { fprintf(stderr, "kernel_launch: unexpected sizes n_in %d out %d (want %zu) ws %zu (want %zu)\n", n_in, out_size, (size_t)O_END, ws_size, (size_t)WS_END); grid = -1; return; }
        int dev = 0, cus = 0, per_cu = 0;
        if (hipGetDevice(&dev) != hipSuccess || hipDeviceGetAttribute(&cus, hipDeviceAttributeMultiprocessorCount, dev) != hipSuccess) { grid = -1; return; }
        if (hipFuncSetAttribute((const void*)mega_fwd, hipFuncAttributeMaxDynamicSharedMemorySize, LDS_BYTES) != hipSuccess) { fprintf(stderr, "kernel_launch: hipFuncSetAttribute failed\n"); grid = -1; return; }
        if (hipOccupancyMaxActiveBlocksPerMultiprocessor(&per_cu, (const void*)mega_fwd, NTHREADS, LDS_BYTES) != hipSuccess || per_cu < 1) fprintf(stderr, "kernel_launch: occupancy query says %d\n", per_cu);
        (void)hipGetLastError();
        grid = cus;
    }
    if (grid < 0) return;
    (void)hipMemsetAsync((char*)d_ws + WS_CTL, 0, CTL_ZERO_BYTES, stream);
    Args a{};
    for (int i = 0; i < 23; ++i) a.in[i] = (const float*)d_in[i];
    a.out = (float*)d_out; a.ws = (unsigned char*)d_ws; a.ph_lo = PH_LO; a.ph_hi = PH_HI;
    hipLaunchKernelGGL(mega_fwd, dim3(grid), dim3(NTHREADS), LDS_BYTES, stream, a);
}
#ifdef EMU
static void dump_region(const char* dir, const char* name, void* ws, size_t off, size_t bytes) { char p[512]; snprintf(p, sizeof p, "%s/ws_%s.bin", dir, name); FILE* f = fopen(p, "wb"); fwrite((char*)ws + off, 1, bytes, f); fclose(f); }
void emu_dump_ws(const char* dir, void* ws) {
    dump_region(dir, "H", ws, WS_H, (size_t)MPAD * D * 2); dump_region(dir, "Q", ws, WS_Q, (size_t)MPAD * D * 2); dump_region(dir, "KVB", ws, WS_KVB, (size_t)MPAD * D * 2);
    dump_region(dir, "WINB", ws, WS_WINB, (size_t)MPAD * 512 * 2); dump_region(dir, "GATES", ws, WS_GATES, (size_t)MPAD * 48 * 4); dump_region(dir, "AO", ws, WS_AO, (size_t)MPAD * D * 2);
    dump_region(dir, "Y", ws, WS_Y, (size_t)MPAD * D * 4); dump_region(dir, "U", ws, WS_U, (size_t)MPAD * FF2 * 2); dump_region(dir, "ACT", ws, WS_ACT, (size_t)MPAD * D_FF * 2);
    dump_region(dir, "KC", ws, WS_KC, (size_t)32 << 20); dump_region(dir, "MISC", ws, WS_MISC, (size_t)64 << 20);
    dump_region(dir, "MQ", ws, WS_MQ, (size_t)MPAD * 512 * 2); dump_region(dir, "MK", ws, WS_MK, (size_t)MPAD * 512 * 2); dump_region(dir, "MV", ws, WS_MV, (size_t)MPAD * D * 2);
    dump_region(dir, "MO", ws, WS_MO, (size_t)MPAD * D * 2); dump_region(dir, "MG", ws, WS_MG, (size_t)MPAD * 16 * 4);
    dump_region(dir, "WNSAIN", ws, WS_WNSAIN, (size_t)NSA_IN_PAD * D * 2);
    dump_region(dir, "CTL", ws, WS_CTL, 65536);
}
#endif
```

```cpp
#ifndef EMU
#include <hip/hip_runtime.h>
#endif
#include <cstdio>
#include <cstdint>
#ifdef EMU
#define LAS
#define GAS
#define ASMV(...) ((void)0)
#else
#define LAS __attribute__((address_space(3)))
#define GAS __attribute__((address_space(1)))
#define ASMV(...) asm volatile(__VA_ARGS__)
#endif

#ifdef EMU
static inline int lane_id() { return emu_cur->lane; }
#else
__device__ __forceinline__ int lane_id() { unsigned ones = ~0u; asm volatile("" : "+s"(ones)); return (int)__builtin_amdgcn_mbcnt_hi(ones, __builtin_amdgcn_mbcnt_lo(ones, 0u)); }
#endif
#ifdef EMU
static inline int bcast0(int v) { return (int)emu_xchg((unsigned)v, 0); }
#else
__device__ __forceinline__ int bcast0(int v) { return __builtin_amdgcn_readfirstlane(v); }
#endif
#ifdef EMU_CFG_SMALL
#ifndef EMU_DFF
#define EMU_DFF 512
#endif
#ifndef EMU_DECB
#define EMU_DECB 2
#endif
constexpr int BATCH = 1, SEQ = 512, DEC_BATCH = EMU_DECB, PAST_LEN = 512, SEL_TOPK = 4, WINDOW = 128, D_FF = EMU_DFF;
#else
constexpr int BATCH = 4, SEQ = 4096, DEC_BATCH = 32, PAST_LEN = 8192, SEL_TOPK = 16, WINDOW = 512, D_FF = 4096;
#endif
constexpr int DEC_SEQ = 4, PAGE_SIZE = 128, D = 1024, FF2 = 2 * D_FF;
constexpr int MPR = BATCH * SEQ, MSA = DEC_BATCH * DEC_SEQ, MT = MPR + MSA, MPAD = (MT + 255) / 256 * 256;
constexpr int NSA_IN = 2608, NSA_IN_PAD = 2816, ML_IN = 3088, ML_IN_PAD = 3328;
constexpr int N_PAGES = PAST_LEN / PAGE_SIZE, N_USED = DEC_BATCH * N_PAGES, N_PHYS = N_USED + (N_USED / 4 > 1 ? N_USED / 4 : 1);
constexpr int WB_LEN = WINDOW < PAST_LEN ? WINDOW : PAST_LEN, WKEEP = WINDOW < SEQ ? WINDOW : SEQ;
constexpr int NCH_P = SEQ / 16, NC_P = NCH_P - 1, TS = PAST_LEN + DEC_SEQ, NCH_S = TS / 16, NC_S = NCH_S - 1;
constexpr int NSEL_P = SEQ / 64, NSEL_S = (TS + 63) / 64;
constexpr float RMS_EPS = 1e-6f;
constexpr float QSCALE = 0.125f * 1.4426950408889634f;
static_assert(PAST_LEN % 64 == 0 && SEQ % 64 == 0 && DEC_SEQ == 4, "shape assumptions");

constexpr size_t O_Y = 0, O_KV = O_Y + (size_t)MT * D, O_WINP = O_KV + (size_t)MT * D, O_WINS = O_WINP + (size_t)BATCH * WKEEP * 512,
    O_CP = O_WINS + (size_t)DEC_BATCH * WB_LEN * 512, O_CS = O_CP + (size_t)BATCH * 8 * 128 * 64, O_NP = O_CS + (size_t)DEC_BATCH * 8 * 128 * 64,
    O_NS = O_NP + (size_t)BATCH * 8 * 64, O_MP = O_NS + (size_t)DEC_BATCH * 8 * 64, O_MS = O_MP + (size_t)BATCH * 8, O_CVP = O_MS + (size_t)DEC_BATCH * 8,
    O_CVS = O_CVP + (size_t)2 * BATCH * 2 * FF2, O_END = O_CVS + (size_t)2 * DEC_BATCH * 2 * FF2;

constexpr size_t al4k(size_t x) { return (x + 4095) & ~(size_t)4095; }
constexpr size_t WS_CTL = 0, CTL_ZERO_BYTES = 1u << 20;
constexpr size_t WS_WNSAIN = CTL_ZERO_BYTES;
constexpr size_t WS_WNSAOUT = WS_WNSAIN + al4k((size_t)NSA_IN_PAD * D * 2);
constexpr size_t WS_WMLIN = WS_WNSAOUT + al4k((size_t)D * D * 2);
constexpr size_t WS_WMLOUT = WS_WMLIN + al4k((size_t)ML_IN_PAD * D * 2);
constexpr size_t WS_WUP = WS_WMLOUT + al4k((size_t)D * D * 2);
constexpr size_t WS_WDOWN = WS_WUP + al4k((size_t)2 * FF2 * D * 2);
constexpr size_t WS_H = WS_WDOWN + al4k((size_t)2 * D * D_FF * 2);
constexpr size_t WS_Q = WS_H + al4k((size_t)MPAD * D * 2);
constexpr size_t WS_KVB = WS_Q + al4k((size_t)MPAD * D * 2);
constexpr size_t WS_WINB = WS_KVB + al4k((size_t)MPAD * D * 2);
constexpr size_t WS_GATES = WS_WINB + al4k((size_t)MPAD * 512 * 2);
constexpr size_t WS_AO = WS_GATES + al4k((size_t)MPAD * 48 * 4);
constexpr size_t WS_Y = WS_AO + al4k((size_t)MPAD * D * 2);
constexpr size_t WS_U = WS_Y + al4k((size_t)MPAD * D * 4);
constexpr size_t WS_ACT = WS_U + al4k((size_t)MPAD * FF2 * 2);
constexpr size_t WS_KC = WS_ACT + al4k((size_t)MPAD * D_FF * 2);
constexpr size_t KC_P_ELEMS = (size_t)BATCH * 4 * 256 * 64 * (NC_P + 255) / 256 * 1;
constexpr size_t WS_MQ = WS_KC + al4k((size_t)64 << 20);
constexpr size_t WS_MK = WS_MQ + al4k((size_t)MPAD * 512 * 2);
constexpr size_t WS_MV = WS_MK + al4k((size_t)MPAD * 512 * 2);
constexpr size_t WS_MO = WS_MV + al4k((size_t)MPAD * D * 2);
constexpr size_t WS_MG = WS_MO + al4k((size_t)MPAD * D * 2);
constexpr size_t WS_YS = WS_MG + al4k((size_t)MPAD * 16 * 4);
constexpr size_t WS_XS = WS_YS + al4k((size_t)8 * MSA * D * 4);
constexpr size_t WS_UB = WS_XS + al4k((size_t)8 * MPR * 4 * 4) - al4k((size_t)8 * MSA * D * 4) + al4k((size_t)8 * MSA * D * 4);
constexpr size_t WS_MISC = WS_UB + al4k((size_t)(MPR / 256) * 4 * FF2 * 2) - al4k((size_t)8 * MSA * D * 4) + al4k((size_t)8 * MSA * D * 4);
constexpr size_t WS_END = WS_MISC + ((size_t)512 << 20);
constexpr int CW_TMO = 0, CW_BAR = 4096;
namespace pg8 {
typedef unsigned short bf16_t;
typedef short bf16x8 __attribute__((ext_vector_type(8)));
typedef float f32x4 __attribute__((ext_vector_type(4)));
typedef unsigned u32x4 __attribute__((ext_vector_type(4)));
constexpr int BM = 256, BK = 64, HALF = 128, HTB = HALF * BK * 2  , STAGE_BYTES = 8 * HTB, NXCD = 8, WGM = 8;

__host__ __device__ __forceinline__ int lds_byte(int r, int c) { const int st = (r >> 4) * 2 + (c >> 5), rr = r & 15, cc = c & 31, ob = rr * 64 + cc * 2; return st * 1024 + (ob ^ (((ob >> 9) & 1) << 5)); }
__host__ __device__ __forceinline__ void stage_rc(int b, int& R, int& C) { const int st = b / 1024, sb = b % 1024, swz = sb ^ (((sb >> 9) & 1) << 5); R = (st >> 1) * 16 + swz / 64; C = (st & 1) * 32 + (swz % 64) / 2; }
__host__ __device__ __forceinline__ int perm32(int rho) { const int n = rho >> 4, i = rho & 15; return 8 * (i >> 2) + 4 * n + (i & 3); }

struct Unit { int pm, pn; };
struct Gemm { const bf16_t* A; const bf16_t* Bt; int M, N, K; };

struct StaticOrder {
    int nM, nN, nwg, G, c;
    __host__ __device__ void init(int M, int N, int G_, int c_) { nM = M / BM; nN = N / BM; nwg = nM * nN; G = G_; c = c_; }
    __host__ __device__ bool next(int i, Unit& u) const {
        const long L = (long)i * G + c; if (L >= nwg) return false;
        int wgid = (int)L; { const int q = nwg / NXCD, r = nwg % NXCD, xcd = wgid % NXCD, off = wgid / NXCD; wgid = (xcd < r ? xcd * (q + 1) : r * (q + 1) + (xcd - r) * q) + off; }
        const int nig = WGM * nN, gid = wgid / nig, fm = gid * WGM, gsz = (nM - fm) < WGM ? (nM - fm) : WGM;
        u.pm = fm + ((wgid % nig) % gsz); u.pn = (wgid % nig) / gsz; return true;
    }
    __device__ __forceinline__ void a_ready(const Unit&) const {}
    __device__ __forceinline__ void done(const Unit&) const {}
};

#ifdef EMU
__device__ __forceinline__ unsigned cvt_pk_bf16(float lo, float hi) { unsigned a = __builtin_bit_cast(unsigned, lo), b = __builtin_bit_cast(unsigned, hi);
    a = (a + 0x7fffu + ((a >> 16) & 1u)) >> 16; b = (b + 0x7fffu + ((b >> 16) & 1u)) >> 16; return a | (b << 16); }
#else
typedef float cvt_f32x2_t __attribute__((ext_vector_type(2))); typedef __bf16 cvt_bf16x2_t __attribute__((ext_vector_type(2)));
__device__ __forceinline__ unsigned cvt_pk_bf16(float lo, float hi) { const cvt_f32x2_t v = {lo, hi}; const cvt_bf16x2_t b = __builtin_convertvector(v, cvt_bf16x2_t); return __builtin_bit_cast(unsigned, b); }
#endif
template <class Epi, class Sched, bool ALIGN_EPI = false, bool SP2 = false>
__device__ __forceinline__ void gemm_phase(LAS unsigned char* lds, const Gemm g, const Sched& S, const Epi& E, int wave_id) {
    int tid_ = wave_id * 64 + lane_id(); ASMV("" : "+v"(tid_));
    const int tid = tid_, wid = __builtin_amdgcn_readfirstlane(tid >> 6), lane = tid & 63, wr = wid >> 2, wc = wid & 3, fr = lane & 15, fq = lane >> 4;
    const int K = g.K, nt = K / BK;
    unsigned voffA[2], voffB[2];
#pragma unroll
    for (int i = 0; i < 2; ++i) { int R, C; stage_rc(tid * 16 + i * 8192, R, C); const int Rb = Epi::PERM ? ((R & ~31) + perm32(R & 31)) : R;
        voffA[i] = (unsigned)(R * K + C) * 2u; voffB[i] = (unsigned)(Rb * K + C) * 2u; }
    const size_t kstep = (size_t)(BK * 2);
    const size_t hstep = (size_t)HALF * K * 2;
    const size_t tstep = 2 * hstep;
    const unsigned ldsw = (unsigned)wid * 1024u;
    const int aoff = lds_byte(wr * 64 + fr, fq * 8), boff = lds_byte(wc * 32 + fr, fq * 8);
#define PG8_SA(b, h) (((b) * 2 + (h)) * HTB)
#define PG8_SB(b, h) ((4 + (b) * 2 + (h)) * HTB)
#define PG8_STAGE(bufoff, gbase, voff) do { _Pragma("unroll") for (int _i = 0; _i < 2; ++_i) \
        __builtin_amdgcn_global_load_lds((const unsigned*)((const char*)(gbase) + (voff)[_i]), (LAS unsigned*)(lds + (bufoff) + ldsw + _i * 8192), 16, 0, 0); } while (0)
#define PG8_LDA(dst, b, h) do { _Pragma("unroll") for (int m = 0; m < 4; ++m) _Pragma("unroll") for (int k = 0; k < 2; ++k) dst[m][k] = *(const LAS bf16x8*)(lds + PG8_SA(b, h) + aoff + m * 2048 + k * 1024); } while (0)
#define PG8_LDB(dst, b, h) do { _Pragma("unroll") for (int n = 0; n < 2; ++n) _Pragma("unroll") for (int k = 0; k < 2; ++k) dst[n][k] = *(const LAS bf16x8*)(lds + PG8_SB(b, h) + boff + n * 2048 + k * 1024); } while (0)
#define PG8_MMA(ai, bj, At, Bt) do { __builtin_amdgcn_s_setprio(1); _Pragma("unroll") for (int m = 0; m < 4; ++m) _Pragma("unroll") for (int n = 0; n < 2; ++n) _Pragma("unroll") for (int k = 0; k < 2; ++k) \
        acc[ai][bj][m][n] = __builtin_amdgcn_mfma_f32_16x16x32_bf16(Bt[n][k], At[m][k], acc[ai][bj][m][n], 0, 0, 0); __builtin_amdgcn_s_setprio(0); } while (0)
#define PG8_WAIT_V(n) ASMV("s_waitcnt vmcnt(" #n ")" ::: "memory")
#define PG8_WAIT_L(n) ASMV("s_waitcnt lgkmcnt(" #n ")" ::: "memory")
#define PG8_BAR __builtin_amdgcn_s_barrier()
#define PG8_SCHED __builtin_amdgcn_sched_barrier(0)
    Unit cur, nxt; int ui = 0;
    if (!S.next(0, cur)) return;
    f32x4 acc[2][2][4][2];
#pragma unroll
    for (int a = 0; a < 2; ++a)
#pragma unroll
        for (int b = 0; b < 2; ++b)
#pragma unroll
            for (int m = 0; m < 4; ++m)
#pragma unroll
                for (int n = 0; n < 2; ++n) acc[a][b][m][n] = (f32x4){0.f, 0.f, 0.f, 0.f};
    bf16x8 At[4][2], B0[2][2], B1[2][2];
    const char* cA = (const char*)g.A + (size_t)cur.pm * tstep; const char* cB = (const char*)g.Bt + (size_t)cur.pn * tstep;
    S.a_ready(cur);
    if constexpr (SP2) {
        PG8_STAGE(PG8_SB(0, 0), cB, voffB); PG8_STAGE(PG8_SB(0, 1), cB + hstep, voffB); PG8_STAGE(PG8_SA(0, 0), cA, voffA); PG8_STAGE(PG8_SA(0, 1), cA + hstep, voffA);
        if (wr == 1) PG8_BAR;
        PG8_WAIT_V(2); PG8_BAR;
        PG8_STAGE(PG8_SB(1, 0), cB + kstep, voffB); PG8_STAGE(PG8_SA(1, 0), cA + kstep, voffA); PG8_STAGE(PG8_SB(1, 1), cB + hstep + kstep, voffB);
        PG8_WAIT_V(6); PG8_BAR;
    } else {
        PG8_STAGE(PG8_SB(0, 0), cB, voffB); PG8_STAGE(PG8_SA(0, 0), cA, voffA); PG8_STAGE(PG8_SB(0, 1), cB + hstep, voffB); PG8_STAGE(PG8_SA(0, 1), cA + hstep, voffA);
        if (wr == 1) PG8_BAR;
        PG8_WAIT_V(4); PG8_BAR;
        PG8_STAGE(PG8_SB(1, 0), cB + kstep, voffB); PG8_STAGE(PG8_SA(1, 0), cA + kstep, voffA); PG8_STAGE(PG8_SB(1, 1), cB + hstep + kstep, voffB);
        PG8_WAIT_V(6); PG8_BAR;
    }
    for (;;) {
        const bool has_next = S.next(ui + 1, nxt);
        const char* nA = has_next ? (const char*)g.A + (size_t)nxt.pm * tstep : cA; const char* nB = has_next ? (const char*)g.Bt + (size_t)nxt.pn * tstep : cB;
        for (int t = 0; t < nt; t += 2) {
            const bool last = (t == nt - 2);
            const char* a1 = cA + (size_t)(t + 1) * kstep;
            const char* a2 = last ? nA : cA + (size_t)(t + 2) * kstep; const char* b2 = last ? nB : cB + (size_t)(t + 2) * kstep;
            const char* a3 = a2 + kstep; const char* b3 = b2 + kstep;
            if (last && has_next) S.a_ready(nxt);
            if constexpr (SP2) {
            PG8_LDB(B0, 0, 0); PG8_LDB(B1, 0, 1); PG8_SCHED; PG8_LDA(At, 0, 0); PG8_STAGE(PG8_SA(1, 1), a1 + hstep, voffA);
            PG8_WAIT_V(8); PG8_WAIT_L(0); PG8_BAR; PG8_MMA(0, 0, At, B0); PG8_MMA(0, 1, At, B1); PG8_BAR; PG8_SCHED;
            PG8_LDA(At, 0, 1); PG8_STAGE(PG8_SB(0, 0), b2, voffB); PG8_STAGE(PG8_SB(0, 1), b2 + hstep, voffB); PG8_STAGE(PG8_SA(0, 0), a2, voffA);
            PG8_WAIT_V(8); PG8_WAIT_L(0); PG8_BAR; PG8_MMA(1, 0, At, B0); PG8_MMA(1, 1, At, B1); PG8_BAR; PG8_SCHED;
            PG8_LDB(B0, 1, 0); PG8_LDB(B1, 1, 1); PG8_SCHED; PG8_LDA(At, 1, 0); PG8_STAGE(PG8_SA(0, 1), a2 + hstep, voffA);
            PG8_WAIT_V(8); PG8_WAIT_L(0); PG8_BAR; PG8_MMA(0, 0, At, B0); PG8_MMA(0, 1, At, B1); PG8_BAR; PG8_SCHED;
            PG8_LDA(At, 1, 1); PG8_STAGE(PG8_SB(1, 0), b3, voffB); PG8_STAGE(PG8_SB(1, 1), b3 + hstep, voffB); PG8_STAGE(PG8_SA(1, 0), a3, voffA);
            PG8_WAIT_V(8); PG8_WAIT_L(0); PG8_BAR; PG8_MMA(1, 0, At, B0); PG8_MMA(1, 1, At, B1); PG8_BAR; PG8_SCHED;
            } else {
            PG8_LDB(B0, 0, 0); PG8_SCHED; PG8_LDA(At, 0, 0); PG8_STAGE(PG8_SA(1, 1), a1 + hstep, voffA);
            PG8_WAIT_L(8); PG8_BAR; PG8_WAIT_L(0); PG8_MMA(0, 0, At, B0); PG8_BAR; PG8_SCHED;
            PG8_LDB(B1, 0, 1); PG8_STAGE(PG8_SB(0, 0), b2, voffB);
            PG8_BAR; PG8_WAIT_L(0); PG8_MMA(0, 1, At, B1); PG8_BAR;
            PG8_LDA(At, 0, 1); PG8_STAGE(PG8_SA(0, 0), a2, voffA);
            PG8_BAR; PG8_WAIT_L(0); PG8_MMA(1, 0, At, B0); PG8_BAR; PG8_SCHED;
            PG8_STAGE(PG8_SB(0, 1), b2 + hstep, voffB);
            PG8_WAIT_V(6); PG8_BAR; PG8_MMA(1, 1, At, B1); PG8_BAR;
            PG8_LDB(B0, 1, 0); PG8_SCHED; PG8_LDA(At, 1, 0); PG8_STAGE(PG8_SA(0, 1), a2 + hstep, voffA);
            PG8_WAIT_L(8); PG8_BAR; PG8_WAIT_L(0); PG8_MMA(0, 0, At, B0); PG8_BAR; PG8_SCHED;
            PG8_LDB(B1, 1, 1); PG8_STAGE(PG8_SB(1, 0), b3, voffB);
            PG8_BAR; PG8_WAIT_L(0); PG8_MMA(0, 1, At, B1); PG8_BAR;
            PG8_LDA(At, 1, 1); PG8_STAGE(PG8_SA(1, 0), a3, voffA);
            PG8_BAR; PG8_WAIT_L(0); PG8_MMA(1, 0, At, B0); PG8_BAR; PG8_SCHED;
            PG8_STAGE(PG8_SB(1, 1), b3 + hstep, voffB);
            PG8_WAIT_V(6); PG8_BAR; PG8_MMA(1, 1, At, B1); PG8_BAR;
            }
        }
        if constexpr (ALIGN_EPI) { if (wr == 0) PG8_BAR; }
        if constexpr (!Epi::AFTER_DRAIN) { E(acc, cur, wr, wc, fr, fq); S.done(cur); }
        if (!has_next) break;
#pragma unroll
        for (int a = 0; a < 2; ++a)
#pragma unroll
            for (int b = 0; b < 2; ++b)
#pragma unroll
                for (int m = 0; m < 4; ++m)
#pragma unroll
                    for (int n = 0; n < 2; ++n) acc[a][b][m][n] = (f32x4){0.f, 0.f, 0.f, 0.f};
        cur = nxt; cA = nA; cB = nB; ++ui;
        if constexpr (ALIGN_EPI) { if (wr == 1) PG8_BAR; }
    }
    PG8_WAIT_V(0);
    if constexpr (!ALIGN_EPI) { if (wr == 0) PG8_BAR; }
    PG8_BAR;
    if constexpr (Epi::AFTER_DRAIN) { E.fused(acc, cur, wr, wc, fr, fq, lds, wid, lane); S.done(cur); }
#undef PG8_SA
#undef PG8_SB
#undef PG8_STAGE
#undef PG8_LDA
#undef PG8_LDB
#undef PG8_MMA
#undef PG8_WAIT_V
#undef PG8_WAIT_L
#undef PG8_BAR
#undef PG8_SCHED
}
}
typedef unsigned short bf16;
typedef unsigned v4u __attribute__((ext_vector_type(4)));
typedef unsigned v2u __attribute__((ext_vector_type(2)));
typedef float f32x4 __attribute__((ext_vector_type(4)));
typedef float f32x2 __attribute__((ext_vector_type(2)));
typedef float f32x16 __attribute__((ext_vector_type(16)));
typedef short bf16x8 __attribute__((ext_vector_type(8)));
typedef GAS unsigned gu32;
#define RLX_AGENT __ATOMIC_RELAXED, __HIP_MEMORY_SCOPE_AGENT
#ifdef EMU
#define LDS_WAIT() emu_wave_sync()
#else
#define LDS_WAIT() ASMV("s_waitcnt lgkmcnt(0)" ::: "memory")
#endif
#define VM_WAIT() ASMV("s_waitcnt vmcnt(0)" ::: "memory")
using pg8::cvt_pk_bf16;
__device__ __forceinline__ float bf2f(unsigned short h) { return __builtin_bit_cast(float, (unsigned)h << 16); }
__device__ __forceinline__ float bflo(unsigned w) { return __builtin_bit_cast(float, w << 16); }
__device__ __forceinline__ float bfhi(unsigned w) { return __builtin_bit_cast(float, w & 0xffff0000u); }
__device__ __forceinline__ float wave_sum(float v) {
#pragma unroll
    for (int o = 1; o < 64; o <<= 1) v += __shfl_xor(v, o);
    return v;
}
__device__ __forceinline__ float wave_max(float v) {
#pragma unroll
    for (int o = 1; o < 64; o <<= 1) v = fmaxf(v, __shfl_xor(v, o));
    return v;
}
__device__ __forceinline__ float gelu_tanh(float x) {
    constexpr float K1 = -2.0f * 1.4426950408889634f * 0.7978845608028654f, K2 = K1 * 0.044715f;
    const float t = x * __builtin_fmaf(x * x, K2, K1);
    return x * __builtin_amdgcn_rcpf(1.0f + __builtin_amdgcn_exp2f(t));
}
__device__ __forceinline__ float sigmoidf_(float x) { return __builtin_amdgcn_rcpf(1.0f + __builtin_amdgcn_exp2f(-1.4426950408889634f * x)); }
#define XB_TMO      128
#define XB_XCNT(j)  (256  + 64 * (j))
#define XB_XSUB(j)  (1280 + 64 * (j))
#define XB_XGEN(j)  (2304 + 64 * (j))
#define XB_TOP      3328
#define XB_TOPGEN   3392
#define XCD_BAR_WORDS 3456
#define XB_SPIN_CAP (1u << 18)

__device__ __forceinline__ unsigned xb_ld(unsigned* p)              { return __hip_atomic_load(p, __ATOMIC_RELAXED, __HIP_MEMORY_SCOPE_AGENT); }
__device__ __forceinline__ unsigned xb_add(unsigned* p, unsigned v) { return __hip_atomic_fetch_add(p, v, __ATOMIC_RELAXED, __HIP_MEMORY_SCOPE_AGENT); }
__device__ __forceinline__ unsigned xb_xcc_id() { return (unsigned)__builtin_amdgcn_s_getreg((3 << 11) | 20) & 0xFu; }
#define XB_SPIN(cond, bar) do { unsigned _sp = 0; while (cond) { __builtin_amdgcn_s_sleep(1); \
    if ((++_sp & 255u) == 0u) { if (xb_ld(&(bar)[XB_TMO])) break; if (_sp > XB_SPIN_CAP) { atomicAdd(&(bar)[XB_TMO], 1u); break; } } } } while (0)

struct XcdBarrier {
    unsigned* bar; unsigned x; unsigned wv;
    volatile LAS unsigned* st;
};

__device__ __forceinline__ XcdBarrier xcd_barrier_post(unsigned* bar, volatile LAS unsigned* st, unsigned wv) {
    XcdBarrier b; b.bar = bar; b.x = xb_xcc_id(); b.st = st; b.wv = wv;
    if (wv == 0u && lane_id() == 0) (void)xb_add(&bar[XB_XCNT(b.x)], 1u);
    return b;
}
__device__ __forceinline__ void xcd_barrier_complete(unsigned* bar, unsigned x, unsigned& nloc, unsigned& nx) {
    const unsigned G = gridDim.x * gridDim.y * gridDim.z;
    unsigned sum, cnt, mine, sp = 0u;
    for (;;) {
        sum = 0u; cnt = 0u; mine = 0u;
#pragma unroll
        for (unsigned j = 0; j < 16; ++j) { const unsigned c = xb_ld(&bar[XB_XCNT(j)]); sum += c; cnt += (c > 0u) ? 1u : 0u; mine = (j == x) ? c : mine; }
        if (sum == G) break;
        __builtin_amdgcn_s_sleep(1);
        if ((++sp & 255u) == 0u) { if (xb_ld(&bar[XB_TMO])) break; if (sp > XB_SPIN_CAP) { atomicAdd(&bar[XB_TMO], 1u); break; } }
    }
    nloc = mine > 0u ? mine : 1u; nx = cnt > 0u ? cnt : 1u;
}

__device__ __forceinline__ void xcd_barrier(const XcdBarrier& b) {
    ASMV("s_waitcnt vmcnt(0)" ::: "memory");
    __syncthreads();
    if (b.wv == 0u && lane_id() == 0) {
        unsigned* bar = b.bar; unsigned bx_ = b.x;
#ifndef EMU
        { unsigned long long p_ = (unsigned long long)bar; asm volatile("" : "+s"(p_), "+s"(bx_)); bar = (unsigned*)p_; }
#endif
        __builtin_amdgcn_s_waitcnt(0);
        unsigned nloc = b.st[0], nx = b.st[1];
        if (nloc == 0u) { xcd_barrier_complete(bar, bx_, nloc, nx); b.st[0] = nloc; b.st[1] = nx; }
        const unsigned old = xb_add(&bar[XB_XSUB(bx_)], 1u);
        const unsigned gen = old / nloc;
        if (old + 1u == (gen + 1u) * nloc) {
            __builtin_amdgcn_fence(__ATOMIC_RELEASE, "agent");
            ASMV("s_waitcnt vmcnt(0)" ::: "memory");
            const unsigned og = xb_add(&bar[XB_TOP], 1u);
            const unsigned tg = og / nx;
            if (og + 1u == (tg + 1u) * nx) xb_add(&bar[XB_TOPGEN], 1u);
            else XB_SPIN(xb_ld(&bar[XB_TOPGEN]) == tg, bar);
            __builtin_amdgcn_fence(__ATOMIC_ACQUIRE, "agent");
            xb_add(&bar[XB_XGEN(bx_)], 1u);
            ASMV("s_waitcnt vmcnt(0)" ::: "memory");
        } else {
            XB_SPIN(xb_ld(&bar[XB_XGEN(bx_)]) == gen, bar);
            __builtin_amdgcn_fence(__ATOMIC_ACQUIRE, "agent");
            ASMV("s_waitcnt vmcnt(0)" ::: "memory");
        }
    }
    __syncthreads();
}
constexpr int NWAVES = 8, NTHREADS = 512;
constexpr int RING_OFF = 0, RING_BYTES = 147456;
constexpr int LDSCTL_OFF = RING_BYTES, MISC_OFF = LDSCTL_OFF + 320;
constexpr int LDS_BYTES = 149504;
static_assert(MISC_OFF + 128 <= LDS_BYTES, "LDS map");
struct Frame {
    LAS unsigned char* lds;
    volatile LAS unsigned* MISC;
    gu32* ctl;
    int tid, lane, wave, vcu, G;
    const float* const* in;
    float* out;
    unsigned char* ws;
};
#ifdef EMU
#define AS_GLOBAL(T, p) ((T*)(p))
#else
#define AS_GLOBAL(T, p) ((T*)(GAS T*)(p))
#endif
template <class T> __device__ __forceinline__ T* wsp(const Frame& F, size_t off) { return AS_GLOBAL(T, F.ws + off); }
__device__ __forceinline__ const float* inp(const Frame& F, int i) { return AS_GLOBAL(const float, F.in[i]); }
__device__ __forceinline__ float* outp(const Frame& F) { return AS_GLOBAL(float, F.out); }

__device__ __forceinline__ int up_orig_col(int np) { return (np >> 8) * 128 + (np & 127) + ((np >> 7) & 1) * D_FF; }
__device__ __forceinline__ void st_bf16x8(bf16* p, const f32x4& a, const f32x4& b, float s) {
    v4u w; w.x = cvt_pk_bf16(a[0] * s, a[1] * s); w.y = cvt_pk_bf16(a[2] * s, a[3] * s); w.z = cvt_pk_bf16(b[0] * s, b[1] * s); w.w = cvt_pk_bf16(b[2] * s, b[3] * s);
    *(GAS v4u*)p = w;
}
#define EPI_BIG_LOOP \
    __device__ __forceinline__ void operator()(const f32x4 (&acc)[2][2][4][2], const pg8::Unit& u, int wr, int wc, int fr, int fq) const { \
    _Pragma("unroll") for (int ai = 0; ai < 2; ++ai) _Pragma("unroll") for (int m = 0; m < 4; ++m) { const int row = u.pm * 256 + ai * 128 + wr * 64 + m * 16 + fr; if (row < MT) { \
    _Pragma("unroll") for (int bj = 0; bj < 2; ++bj) put(row, u.pn * 256 + bj * 128 + wc * 32 + 8 * fq, u.pn, 0, acc[ai][bj][m][0], acc[ai][bj][m][1]); } } }

struct EpiNsaIn {
    static constexpr bool PERM = true, AFTER_DRAIN = false;
    unsigned char* ws; float* out;
    __device__ __forceinline__ void put(int row, int col, int pn, int ks, const f32x4& v0, const f32x4& v1) const {
            bf16* const Q = AS_GLOBAL(bf16, ws + WS_Q); bf16* const KVB = AS_GLOBAL(bf16, ws + WS_KVB); bf16* const WINB = AS_GLOBAL(bf16, ws + WS_WINB); float* const GATES = AS_GLOBAL(float, ws + WS_GATES);
            if (pn < 4) { st_bf16x8(Q + (size_t)row * 1024 + col, v0, v1, QSCALE); }
            else if (pn < 8) { const int c = col - 1024; st_bf16x8(KVB + (size_t)row * 1024 + c, v0, v1, 1.f);
                float* o = AS_GLOBAL(float, out) + O_KV + (size_t)row * 1024 + c; *(GAS f32x4*)o = v0; *(GAS f32x4*)(o + 4) = v1; }
            else if (pn < 10) { const int c = col - 2048; st_bf16x8(WINB + (size_t)row * 512 + c, v0, v1, 1.f);
                float* o = nullptr;
                if (row < MPR) { const int b = row / SEQ, t = row % SEQ; if (t >= SEQ - WKEEP) o = AS_GLOBAL(float, out) + O_WINP + ((size_t)b * WKEEP + (t - (SEQ - WKEEP))) * 512 + c; }
                else { const int r = row - MPR, b = r / DEC_SEQ, t = r % DEC_SEQ; o = AS_GLOBAL(float, out) + O_WINS + ((size_t)b * WB_LEN + (WB_LEN - DEC_SEQ + t)) * 512 + c; }
                if (o) { *(GAS f32x4*)o = v0; *(GAS f32x4*)(o + 4) = v1; } }
            else { const int c = col - 2560; if (c < 48) { float* o = GATES + (size_t)row * 48 + c; *(GAS f32x4*)o = v0; *(GAS f32x4*)(o + 4) = v1; } }
            }
    EPI_BIG_LOOP
};
struct EpiF32 {
    static constexpr bool PERM = true, AFTER_DRAIN = false;
    unsigned char* ws;
    __device__ __forceinline__ void put(int row, int col, int pn, int ks, const f32x4& v0, const f32x4& v1) const {
            float* const Y = AS_GLOBAL(float, ws + WS_Y); float* const YS = AS_GLOBAL(float, ws + WS_YS); constexpr int ldc = D;
            float* o = row < MPR ? Y + (size_t)row * ldc + col : YS + ((size_t)ks * MSA + (row - MPR)) * ldc + col; *(GAS f32x4*)o = v0; *(GAS f32x4*)(o + 4) = v1;
            }
    EPI_BIG_LOOP
};
constexpr int UPX_OFF = 131072;
constexpr int UPT_OFF = UPX_OFF + 4 * 2 * 256 * 4;
static_assert(UPT_OFF + 4 * 256 * 4 <= RING_BYTES && pg8::STAGE_BYTES <= UPX_OFF, "exchange region");
template <int N> __device__ __forceinline__ f32x4 ror4(const f32x4& v) {
    f32x4 r;
#pragma unroll
    for (int e = 0; e < 4; ++e) { const float x = v[e]; r[e] = __builtin_bit_cast(float, __builtin_amdgcn_update_dpp(0, __builtin_bit_cast(int, x), 0x120 + N, 0xf, 0xf, false)); }
    return r; }
__device__ __forceinline__ f32x4 shfl4(const f32x4& v, int src) { f32x4 r; r[0] = __shfl(v[0], src); r[1] = __shfl(v[1], src); r[2] = __shfl(v[2], src); r[3] = __shfl(v[3], src); return r; }
struct EpiUpConv {
    static constexpr bool PERM = true, AFTER_DRAIN = false;
    unsigned char* ws; float* out; const float* const* in; int layer; LAS float* exch;
    __device__ __forceinline__ void st4(bf16* p, const f32x4& v) const { v2u w; w.x = cvt_pk_bf16(v[0], v[1]); w.y = cvt_pk_bf16(v[2], v[3]); *(GAS v2u*)p = w; }
    __device__ __forceinline__ void put(int row, int col, int pn, int ks, const f32x4& v0, const f32x4& v1) const {
        bf16* const U = AS_GLOBAL(bf16, ws + WS_U); const int oc = up_orig_col(col), r = row - MPR, b = r / DEC_SEQ, t = r % DEC_SEQ;
        st4(U + (size_t)row * FF2 + oc, v0); st4(U + (size_t)row * FF2 + oc + 4, v1);
        if (t >= DEC_SEQ - 2) { float* o = AS_GLOBAL(float, out) + O_CVS + (((size_t)layer * DEC_BATCH + b) * 2 + (t - (DEC_SEQ - 2))) * FF2 + oc; *(GAS f32x4*)o = v0; *(GAS f32x4*)(o + 4) = v1; }
    }
    __device__ __forceinline__ void operator()(const f32x4 (&acc)[2][2][4][2], const pg8::Unit& u, int wr, int wc, int fr, int fq) const {
        const int lane = fq * 16 + fr, gcol0 = 128 * u.pn + 32 * wc + 8 * fq;
        bf16* const ACT = AS_GLOBAL(bf16, ws + WS_ACT); bf16* const U = AS_GLOBAL(bf16, ws + WS_U); bf16* const UB = AS_GLOBAL(bf16, ws + WS_UB);
        if (u.pm >= MPR / 256) {
#pragma unroll
            for (int ai = 0; ai < 2; ++ai)
#pragma unroll
                for (int m = 0; m < 4; ++m) { const int row = u.pm * 256 + ai * 128 + wr * 64 + m * 16 + fr; if (row < MT) { const int r = row - MPR, b = r / DEC_SEQ, t = r % DEC_SEQ;
#pragma unroll
                    for (int bj = 0; bj < 2; ++bj)
#pragma unroll
                        for (int n = 0; n < 2; ++n) { const int col = bj * D_FF + gcol0 + 4 * n; st4(U + (size_t)row * FF2 + col, acc[ai][bj][m][n]);
                            if (t >= DEC_SEQ - 2) *(GAS f32x4*)(AS_GLOBAL(float, out) + O_CVS + (((size_t)layer * DEC_BATCH + b) * 2 + (t - (DEC_SEQ - 2))) * FF2 + col) = acc[ai][bj][m][n]; } } }
            return;
        }
        LAS float* taps = exch + 4 * 2 * 256;
        { const int tid = (wr * 4 + wc) * 64 + lane, ci = tid & 255, hf = tid >> 8, oc = (ci >> 7) * D_FF + 128 * u.pn + (ci & 127);
          const float* cw = AS_GLOBAL(const float, in[20]) + (size_t)layer * 3 * FF2; const float* cb = AS_GLOBAL(const float, in[21]) + (size_t)layer * FF2;
          taps[(2 * hf) * 256 + ci] = hf ? cw[2 * FF2 + oc] : cw[oc]; taps[(2 * hf + 1) * 256 + ci] = hf ? cb[oc] : cw[FF2 + oc]; }
        if (fr >= 14) {
#pragma unroll
            for (int ai = 0; ai < 2; ++ai)
#pragma unroll
                for (int bj = 0; bj < 2; ++bj)
#pragma unroll
                    for (int n = 0; n < 2; ++n) *(LAS f32x4*)(exch + ((ai * 2 + wr) * 2 + (fr - 14)) * 256 + 128 * bj + 32 * wc + 8 * fq + 4 * n) = acc[ai][bj][3][n]; }
        LDS_WAIT(); __builtin_amdgcn_s_barrier(); ASMV("" ::: "memory");
        const int s1 = (lane & 48) | ((lane - 1) & 15), s2 = (lane & 48) | ((lane - 2) & 15);
        constexpr int TPS = SEQ / 256;
        const bool seq_last = (u.pm % TPS) == TPS - 1; const int bseq = u.pm / TPS;
#pragma unroll
        for (int n = 0; n < 2; ++n) {
            f32x4 w0[2], w1[2], w2[2], bb[2];
#pragma unroll
            for (int bj = 0; bj < 2; ++bj) { const LAS float* tp = taps + 128 * bj + 32 * wc + 8 * fq + 4 * n; w0[bj] = *(const LAS f32x4*)tp; w1[bj] = *(const LAS f32x4*)(tp + 256); w2[bj] = *(const LAS f32x4*)(tp + 512); bb[bj] = *(const LAS f32x4*)(tp + 768); }
#pragma unroll
            for (int ai = 0; ai < 2; ++ai) {
                const int gp = ai * 2 + wr - 1; f32x4 h62[2], h63[2];
#pragma unroll
                for (int bj = 0; bj < 2; ++bj) { const int gpc = gp < 0 ? 0 : gp; const LAS float* hp = exch + (gpc * 2) * 256 + 128 * bj + 32 * wc + 8 * fq + 4 * n; h62[bj] = *(const LAS f32x4*)hp; h63[bj] = *(const LAS f32x4*)(hp + 256); }
#pragma unroll
                for (int m = 0; m < 4; ++m) { f32x4 c[2];
#pragma unroll
                    for (int bj = 0; bj < 2; ++bj) { const f32x4 cur = acc[ai][bj][m][n];
                        f32x4 p1, p2; if (m == 0) { p1 = h63[bj]; p2 = fr == 14 ? h62[bj] : h63[bj]; } else { p1 = acc[ai][bj][m > 0 ? m - 1 : 0][n]; p2 = p1; }
                        const f32x4 x1 = shfl4(fr == 15 ? p1 : cur, s1), x2 = shfl4(fr >= 14 ? p2 : cur, s2);
                        c[bj] = bb[bj] + w0[bj] * x2 + w1[bj] * x1 + w2[bj] * cur; }
                    const int row = u.pm * 256 + ai * 128 + wr * 64 + m * 16 + fr;
                    if (!(gp < 0 && m == 0 && fr < 2)) { f32x4 a; a[0] = gelu_tanh(c[0][0]) * c[1][0]; a[1] = gelu_tanh(c[0][1]) * c[1][1]; a[2] = gelu_tanh(c[0][2]) * c[1][2]; a[3] = gelu_tanh(c[0][3]) * c[1][3];
                        st4(ACT + (size_t)row * D_FF + gcol0 + 4 * n, a); }
                }
            }
            __builtin_amdgcn_sched_barrier(0);
#pragma unroll
            for (int bj = 0; bj < 2; ++bj) { const int col = bj * D_FF + gcol0 + 4 * n;
                if (wr == 0 && fr < 2) st4(UB + ((size_t)u.pm * 4 + fr) * FF2 + col, acc[0][bj][0][n]);
                if (wr == 1 && fr >= 14) { st4(UB + ((size_t)u.pm * 4 + 2 + (fr - 14)) * FF2 + col, acc[1][bj][3][n]);
                    if (seq_last) *(GAS f32x4*)(AS_GLOBAL(float, out) + O_CVP + (((size_t)layer * BATCH + bseq) * 2 + (fr - 14)) * FF2 + col) = acc[1][bj][3][n]; } }
            __builtin_amdgcn_sched_barrier(0);
        }
    }
};
struct EpiMlIn {
    static constexpr bool PERM = true, AFTER_DRAIN = false;
    unsigned char* ws;
    __device__ __forceinline__ void put(int row, int col, int pn, int ks, const f32x4& v0, const f32x4& v1) const {
            bf16* const MQ = AS_GLOBAL(bf16, ws + WS_MQ); bf16* const MK = AS_GLOBAL(bf16, ws + WS_MK); bf16* const MV = AS_GLOBAL(bf16, ws + WS_MV); bf16* const MO = AS_GLOBAL(bf16, ws + WS_MO); float* const MG = AS_GLOBAL(float, ws + WS_MG);
            if (pn < 2) st_bf16x8(MQ + (size_t)row * 512 + col, v0, v1, 1.f);
            else if (pn < 4) st_bf16x8(MK + (size_t)row * 512 + (col - 512), v0, v1, 0.125f);
            else if (pn < 8) st_bf16x8(MV + (size_t)row * 1024 + (col - 1024), v0, v1, 1.f);
            else if (pn < 12) st_bf16x8(MO + (size_t)row * 1024 + (col - 2048), v0, v1, 1.f);
            else { const int c = col - 3072; if (c < 16) { float* o = MG + (size_t)row * 16 + c; *(GAS f32x4*)o = v0; *(GAS f32x4*)(o + 4) = v1; } }
            }
    EPI_BIG_LOOP
};

constexpr int CW_PAN = 16384;
struct EpiRmsRes {
    static constexpr bool PERM = true, AFTER_DRAIN = true;
    unsigned char* ws; float* out; const float* ga; const float* gb; gu32* ctl; int site;
    __device__ __forceinline__ bool stats(const f32x4 (&v)[2][2][4][2], const pg8::Unit& u, int wr, int wc, int fr, int fq, LAS unsigned char* lds, int wid, int lane, int e) const {
        LAS float* P = (LAS float*)lds; LAS float* S = (LAS float*)(lds + 4096); LAS unsigned* flag = (LAS unsigned*)(lds + 4096 + 1024);
        GAS float* slots = (GAS float*)AS_GLOBAL(float, ws + WS_XS) + (size_t)(site * 2 + e) * MPR * 4; gu32* cnt = ctl + CW_PAN + ((site * 2 + e) * 64 + u.pm) * 64;
#pragma unroll
        for (int ai = 0; ai < 2; ++ai)
#pragma unroll
            for (int m = 0; m < 4; ++m) { float q = 0.f;
#pragma unroll
                for (int bj = 0; bj < 2; ++bj)
#pragma unroll
                    for (int n = 0; n < 2; ++n) { const f32x4 x = v[ai][bj][m][n]; q += (x[0] * x[0] + x[1] * x[1]) + (x[2] * x[2] + x[3] * x[3]); }
                q += __shfl_xor(q, 16); q += __shfl_xor(q, 32);
                if (fq == 0) P[(ai * 128 + wr * 64 + m * 16 + fr) * 4 + wc] = q; }
        LDS_WAIT(); __builtin_amdgcn_s_barrier(); ASMV("" ::: "memory");
        const int row = wid * 32 + (lane & 31);
        if (lane < 32) { const float tot = (P[row * 4] + P[row * 4 + 1]) + (P[row * 4 + 2] + P[row * 4 + 3]);
            __hip_atomic_store((GAS unsigned*)(slots + ((size_t)u.pm * 256 + row) * 4 + u.pn), __builtin_bit_cast(unsigned, tot), __ATOMIC_RELAXED, __HIP_MEMORY_SCOPE_AGENT); }
        ASMV("s_waitcnt vmcnt(0)" ::: "memory");
        if (lane == 0) __hip_atomic_fetch_add(cnt, 1u, __ATOMIC_RELAXED, __HIP_MEMORY_SCOPE_AGENT);
        if (wid == 0) { bool dead = false; unsigned spins = 0;
            for (;;) { if ((unsigned)__builtin_amdgcn_readfirstlane((int)__hip_atomic_load(cnt, __ATOMIC_RELAXED, __HIP_MEMORY_SCOPE_AGENT)) >= 32u) break;
                if (++spins > (1u << 22)) { if (lane == 0) __hip_atomic_store(ctl + CW_TMO, 1u, __ATOMIC_RELAXED, __HIP_MEMORY_SCOPE_AGENT); dead = true; break; }
                __builtin_amdgcn_s_sleep(2); }
            __builtin_amdgcn_fence(__ATOMIC_ACQUIRE, "agent");
            if (lane == 0) flag[0] = dead ? 1u : 0u; }
        ASMV("s_waitcnt vmcnt(0) lgkmcnt(0)" ::: "memory"); LDS_WAIT(); __builtin_amdgcn_s_barrier(); ASMV("" ::: "memory");
        const bool bad = flag[0] != 0u;
        if (lane < 32) { const GAS unsigned* sp = (const GAS unsigned*)(slots + ((size_t)u.pm * 256 + row) * 4); float q = 0.f;
#pragma unroll
            for (int t = 0; t < 4; ++t) q += __builtin_bit_cast(float, __hip_atomic_load(sp + t, __ATOMIC_RELAXED, __HIP_MEMORY_SCOPE_AGENT));
            S[row] = 1.0f / sqrtf(q * (1.0f / D) + RMS_EPS); }
        LDS_WAIT(); __builtin_amdgcn_s_barrier(); ASMV("" ::: "memory");
        return bad;
    }
    __device__ __forceinline__ void fused(f32x4 (&acc)[2][2][4][2], const pg8::Unit& u, int wr, int wc, int fr, int fq, LAS unsigned char* lds, int wid, int lane) const {
        const LAS float* S = (const LAS float*)(lds + 4096); const int col0 = u.pn * 256 + wc * 32 + 8 * fq;
        GAS float* xres = (GAS float*)AS_GLOBAL(float, out) + O_Y; const float qnan = __builtin_nanf("");
        bool bad = stats(acc, u, wr, wc, fr, fq, lds, wid, lane, 0);
        f32x4 g[2][2];
#pragma unroll
        for (int bj = 0; bj < 2; ++bj)
#pragma unroll
            for (int n = 0; n < 2; ++n) g[bj][n] = *(const GAS f32x4*)(ga + col0 + bj * 128 + 4 * n);
#pragma unroll
        for (int ai = 0; ai < 2; ++ai)
#pragma unroll
            for (int m = 0; m < 4; ++m) { const int r = ai * 128 + wr * 64 + m * 16 + fr; const float rs = S[r]; GAS float* xp = xres + (size_t)(u.pm * 256 + r) * D + col0;
#pragma unroll
                for (int bj = 0; bj < 2; ++bj)
#pragma unroll
                    for (int n = 0; n < 2; ++n) { const f32x4 x = *(const GAS f32x4*)(xp + bj * 128 + 4 * n); f32x4 o = x + acc[ai][bj][m][n] * rs * g[bj][n];
                        if (bad) o = (f32x4){qnan, qnan, qnan, qnan}; acc[ai][bj][m][n] = o; if (!gb) *(GAS f32x4*)(xp + bj * 128 + 4 * n) = o; }
                ASMV("" : "+v"(acc[ai][0][m][0]), "+v"(acc[ai][0][m][1]), "+v"(acc[ai][1][m][0]), "+v"(acc[ai][1][m][1]));
                if (m & 1) ASMV("" ::: "memory"); }
        if (!gb) return;
        bad = stats(acc, u, wr, wc, fr, fq, lds, wid, lane, 1) || bad;
#pragma unroll
        for (int bj = 0; bj < 2; ++bj)
#pragma unroll
            for (int n = 0; n < 2; ++n) g[bj][n] = *(const GAS f32x4*)(gb + col0 + bj * 128 + 4 * n);
        GAS bf16* H = (GAS bf16*)AS_GLOBAL(bf16, ws + WS_H);
#pragma unroll
        for (int ai = 0; ai < 2; ++ai)
#pragma unroll
            for (int m = 0; m < 4; ++m) { const int r = ai * 128 + wr * 64 + m * 16 + fr; const float rs = bad ? qnan : S[r]; const size_t ro = (size_t)(u.pm * 256 + r) * D + col0;
#pragma unroll
                for (int bj = 0; bj < 2; ++bj) { const f32x4 a = acc[ai][bj][m][0], b = acc[ai][bj][m][1];
                    *(GAS f32x4*)(xres + ro + bj * 128) = a; *(GAS f32x4*)(xres + ro + bj * 128 + 4) = b;
                    const f32x4 ha = a * rs * g[bj][0], hb = b * rs * g[bj][1]; v4u w; w.x = cvt_pk_bf16(ha[0], ha[1]); w.y = cvt_pk_bf16(ha[2], ha[3]); w.z = cvt_pk_bf16(hb[0], hb[1]); w.w = cvt_pk_bf16(hb[2], hb[3]);
                    *(GAS v4u*)(H + ro + bj * 128) = w; }
                ASMV("" ::: "memory"); }
    }
    __device__ __forceinline__ void put(int row, int col, int pn, int ks, const f32x4& v0, const f32x4& v1) const {
        float* o = AS_GLOBAL(float, ws + WS_YS) + ((size_t)ks * MSA + (row - MPR)) * D + col; *(GAS f32x4*)o = v0; *(GAS f32x4*)(o + 4) = v1; }
};
template <class Epi> __device__ __forceinline__ void mini_gemm(const Frame& F, const bf16* A, const bf16* Bt, int row_lo, int nrows, int col_lo, int ncols, int K, int ksplit, const Epi& E) {
    const int lane = F.lane, fr = lane & 15, fq = lane >> 4, gw = F.vcu * NWAVES + F.wave, NGW = F.G * NWAVES;
    const int nct = ncols / 32, nrt = (nrows + 15) / 16, ntile = nrt * nct, klen = K / ksplit;
    for (int un = gw; un < ntile * ksplit; un += NGW) {
        const int ks = un / ntile, t = un % ntile, rt = t / nct, ct = t % nct, row = row_lo + rt * 16 + fr, colb = col_lo + ct * 32;
        const GAS bf16* ap = (const GAS bf16*)A + (size_t)(row < row_lo + nrows ? row : row_lo) * K + ks * klen + fq * 8;
        const GAS bf16* bp0 = (const GAS bf16*)Bt + (size_t)(colb + 8 * (fr >> 2) + (fr & 3)) * K + ks * klen + fq * 8; const GAS bf16* bp1 = bp0 + (size_t)4 * K;
        f32x4 acc0 = (f32x4){0.f, 0.f, 0.f, 0.f}, acc1 = acc0;
        for (int k0 = 0; k0 < klen; k0 += 256) {
            bf16x8 a[8], b0[8], b1[8];
#pragma unroll
            for (int i = 0; i < 8; ++i) { a[i] = *(const GAS bf16x8*)(ap + k0 + 32 * i); b0[i] = *(const GAS bf16x8*)(bp0 + k0 + 32 * i); b1[i] = *(const GAS bf16x8*)(bp1 + k0 + 32 * i); }
#pragma unroll
            for (int i = 0; i < 8; ++i) { acc0 = __builtin_amdgcn_mfma_f32_16x16x32_bf16(b0[i], a[i], acc0, 0, 0, 0); acc1 = __builtin_amdgcn_mfma_f32_16x16x32_bf16(b1[i], a[i], acc1, 0, 0, 0); }
        }
        if (row < row_lo + nrows) E.put(row, colb + 8 * fq, colb >> 8, ks, acc0, acc1);
    }
}
__device__ __forceinline__ void transpose_item(const float* W, int K, int N, int Npad, bf16* WT, LAS float* scr, int item, int lane, bool upmap = false) {
    const int nblk = Npad / 32, kb = item / nblk, nb = item % nblk, k0 = 64 * kb, n0 = 32 * nb;
    const int nn = (upmap ? up_orig_col(n0) : n0) + (lane & 31);
#pragma unroll
    for (int hb = 0; hb < 2; ++hb) { float tv[16];
#pragma unroll
        for (int i = 0; i < 16; ++i) { const int kk = 2 * (16 * hb + i) + (lane >> 5); tv[i] = nn < N ? ((const GAS float*)W)[(size_t)(k0 + kk) * N + nn] : 0.f; }
#pragma unroll
        for (int i = 0; i < 16; ++i) scr[(2 * (16 * hb + i) + (lane >> 5)) * 33 + (lane & 31)] = tv[i]; }
    LDS_WAIT(); ASMV("" ::: "memory");
    const int c = lane & 7;
#pragma unroll
    for (int j = 0; j < 4; ++j) { const int n = (lane >> 3) + 8 * j; const LAS float* s = scr + (8 * c) * 33 + n;
        v4u o; o.x = cvt_pk_bf16(s[0 * 33], s[1 * 33]); o.y = cvt_pk_bf16(s[2 * 33], s[3 * 33]); o.z = cvt_pk_bf16(s[4 * 33], s[5 * 33]); o.w = cvt_pk_bf16(s[6 * 33], s[7 * 33]);
        *(GAS v4u*)(WT + (size_t)(n0 + n) * K + k0 + 8 * c) = o; }
    LDS_WAIT(); ASMV("" ::: "memory");
}
__device__ __forceinline__ const float* x_in_row(const Frame& F, int m) { return m < MPR ? inp(F, 0) + (size_t)m * D : inp(F, 1) + (size_t)(m - MPR) * D; }
__device__ __forceinline__ void rms_rows2_to_bf16(const Frame& F, int m0, int m1, bool two, const float* g) {
    typedef const GAS f32x4* gcp; const int mm[2] = {m0, two ? m1 : m0}; f32x4 v[2][4];
#pragma unroll
    for (int q = 0; q < 2; ++q) { gcp xr = (gcp)x_in_row(F, mm[q]) + F.lane;
#pragma unroll
        for (int j = 0; j < 4; ++j) v[q][j] = xr[64 * j]; }
#pragma unroll
    for (int q = 0; q < 2; ++q) { if (q == 1 && !two) break; const int m = mm[q]; float s = 0.f;
#pragma unroll
        for (int j = 0; j < 4; ++j) s += (v[q][j].x * v[q][j].x + v[q][j].y * v[q][j].y) + (v[q][j].z * v[q][j].z + v[q][j].w * v[q][j].w);
        const float rstd = 1.f / sqrtf(wave_sum(s) * (1.f / D) + RMS_EPS);
        GAS v2u* o8 = (GAS v2u*)(wsp<bf16>(F, WS_H) + (size_t)m * D) + F.lane; GAS f32x4* xc = (GAS f32x4*)(outp(F) + O_Y + (size_t)m * D) + F.lane;
#pragma unroll
        for (int j = 0; j < 4; ++j) { const f32x4 gg = ((gcp)g + F.lane)[64 * j]; xc[64 * j] = v[q][j];
            v2u w; w.x = cvt_pk_bf16(v[q][j].x * rstd * gg.x, v[q][j].y * rstd * gg.y); w.y = cvt_pk_bf16(v[q][j].z * rstd * gg.z, v[q][j].w * rstd * gg.w); o8[64 * j] = w; } }
}
__device__ __forceinline__ void p0_prologue(Frame& F) {
    LAS float* scr = (LAS float*)(F.lds + RING_OFF + F.wave * 16384);
    const int gw = F.vcu * NWAVES + F.wave, NGW = F.G * NWAVES;
    constexpr int I_NI = (D / 64) * (NSA_IN_PAD / 32), I_DD = (D / 64) * (D / 32), I_MI = (D / 64) * (ML_IN_PAD / 32), I_UP = (D / 64) * (FF2 / 32), I_DN = (D_FF / 64) * (D / 32);
    constexpr int NITEMS = I_NI + 2 * I_DD + I_MI + 2 * I_UP + 2 * I_DN;
    for (int it = gw; it < NITEMS; it += NGW) {
        int r = it;
        if (r < I_NI) { transpose_item(inp(F, 10), D, NSA_IN, NSA_IN_PAD, wsp<bf16>(F, WS_WNSAIN), scr, r, F.lane); continue; } r -= I_NI;
        if (r < I_DD) { transpose_item(inp(F, 11), D, D, D, wsp<bf16>(F, WS_WNSAOUT), scr, r, F.lane); continue; } r -= I_DD;
        if (r < I_MI) { transpose_item(inp(F, 15), D, ML_IN, ML_IN_PAD, wsp<bf16>(F, WS_WMLIN), scr, r, F.lane); continue; } r -= I_MI;
        if (r < I_DD) { transpose_item(inp(F, 18), D, D, D, wsp<bf16>(F, WS_WMLOUT), scr, r, F.lane); continue; } r -= I_DD;
        if (r < 2 * I_UP) { const int l = r / I_UP; transpose_item(inp(F, 19) + (size_t)l * D * FF2, D, FF2, FF2, wsp<bf16>(F, WS_WUP) + (size_t)l * FF2 * D, scr, r % I_UP, F.lane, true); continue; } r -= 2 * I_UP;
        { const int l = r / I_DN; transpose_item(inp(F, 22) + (size_t)l * D_FF * D, D_FF, D, D, wsp<bf16>(F, WS_WDOWN) + (size_t)l * D * D_FF, scr, r % I_DN, F.lane); }
    }
    for (int m = gw; m < MT; m += 2 * NGW) rms_rows2_to_bf16(F, m, m + NGW, m + NGW < MT, inp(F, 9));
    { const size_t per_b = (size_t)(WB_LEN - DEC_SEQ) * 512 / 4, total = per_b * DEC_BATCH;
      for (size_t i = (size_t)blockIdx.x * NTHREADS + F.tid; i < total; i += (size_t)F.G * NTHREADS) { const size_t b = i / per_b, r = i % per_b;
          ((f32x4*)(outp(F) + O_WINS + b * WB_LEN * 512))[r] = ((const f32x4*)(inp(F, 3) + b * WB_LEN * 512 + DEC_SEQ * 512))[r]; } }
}
constexpr int NSN = (MSA + NWAVES - 1) / NWAVES, CW_SN = 60000;
__device__ __forceinline__ void norm_phase(Frame& F, int row_lo, const float* Y, const float* YS, int ksplit, const float* ga, const float* gb, bf16* H, gu32* gate = nullptr, int wg_base = 0) {
    const int vrel = (int)blockIdx.x - wg_base;
    if (gate && (vrel < 0 || vrel >= NSN)) return;
    const int gw = row_lo + (gate ? vrel : F.vcu) * NWAVES + F.wave, NGW = (gate ? NSN : F.G) * NWAVES;
    typedef const GAS f32x4* gcp; typedef GAS f32x4* gp4;
    f32x4 gA[4], gB[4];
#pragma unroll
    for (int j = 0; j < 4; ++j) { gA[j] = ((gcp)ga + F.lane)[64 * j]; gB[j] = gb ? ((gcp)gb + F.lane)[64 * j] : (f32x4){0.f, 0.f, 0.f, 0.f}; }
    for (int m0 = gw; m0 < MT; m0 += 2 * NGW) {
        const int m1 = m0 + NGW; const bool two = m1 < MT; const int mm[2] = {m0, two ? m1 : m0};
        f32x4 y[2][4], x[2][4];
#pragma unroll
        for (int q = 0; q < 2; ++q) { const int m = mm[q]; gcp yr = (gcp)(Y + (size_t)m * D) + F.lane; gcp xr = (gcp)(outp(F) + O_Y + (size_t)m * D) + F.lane;
#pragma unroll
            for (int j = 0; j < 4; ++j) { y[q][j] = yr[64 * j]; x[q][j] = xr[64 * j]; } }
#pragma unroll
        for (int q = 0; q < 2; ++q) { const int m = mm[q];
            if (m >= MPR) {
#pragma unroll
                for (int j = 0; j < 4; ++j) { y[q][j] = (f32x4){0.f, 0.f, 0.f, 0.f}; for (int k = 0; k < ksplit; ++k) y[q][j] = y[q][j] + ((gcp)(YS + ((size_t)k * MSA + (m - MPR)) * D) + F.lane)[64 * j]; } } }
#pragma unroll
        for (int q = 0; q < 2; ++q) { const int m = mm[q]; if (q == 1 && !two) break;
            float s = 0.f;
#pragma unroll
            for (int j = 0; j < 4; ++j) s += (y[q][j].x * y[q][j].x + y[q][j].y * y[q][j].y) + (y[q][j].z * y[q][j].z + y[q][j].w * y[q][j].w);
            const float r1 = 1.f / sqrtf(wave_sum(s) * (1.f / D) + RMS_EPS); float s2 = 0.f; gp4 xw = (gp4)(outp(F) + O_Y + (size_t)m * D) + F.lane;
#pragma unroll
            for (int j = 0; j < 4; ++j) { x[q][j] = x[q][j] + y[q][j] * r1 * gA[j]; xw[64 * j] = x[q][j];
                s2 += (x[q][j].x * x[q][j].x + x[q][j].y * x[q][j].y) + (x[q][j].z * x[q][j].z + x[q][j].w * x[q][j].w); }
            if (gb) { const float r2 = 1.f / sqrtf(wave_sum(s2) * (1.f / D) + RMS_EPS); GAS v2u* o8 = (GAS v2u*)(H + (size_t)m * D) + F.lane;
#pragma unroll
                for (int j = 0; j < 4; ++j) { v2u w; w.x = cvt_pk_bf16(x[q][j].x * r2 * gB[j].x, x[q][j].y * r2 * gB[j].y); w.y = cvt_pk_bf16(x[q][j].z * r2 * gB[j].z, x[q][j].w * r2 * gB[j].w);
                    if (gate) __hip_atomic_store((GAS unsigned long long*)(o8 + 64 * j), ((unsigned long long)w.y << 32) | w.x, __ATOMIC_RELAXED, __HIP_MEMORY_SCOPE_AGENT); else o8[64 * j] = w; } }
        }
        if (gate) { ASMV("s_waitcnt vmcnt(0)" ::: "memory"); if (F.lane == 0) __hip_atomic_fetch_add(gate, two ? 2u : 1u, __ATOMIC_RELAXED, __HIP_MEMORY_SCOPE_AGENT); }
    }
}
struct GatedOrder : pg8::StaticOrder {
    gu32* gate; gu32* tmo;
    __device__ __forceinline__ void a_ready(const pg8::Unit& u) const {
        if (u.pm == MPR / 256) { unsigned spins = 0;
            while (__hip_atomic_load(gate, __ATOMIC_RELAXED, __HIP_MEMORY_SCOPE_AGENT) < (unsigned)MSA) { __builtin_amdgcn_s_sleep(2); if (++spins > (1u << 22)) { __hip_atomic_store(tmo, 1u, __ATOMIC_RELAXED, __HIP_MEMORY_SCOPE_AGENT); break; } }
            __builtin_amdgcn_fence(__ATOMIC_ACQUIRE, "agent"); } }
};
__device__ __forceinline__ void conv_fix_phase(Frame& F, int layer) {
    constexpr int NCB = D_FF / 512, NPT = MPR / 256, TPS = SEQ / 256, UNITS_P = NPT * NCB, UNITS_S = DEC_BATCH * NCB;
    const bf16* U = wsp<bf16>(F, WS_U); const bf16* UB = wsp<bf16>(F, WS_UB); bf16* ACT = wsp<bf16>(F, WS_ACT);
    const float* cw = inp(F, 20) + (size_t)layer * 3 * FF2; const float* cb = inp(F, 21) + (size_t)layer * FF2; const float* sbuf = inp(F, 7) + (size_t)layer * DEC_BATCH * 2 * FF2;
    const int gw = F.vcu * NWAVES + F.wave, NGW = F.G * NWAVES;
    for (int un = gw; un < UNITS_P + UNITS_S; un += NGW) {
        const bool samp = un >= UNITS_P; const int q = samp ? un - UNITS_P : un, cbk = q % NCB, id = q / NCB, j0 = cbk * 512 + F.lane * 8;
        const int nrows = samp ? DEC_SEQ : 2, row0 = samp ? MPR + id * DEC_SEQ : id * 256;
        float w[3][2][8], bb[2][8], p2[2][8], p1[2][8];
#pragma unroll
        for (int h = 0; h < 2; ++h) { const int c0 = j0 + h * D_FF;
#pragma unroll
            for (int e = 0; e < 8; ++e) { bb[h][e] = cb[c0 + e]; w[0][h][e] = cw[c0 + e]; w[1][h][e] = cw[FF2 + c0 + e]; w[2][h][e] = cw[2 * FF2 + c0 + e]; p2[h][e] = 0.f; p1[h][e] = 0.f; }
            if (samp) {
#pragma unroll
                for (int e = 0; e < 8; ++e) { p2[h][e] = sbuf[((size_t)id * 2 + 0) * FF2 + c0 + e]; p1[h][e] = sbuf[((size_t)id * 2 + 1) * FF2 + c0 + e]; } }
            else if (id % TPS != 0) { const v4u a = *(const GAS v4u*)(UB + ((size_t)(id - 1) * 4 + 2) * FF2 + c0), b = *(const GAS v4u*)(UB + ((size_t)(id - 1) * 4 + 3) * FF2 + c0);
#pragma unroll
                for (int e = 0; e < 4; ++e) { p2[h][2 * e] = bflo(a[e]); p2[h][2 * e + 1] = bfhi(a[e]); p1[h][2 * e] = bflo(b[e]); p1[h][2 * e + 1] = bfhi(b[e]); } }
        }
        v4u ur[DEC_SEQ][2];
#pragma unroll
        for (int r = 0; r < DEC_SEQ; ++r) { const int rr = r < nrows ? r : 0;
#pragma unroll
            for (int h = 0; h < 2; ++h) ur[r][h] = samp ? *(const GAS v4u*)(U + (size_t)(row0 + rr) * FF2 + j0 + h * D_FF) : *(const GAS v4u*)(UB + ((size_t)id * 4 + rr) * FF2 + j0 + h * D_FF); }
#pragma unroll
        for (int r = 0; r < DEC_SEQ; ++r) { if (r >= nrows) break;
            float cv[2][8];
#pragma unroll
            for (int h = 0; h < 2; ++h) { const v4u a = ur[r][h];
#pragma unroll
                for (int e = 0; e < 4; ++e) { const float u0 = bflo(a[e]), u1 = bfhi(a[e]);
                    cv[h][2 * e] = bb[h][2 * e] + w[0][h][2 * e] * p2[h][2 * e] + w[1][h][2 * e] * p1[h][2 * e] + w[2][h][2 * e] * u0;
                    cv[h][2 * e + 1] = bb[h][2 * e + 1] + w[0][h][2 * e + 1] * p2[h][2 * e + 1] + w[1][h][2 * e + 1] * p1[h][2 * e + 1] + w[2][h][2 * e + 1] * u1;
                    p2[h][2 * e] = p1[h][2 * e]; p2[h][2 * e + 1] = p1[h][2 * e + 1]; p1[h][2 * e] = u0; p1[h][2 * e + 1] = u1; } }
            v4u o;
#pragma unroll
            for (int e = 0; e < 4; ++e) o[e] = cvt_pk_bf16(gelu_tanh(cv[0][2 * e]) * cv[1][2 * e], gelu_tanh(cv[0][2 * e + 1]) * cv[1][2 * e + 1]);
            *(GAS v4u*)(ACT + (size_t)(row0 + r) * D_FF + j0) = o;
        }
    }
}
constexpr int NCPAD_P = (NC_P + 63) / 64 * 64, NCPAD_S = (NC_S + 63) / 64 * 64;
constexpr size_t KC_P_OFF = 0, VC_P_OFF = KC_P_OFF + (size_t)BATCH * 4 * NCPAD_P * 64 * 2, KC_S_OFF = VC_P_OFF + (size_t)BATCH * 4 * NCPAD_P * 64 * 2,
    VC_S_OFF = KC_S_OFF + (size_t)DEC_BATCH * 4 * NCPAD_S * 64 * 2, W1T_OFF = VC_S_OFF + (size_t)DEC_BATCH * 4 * NCPAD_S * 64 * 2,
    W2T_OFF = W1T_OFF + (size_t)2 * 64 * 2048 * 2,
    CB_OFF = W2T_OFF + (size_t)2 * 64 * 64 * 2, KC_END = CB_OFF + 2 * 64 * 4;
static_assert(KC_END <= ((size_t)64 << 20), "KC region");
__device__ __forceinline__ void compress_prologue(Frame& F) {
    LAS float* scr = (LAS float*)(F.lds + RING_OFF + F.wave * 16384);
    const int gw = F.vcu * NWAVES + F.wave, NGW = F.G * NWAVES;
    constexpr int I2 = (64 / 64) * (64 / 32);
    for (int it = gw; it < 2 * I2; it += NGW) { const int c = it / I2, r = it % I2;
        transpose_item(inp(F, 13) + (size_t)c * 64 * 64, 64, 64, 64, wsp<bf16>(F, WS_KC + W2T_OFF) + (size_t)c * 64 * 64, scr, r, F.lane); }
    for (int p = (int)blockIdx.x * NTHREADS + F.tid; p < 2 * 16 * 4 * 4 * 64; p += F.G * NTHREADS) {
        const int ln = p & 63, rh = (p >> 6) & 3, s4 = (p >> 8) & 3, l = (p >> 10) & 15, c = p >> 14; const int h = 32 * (rh & 1) + (ln & 31), d0 = 16 * s4 + 8 * (ln >> 5);
        const float* src = inp(F, 12) + (((size_t)c * 32 + 16 * (rh >> 1) + l) * 64 + d0) * 64 + h;
        v4u w; w.x = cvt_pk_bf16(src[0], src[64]); w.y = cvt_pk_bf16(src[128], src[192]); w.z = cvt_pk_bf16(src[256], src[320]); w.w = cvt_pk_bf16(src[384], src[448]);
        *(GAS v4u*)(wsp<bf16>(F, WS_KC + W1T_OFF) + (size_t)p * 8) = w; }
    const int cb = F.G - 1 - (int)blockIdx.x;
    if (cb >= 0 && cb < 2) { __syncthreads();
        const int c = cb, h4 = F.tid & 15, seg = F.tid >> 4; const float* w1 = inp(F, 12) + (size_t)c * 2048 * 64; const float* pos = inp(F, 14);
        LAS float* red = (LAS float*)(F.lds + RING_OFF); LAS float* P = red + 2048;
        for (int i = F.tid; i < 2048; i += NTHREADS) P[i] = pos[((i >> 6) * 2 + c) * 64 + (i & 63)];
        __syncthreads();
        f32x4 s = (f32x4){0.f, 0.f, 0.f, 0.f};
        for (int kk = 0; kk < 64; kk += 16) { f32x4 w[16];
#pragma unroll
            for (int j = 0; j < 16; ++j) w[j] = *(const GAS f32x4*)(w1 + (size_t)(seg * 64 + kk + j) * 64 + 4 * h4);
#pragma unroll
            for (int j = 0; j < 16; ++j) { const float pv = P[seg * 64 + kk + j]; s[0] += pv * w[j][0]; s[1] += pv * w[j][1]; s[2] += pv * w[j][2]; s[3] += pv * w[j][3]; } }
        *(LAS f32x4*)(red + seg * 64 + 4 * h4) = s; __syncthreads();
        if (F.tid < 64) { float t = 0.f;
#pragma unroll
            for (int i = 0; i < 32; ++i) t += red[i * 64 + F.tid];
            wsp<float>(F, WS_KC + CB_OFF)[c * 64 + F.tid] = t; }
        __syncthreads(); }
}
__device__ __forceinline__ bf16x8 ld_bf8_f32(const float* p) { const f32x4 a = *(const GAS f32x4*)p, b = *(const GAS f32x4*)(p + 4);
    v4u w; w.x = cvt_pk_bf16(a[0], a[1]); w.y = cvt_pk_bf16(a[2], a[3]); w.z = cvt_pk_bf16(b[0], b[1]); w.w = cvt_pk_bf16(b[2], b[3]); return __builtin_bit_cast(bf16x8, w); }
constexpr int CW_CMPQ = 2048;
constexpr int CMP_RSTR = 144, CMP_WBUF = 32 * CMP_RSTR;
template <bool SAMP> __device__ __forceinline__ void compress_unit(Frame& F, int b, int tile, int g, int c) {
    const int lane = F.lane, l32 = lane & 31, hi = lane >> 5;
    const bf16* W1F = wsp<bf16>(F, WS_KC + W1T_OFF); const bf16* W2T = wsp<bf16>(F, WS_KC + W2T_OFF); const float* CB = wsp<float>(F, WS_KC + CB_OFF);
    LAS unsigned char* stg = F.lds + RING_OFF + F.wave * (2 * CMP_WBUF);
    constexpr int nch = SAMP ? NCH_S : NCH_P, nc = SAMP ? NC_S : NC_P, ncpad = SAMP ? NCPAD_S : NCPAD_P;
    constexpr int NLD = SAMP ? 8 : 4, LPS = SAMP ? 16 : 8;
    const int ch0 = 31 * tile;
    const char* src[NLD];
#pragma unroll
    for (int i = 0; i < NLD; ++i) { int chn = ch0 + i * (64 / LPS) + lane / LPS; if (chn > nch - 1) chn = nch - 1; const int tok = 16 * chn;
        if (SAMP) { const int page = ((const int*)inp(F, 8))[b * N_PAGES + tok / PAGE_SIZE]; src[i] = (const char*)(inp(F, 2) + ((size_t)page * PAGE_SIZE + tok % PAGE_SIZE) * 1024 + c * 256 + g * 64) + (lane % LPS) * 16; }
        else src[i] = (const char*)(wsp<bf16>(F, WS_KVB) + (size_t)(b * SEQ + tok) * 1024 + c * 256 + g * 64) + (lane % LPS) * 16; }
    constexpr int TOKB = SAMP ? 4096 : 2048;
    f32x16 acc[2][2];
#pragma unroll
    for (int r = 0; r < 2; ++r)
#pragma unroll
        for (int hb = 0; hb < 2; ++hb) acc[r][hb] = (f32x16){};
    v4u nx[NLD];
#pragma unroll
    for (int i = 0; i < NLD; ++i) nx[i] = *(const GAS v4u*)(src[i]);
#pragma unroll 1
    for (int l = 0; l < 16; ++l) {
        LAS unsigned char* sb = stg + (l & 1) * CMP_WBUF;
#pragma unroll
        for (int i = 0; i < NLD; ++i) { const int row = i * (64 / LPS) + lane / LPS;
            if (SAMP) { const f32x4 f = __builtin_bit_cast(f32x4, nx[i]); v2u w; w.x = cvt_pk_bf16(f[0], f[1]); w.y = cvt_pk_bf16(f[2], f[3]); *(LAS v2u*)(sb + row * CMP_RSTR + (lane % LPS) * 8) = w; }
            else *(LAS v4u*)(sb + row * CMP_RSTR + (lane % LPS) * 16) = nx[i]; }
        const bf16* wl = W1F + (size_t)((c * 16 + l) * 16) * 512 + lane * 8;
        bf16x8 wf[16];
#pragma unroll
        for (int i = 0; i < 16; ++i) wf[i] = *(const GAS bf16x8*)(wl + i * 512);
        ASMV("" ::: "memory");
        { const int ln = l < 15 ? l + 1 : 15;
#pragma unroll
            for (int i = 0; i < NLD; ++i) nx[i] = *(const GAS v4u*)(src[i] + (size_t)ln * TOKB); }
        LDS_WAIT();
#pragma unroll
        for (int s4 = 0; s4 < 4; ++s4) { const bf16x8 kv = *(const LAS bf16x8*)(sb + l32 * CMP_RSTR + s4 * 32 + hi * 16);
#pragma unroll
            for (int rh = 0; rh < 4; ++rh)
                acc[rh >> 1][rh & 1] = __builtin_amdgcn_mfma_f32_32x32x16_bf16(wf[s4 * 4 + rh], kv, acc[rh >> 1][rh & 1], 0, 0, 0); }
    }
    f32x16 o[2]; o[0] = (f32x16){}; o[1] = (f32x16){};
#pragma unroll
    for (int hb = 0; hb < 2; ++hb) {
        float gv[16];
#pragma unroll
        for (int r = 0; r < 16; ++r) { const int h = 32 * hb + (r & 3) + 8 * (r >> 2) + 4 * hi; gv[r] = gelu_tanh(acc[0][hb][r] + __shfl(acc[1][hb][r], (lane + 1) & 63) + CB[c * 64 + h]); }
#pragma unroll
        for (int s = 0; s < 2; ++s) {
            v4u pw; pw.x = cvt_pk_bf16(gv[8 * s + 0], gv[8 * s + 1]); pw.y = cvt_pk_bf16(gv[8 * s + 2], gv[8 * s + 3]); pw.z = cvt_pk_bf16(gv[8 * s + 4], gv[8 * s + 5]); pw.w = cvt_pk_bf16(gv[8 * s + 6], gv[8 * s + 7]);
            const bf16x8 gf = __builtin_bit_cast(bf16x8, pw);
#pragma unroll
            for (int db = 0; db < 2; ++db) {
                const bf16* wp = W2T + (size_t)c * 64 * 64 + (size_t)(32 * db + l32) * 64 + 32 * hb + 16 * s + 4 * hi;
                const v2u a0 = *(const GAS v2u*)wp, a1 = *(const GAS v2u*)(wp + 8); v4u aw; aw.x = a0.x; aw.y = a0.y; aw.z = a1.x; aw.w = a1.y;
                o[db] = __builtin_amdgcn_mfma_f32_32x32x16_bf16(__builtin_bit_cast(bf16x8, aw), gf, o[db], 0, 0, 0);
            }
        }
    }
    const int j = ch0 + l32;
    if (l32 < 31 && j < ncpad) {
        bf16* dst = wsp<bf16>(F, WS_KC + (SAMP ? (c ? VC_S_OFF : KC_S_OFF) : (c ? VC_P_OFF : KC_P_OFF))) + ((size_t)(b * 4 + g) * ncpad + j) * 64;
        const bool live = j < nc;
#pragma unroll
        for (int db = 0; db < 2; ++db)
#pragma unroll
            for (int r4 = 0; r4 < 4; ++r4) { v2u w; w.x = live ? cvt_pk_bf16(o[db][4 * r4], o[db][4 * r4 + 1]) : 0u; w.y = live ? cvt_pk_bf16(o[db][4 * r4 + 2], o[db][4 * r4 + 3]) : 0u;
                __hip_atomic_store((GAS unsigned long long*)(dst + 32 * db + 8 * r4 + 4 * hi), ((unsigned long long)w.y << 32) | w.x, __ATOMIC_RELAXED, __HIP_MEMORY_SCOPE_AGENT); }
    }
}
constexpr int CW_CMPC = 8192;
constexpr int CMP_NT_P = (NCPAD_P + 30) / 31, CMP_NT_S = (NCPAD_S + 30) / 31;
__device__ __forceinline__ void compress_phase(Frame& F, int rep = 0) {
    constexpr int UN_S = DEC_BATCH * CMP_NT_S, UN_P = BATCH * CMP_NT_P;
    LAS unsigned* qslot = (LAS unsigned*)(F.lds + RING_OFF + NWAVES * 2 * CMP_WBUF);
    const int g = F.wave & 3, c = F.wave >> 2;
    for (;;) {
        __syncthreads();
        if (F.tid == 0) *qslot = __hip_atomic_fetch_add(F.ctl + CW_CMPQ + 64 * rep, 1u, __ATOMIC_RELAXED, __HIP_MEMORY_SCOPE_AGENT);
        __syncthreads();
        const int un = (int)*qslot;
        if (un >= UN_S + UN_P) break;
        int cw;
        if (un < UN_P) { compress_unit<false>(F, un / CMP_NT_P, un % CMP_NT_P, g, c); cw = CW_CMPC + 64 * (un / CMP_NT_P); }
        else { const int v = un - UN_P; compress_unit<true>(F, v / CMP_NT_S, v % CMP_NT_S, g, c); cw = CW_CMPC + 64 * (BATCH + v / CMP_NT_S); }
        ASMV("s_waitcnt vmcnt(0)" ::: "memory");
        __syncthreads();
        if (F.tid == 0) __hip_atomic_fetch_add(F.ctl + cw, 1u, __ATOMIC_RELAXED, __HIP_MEMORY_SCOPE_AGENT);
    }
}
#ifndef AT_PROBE
#define AT_PROBE 0
#endif
typedef short v4i16 __attribute__((ext_vector_type(4)));
constexpr int AT_KSTR = 144, AT_TILE = 64 * AT_KSTR;
constexpr int AT_VSTR = 192, AT_VTILE = 64 * AT_VSTR;
constexpr int AT_K = 0, AT_V = 2 * AT_TILE, AT_IMP = 2 * AT_TILE + 2 * AT_VTILE, IMPW_P = 65, IMPW_S = 132, AT_IMP_BYTES = 64 * IMPW_P * 4 + 256;
constexpr int AT_SEL = AT_IMP + AT_IMP_BYTES, AT_SC = AT_SEL + 64 * 3 * 8, AT_UNI = AT_SC + 8 * 192 * 4, AT_OACC = AT_UNI + 64, AT_END = AT_OACC + 32 * NTHREADS * 4;
static_assert((AT_OACC % 16) == 0 && AT_END <= RING_BYTES && 4 * IMPW_S * 4 <= AT_IMP_BYTES && (AT_IMP % 16) == 0 && (AT_SEL % 8) == 0, "attention LDS map");
constexpr float NEG_BIG = -1.0e30f;
struct AtUnit { bool samp; int b, g, t0, row0, ntok; };

struct AtPiece { v4u a, b; int kind; };
template <int BRX, bool SAMP> __device__ __forceinline__ AtPiece at_load_raw(const Frame& F, const AtUnit& u, int ti, int isv) {
    constexpr int BR = BRX & 15;
    int t_ = F.tid; ASMV("" : "+v"(t_));
    if (AT_PROBE == 5 && BRX >= 16) { AtPiece Z; Z.a = (v4u){0u,0u,0u,0u}; Z.b = Z.a; Z.kind = 1; return Z; }
    const int row = t_ >> 3, ch = t_ & 7; AtPiece P; P.b = (v4u){0u, 0u, 0u, 0u};
    if (!SAMP) { const bf16* pb;
        if (BR == 0) pb = wsp<bf16>(F, WS_KC + (isv ? VC_P_OFF : KC_P_OFF)) + ((size_t)(u.b * 4 + u.g) * NCPAD_P + 64 * ti + row) * 64 + ch * 8;
        else if (BR == 1) pb = wsp<bf16>(F, WS_KVB) + (size_t)(u.b * SEQ + 64 * ti + row) * 1024 + 512 + isv * 256 + u.g * 64 + ch * 8;
        else pb = wsp<bf16>(F, WS_WINB) + (size_t)(u.b * SEQ + 64 * ti + row) * 512 + isv * 256 + u.g * 64 + ch * 8;
        P.a = *(const GAS v4u*)pb; P.kind = 1; return P; }
    if (BR == 0) { P.a = *(const GAS v4u*)(wsp<bf16>(F, WS_KC + (isv ? VC_S_OFF : KC_S_OFF)) + ((size_t)(u.b * 4 + u.g) * NCPAD_S + 64 * ti + row) * 64 + ch * 8); P.kind = 1; return P; }
    const char* p; int kind;
    if (BR == 1) { const int co = 512 + isv * 256 + u.g * 64 + ch * 8;
        if (ti < PAST_LEN / 64) { const int page = ((const GAS int*)inp(F, 8))[u.b * N_PAGES + (64 * ti) / PAGE_SIZE]; p = (const char*)(inp(F, 2) + ((size_t)page * PAGE_SIZE + (64 * ti) % PAGE_SIZE + row) * 1024 + co); kind = 2; }
        else { const int rr = row < DEC_SEQ ? row : 0; p = (const char*)(wsp<bf16>(F, WS_KVB) + (size_t)(MPR + u.b * DEC_SEQ + rr) * 1024 + co); kind = row < DEC_SEQ ? 1 : 0; } }
    else { const int co = isv * 256 + u.g * 64 + ch * 8, i = 64 * ti + row;
        const char* pc = (const char*)(inp(F, 3) + ((size_t)u.b * WB_LEN + (i < WB_LEN ? i : 0)) * 512 + co);
        const int rr = (i >= WB_LEN && i < WB_LEN + DEC_SEQ) ? i - WB_LEN : 0; const char* pn = (const char*)(wsp<bf16>(F, WS_WINB) + (size_t)(MPR + u.b * DEC_SEQ + rr) * 512 + co);
        p = i < WB_LEN ? pc : pn; kind = i < WB_LEN ? 2 : (i < WB_LEN + DEC_SEQ ? 1 : 0); }
    P.a = *(const GAS v4u*)p; P.b = *(const GAS v4u*)(p + (kind == 2 ? 16 : 0)); P.kind = kind; return P;
}
template <bool SAMP> __device__ __forceinline__ AtPiece at_load_rt(const Frame& F, const AtUnit& u, int br, int ti, int isv) {
    int t_ = F.tid; ASMV("" : "+v"(t_));
    const int row = t_ >> 3, ch = t_ & 7; AtPiece P; P.b = (v4u){0u, 0u, 0u, 0u};
    if (!SAMP) {
        const bf16* b0 = wsp<bf16>(F, WS_KC + (isv ? VC_P_OFF : KC_P_OFF)) + (size_t)(u.b * 4 + u.g) * NCPAD_P * 64;
        const bf16* b1 = wsp<bf16>(F, WS_KVB) + (size_t)u.b * SEQ * 1024 + 512 + isv * 256 + u.g * 64;
        const bf16* b2 = wsp<bf16>(F, WS_WINB) + (size_t)u.b * SEQ * 512 + isv * 256 + u.g * 64;
        const bf16* base = br == 0 ? b0 : (br == 1 ? b1 : b2); const int stride = br == 0 ? 64 : (br == 1 ? 1024 : 512);
        P.a = *(const GAS v4u*)(base + (size_t)(64 * ti + row) * stride + ch * 8); P.kind = 1; return P; }
    const char* p; int kind;
    if (br == 0) { p = (const char*)(wsp<bf16>(F, WS_KC + (isv ? VC_S_OFF : KC_S_OFF)) + ((size_t)(u.b * 4 + u.g) * NCPAD_S + 64 * ti + row) * 64 + ch * 8); kind = 1; }
    else if (br == 1) { const int co = 512 + isv * 256 + u.g * 64 + ch * 8;
        if (ti < PAST_LEN / 64) { const int page = ((const GAS int*)inp(F, 8))[u.b * N_PAGES + (64 * ti) / PAGE_SIZE]; p = (const char*)(inp(F, 2) + ((size_t)page * PAGE_SIZE + (64 * ti) % PAGE_SIZE + row) * 1024 + co); kind = 2; }
        else { const int rr = row < DEC_SEQ ? row : 0; p = (const char*)(wsp<bf16>(F, WS_KVB) + (size_t)(MPR + u.b * DEC_SEQ + rr) * 1024 + co); kind = row < DEC_SEQ ? 1 : 0; } }
    else { const int co = isv * 256 + u.g * 64 + ch * 8, i = 64 * ti + row;
        const char* pc = (const char*)(inp(F, 3) + ((size_t)u.b * WB_LEN + (i < WB_LEN ? i : 0)) * 512 + co);
        const int rr = (i >= WB_LEN && i < WB_LEN + DEC_SEQ) ? i - WB_LEN : 0; const char* pn = (const char*)(wsp<bf16>(F, WS_WINB) + (size_t)(MPR + u.b * DEC_SEQ + rr) * 512 + co);
        p = i < WB_LEN ? pc : pn; kind = i < WB_LEN ? 2 : (i < WB_LEN + DEC_SEQ ? 1 : 0); }
    P.a = *(const GAS v4u*)p; P.b = *(const GAS v4u*)(p + (kind == 2 ? 16 : 0)); P.kind = kind; return P;
}
__device__ __forceinline__ v4u at_piece_bf16(const AtPiece& P) {
    const f32x4 a = __builtin_bit_cast(f32x4, P.a), b = __builtin_bit_cast(f32x4, P.b); v4u w; w.x = cvt_pk_bf16(a[0], a[1]); w.y = cvt_pk_bf16(a[2], a[3]); w.z = cvt_pk_bf16(b[0], b[1]); w.w = cvt_pk_bf16(b[2], b[3]);
    return P.kind == 2 ? w : (P.kind == 1 ? P.a : (v4u){0u, 0u, 0u, 0u});
}
#ifdef EMU
__device__ __forceinline__ int at_bits_below(unsigned long long e, int lane) { return __popcll(e & ((1ull << lane) - 1ull)); }
#else
__device__ __forceinline__ int at_bits_below(unsigned long long e, int lane) { (void)lane; return (int)__builtin_amdgcn_mbcnt_hi((unsigned)(e >> 32), __builtin_amdgcn_mbcnt_lo((unsigned)e, 0u)); }
#endif
struct AtLane { int t; float slope2; bool rowok; int l32, hi; };
template <int MODE, int KSTEP, bool INTERIOR = false, int PROBE = 0> __device__ __forceinline__ void at_tile(const LAS unsigned char* Kt, const LAS unsigned char* Vt, const bf16x8 (&qf)[4], const AtLane& L,
        int kpos0, bool selok, int wlimit, float& m, float& l, f32x16 (&o)[2], float inv_l, LAS unsigned* imp_row, int j8base, int impw) {
    if (PROBE == 6) return;
    const int l32 = L.l32, hi = L.hi; const int pi = (l32 & 19) | ((l32 >> 1) & 4) | ((l32 << 1) & 8);
    f32x16 p[2];
#pragma unroll
    for (int kb = 0; kb < 2; ++kb) { p[kb] = (f32x16){};
        const LAS unsigned char* kr = Kt + (32 * kb + pi) * AT_KSTR + hi * 16;
        if (PROBE != 3)
#pragma unroll
        for (int kc = 0; kc < 4; ++kc) p[kb] = __builtin_amdgcn_mfma_f32_32x32x16_bf16(*(const LAS bf16x8*)(kr + kc * 32), qf[kc], p[kb], 0, 0, 0); }
    float ls = 0.f;
    if (PROBE != 1) {
    const bool rok = selok && L.rowok;
    int dbase = L.t - kpos0 - KSTEP * 8 * hi; ASMV("" : "+v"(dbase));
    if (INTERIOR) {
        const float sk = L.slope2 * (float)KSTEP, off = -L.slope2 * (float)dbase; float mx = NEG_BIG;
#pragma unroll
        for (int kb = 0; kb < 2; ++kb)
#pragma unroll
            for (int r = 0; r < 16; ++r) { const float s = p[kb][r] + sk * (float)(32 * kb + 16 * (r >> 3) + (r & 7)); p[kb][r] = s; mx = fmaxf(mx, s); }
        mx = rok ? mx + off : NEG_BIG; mx = fmaxf(mx, __shfl_xor(mx, 32));
        const float mn = fmaxf(m, mx);
        if (__any(mn > m)) { const float alpha = __builtin_amdgcn_exp2f(m - mn); l *= alpha;
#pragma unroll
            for (int db = 0; db < 2; ++db)
#pragma unroll
                for (int r = 0; r < 16; ++r) o[db][r] *= alpha; }
        m = mn; const float mref = rok ? mn - off : 1.0e30f;
#pragma unroll
        for (int kb = 0; kb < 2; ++kb)
#pragma unroll
            for (int r = 0; r < 16; ++r) { const float e = __builtin_amdgcn_exp2f(p[kb][r] - mref); p[kb][r] = e; ls += e; }
    } else {
    float mx = NEG_BIG;
#pragma unroll
    for (int kb = 0; kb < 2; ++kb)
#pragma unroll
        for (int r = 0; r < 16; ++r) { const int dist = dbase - KSTEP * (32 * kb + 16 * (r >> 3) + (r & 7));
            const bool ok = rok && dist >= 0 && dist < wlimit; const float s = ok ? p[kb][r] - L.slope2 * (float)dist : NEG_BIG; p[kb][r] = s; mx = fmaxf(mx, s); }
    float mref = m;
    if (MODE != 1) { mx = fmaxf(mx, __shfl_xor(mx, 32)); const float mn = fmaxf(m, mx); mref = mn;
        if (__any(mn > m)) { const float alpha = __builtin_amdgcn_exp2f(m - mn); l *= alpha;
            if (MODE == 2) {
#pragma unroll
                for (int db = 0; db < 2; ++db)
#pragma unroll
                    for (int r = 0; r < 16; ++r) o[db][r] *= alpha; } }
        m = mn; }
#pragma unroll
    for (int kb = 0; kb < 2; ++kb)
#pragma unroll
        for (int r = 0; r < 16; ++r) { const float s = p[kb][r]; float e = (s > -1.0e29f) ? __builtin_amdgcn_exp2f(s - mref) : 0.f; if (MODE == 1) e *= inv_l; p[kb][r] = e; ls += e; }
    }
    }
    if (MODE != 1) l += ls;
    if (MODE == 0) return;
    if (MODE == 1) {
#pragma unroll
        for (int kb = 0; kb < 2; ++kb)
#pragma unroll
            for (int hf = 0; hf < 2; ++hf) { const int na = (j8base + 32 * kb + 16 * hf + 8 * hi) >> 2; const int r0 = 8 * hf;
                const float a = (p[kb][r0] + p[kb][r0 + 1]) + (p[kb][r0 + 2] + p[kb][r0 + 3]), b = (p[kb][r0 + 4] + p[kb][r0 + 5]) + (p[kb][r0 + 6] + p[kb][r0 + 7]) + p[kb][r0 + 3], c = p[kb][r0 + 7];
                if (L.rowok) { __hip_atomic_fetch_add(imp_row + na, (unsigned)(a * 67108864.f + 0.5f), __ATOMIC_RELAXED, __HIP_MEMORY_SCOPE_WORKGROUP);
                    if (na + 1 < impw) __hip_atomic_fetch_add(imp_row + na + 1, (unsigned)(b * 67108864.f + 0.5f), __ATOMIC_RELAXED, __HIP_MEMORY_SCOPE_WORKGROUP);
                    if (na + 2 < impw) __hip_atomic_fetch_add(imp_row + na + 2, (unsigned)(c * 67108864.f + 0.5f), __ATOMIC_RELAXED, __HIP_MEMORY_SCOPE_WORKGROUP); } }
    }
    if (PROBE == 2) return;
    const int gi = L.l32 & 15;
    const LAS unsigned char* vbase = Vt + (8 * hi + (gi >> 2)) * AT_VSTR + (16 * ((L.l32 >> 4) & 1) + 4 * (gi & 3)) * 2;
#pragma unroll
    for (int kb = 0; kb < 2; ++kb)
#pragma unroll
        for (int s = 0; s < 2; ++s) { v4u pw; const int r0 = 8 * s;
            pw.x = cvt_pk_bf16(p[kb][r0], p[kb][r0 + 1]); pw.y = cvt_pk_bf16(p[kb][r0 + 2], p[kb][r0 + 3]); pw.z = cvt_pk_bf16(p[kb][r0 + 4], p[kb][r0 + 5]); pw.w = cvt_pk_bf16(p[kb][r0 + 6], p[kb][r0 + 7]);
            const bf16x8 pf = __builtin_bit_cast(bf16x8, pw);
#pragma unroll
            for (int db = 0; db < 2; ++db) { const LAS unsigned char* vp = vbase + (32 * kb + 16 * s) * AT_VSTR + 64 * db;
                const v4i16 lo = __builtin_amdgcn_ds_read_tr16_b64_v4i16((LAS v4i16*)vp), hh = __builtin_amdgcn_ds_read_tr16_b64_v4i16((LAS v4i16*)(vp + 4 * AT_VSTR));
                const bf16x8 vf = (bf16x8){lo[0], lo[1], lo[2], lo[3], hh[0], hh[1], hh[2], hh[3]};
                o[db] = __builtin_amdgcn_mfma_f32_32x32x16_bf16(vf, pf, o[db], 0, 0, 0); } }
}
#define AT_STAGE(bufi, kreg, vreg) do { int _t = F.tid; ASMV("" : "+v"(_t)); const int _o = (_t >> 3) * AT_KSTR + (_t & 7) * 16; *(LAS v4u*)(lds + AT_K + (bufi) * AT_TILE + _o) = SAMP ? at_piece_bf16(kreg) : (kreg).a; *(LAS v4u*)(lds + AT_V + (bufi) * AT_VTILE + (_t >> 3) * AT_VSTR + (_t & 7) * 16) = SAMP ? at_piece_bf16(vreg) : (vreg).a; } while (0)

template <bool SAMP, int PROBE = 0> __device__ __forceinline__ void nsa_attn_unit(Frame& F, const AtUnit& u) {
    LAS unsigned char* lds = F.lds + RING_OFF;
    LAS unsigned* imp = (LAS unsigned*)(lds + AT_IMP); LAS unsigned long long* selm = (LAS unsigned long long*)(lds + AT_SEL); LAS unsigned* scw = (LAS unsigned*)(lds + AT_SC) + F.wave * 192;
    int lane_ = F.lane; ASMV("" : "+v"(lane_));
    const int lane = lane_, l32 = lane & 31, hi = lane >> 5, hh = F.wave >> 1, th = F.wave & 1;
        const int impw = SAMP ? IMPW_S : IMPW_P, nsel = SAMP ? NSEL_S : NSEL_P, keff = SEL_TOPK < nsel ? SEL_TOPK : nsel;
        AtLane L; L.l32 = l32; L.hi = hi; const int tk = 32 * th + l32; L.rowok = tk < u.ntok; L.t = u.t0 + (L.rowok ? tk : 0);
        L.slope2 = __builtin_amdgcn_exp2f(-0.5f * (float)(u.g * 4 + hh + 1)) * 1.4426950408889634f;
        const int qrow = u.row0 + (L.rowok ? tk : 0);
        bf16x8 qf[4];
        { const bf16* qp = wsp<bf16>(F, WS_Q) + (size_t)qrow * 1024 + u.g * 256 + hh * 64 + hi * 8;
#pragma unroll
          for (int kc = 0; kc < 4; ++kc) qf[kc] = *(const GAS bf16x8*)(qp + kc * 16); }
        for (int i = F.tid; i < AT_IMP_BYTES / 4; i += NTHREADS) imp[i] = 0u;
        if (F.tid < 3) ((LAS unsigned long long*)(lds + AT_UNI))[F.tid] = 0ull;
        LAS unsigned* imp_row = imp + (L.rowok ? tk : 0) * impw;
        f32x16 o[2]; LAS float* oacc = (LAS float*)(lds + AT_OACC) + F.wave * 2048 + lane;
        const float* gp = wsp<float>(F, WS_GATES) + (size_t)qrow * 48 + u.g * 12 + hh * 3;
        const float g0 = sigmoidf_(gp[0]), g1 = sigmoidf_(gp[1]), g2 = sigmoidf_(gp[2]);
        constexpr int PD = SAMP ? 1 : 2;
        const int nct = SAMP ? NCPAD_S / 64 : ((((u.t0 + 32) >> 4) >> 6) + 1 < NCPAD_P / 64 ? (((u.t0 + 32) >> 4) >> 6) + 1 : NCPAD_P / 64);
        int tfirst, tlast, kp0;
        if (SAMP) { tfirst = 0; tlast = (WB_LEN + DEC_SEQ + 63) / 64 - 1; kp0 = PAST_LEN - WB_LEN; }
        else { const int lo = u.t0 - WINDOW + 1; tfirst = lo > 0 ? lo >> 6 : 0; tlast = u.t0 >> 6; kp0 = 0; }
        const int nw = tlast - tfirst + 1;
        float m = NEG_BIG, l = 0.f, inv_l = 0.f; int buf = 0;
        AtPiece k2, v2;
        {
#define AT_CW(ii2, br, ti) const int _q = (ii2), br = _q < 2 * nct ? 0 : 2, ti = _q < 2 * nct ? (_q < nct ? _q : _q - nct) : tfirst + (_q - 2 * nct < nw ? _q - 2 * nct : nw - 1)
            { AT_CW(0, br0, ti0); const AtPiece k1 = at_load_rt<SAMP>(F, u, br0, ti0, 0), v1 = at_load_rt<SAMP>(F, u, br0, ti0, 1); k2 = k1; v2 = v1;
              if (!SAMP) { AT_CW(1, br1, ti1); k2 = at_load_rt<SAMP>(F, u, br1, ti1, 0); v2 = at_load_rt<SAMP>(F, u, br1, ti1, 1); }
              __syncthreads();
              AT_STAGE(0, k1, v1); __syncthreads(); }
            for (int ii = 0; ii < 2 * nct; ++ii) {
                AT_CW(ii + PD, br3, ti3);
                const AtPiece k3 = at_load_rt<SAMP>(F, u, br3, ti3, 0), v3 = at_load_rt<SAMP>(F, u, br3, ti3, 1);
                if (ii == nct) { l += __shfl_xor(l, 32); inv_l = l > 0.f ? 1.0f / l : 0.f; o[0] = (f32x16){}; o[1] = (f32x16){}; }
                const int i = ii < nct ? ii : ii - nct;
                const LAS unsigned char* Kt = lds + AT_K + buf * AT_TILE; const LAS unsigned char* Vt = lds + AT_V + buf * AT_VTILE;
                if (ii < nct) at_tile<0, 16, false, PROBE>(Kt, Vt, qf, L, 16 * 64 * i + 31, true, 0x7fffffff, m, l, o, 0.f, imp_row, 0, impw);
                else at_tile<1, 16, false, PROBE>(Kt, Vt, qf, L, 16 * 64 * i + 31, true, 0x7fffffff, m, l, o, inv_l, imp_row, 64 * i, impw);
                if (SAMP) AT_STAGE(buf ^ 1, k3, v3); else AT_STAGE(buf ^ 1, k2, v2);
                buf ^= 1;
                __syncthreads();
                if (!SAMP) { k2 = k3; v2 = v3; }
            }
#undef AT_CW
        }
#pragma unroll
        for (int db = 0; db < 2; ++db)
#pragma unroll
            for (int r = 0; r < 16; ++r) oacc[(16 * db + r) * 64] = g0 * o[db][r];
        for (int tkk = F.wave; tkk < u.ntok; tkk += NWAVES) {
            const int t = u.t0 + tkk, cur = t >> 6; unsigned sc[3];
#pragma unroll
            for (int i = 0; i < 3; ++i) { const int n = lane + 64 * i; unsigned s = 0u;
                if (n < nsel && 64 * n <= t) { s = imp[tkk * impw + n] + 1u; if (n == 0 || n == cur || n == cur - 1) s += 0x80000000u; }
                sc[i] = s; }
            constexpr int NSELC = SAMP ? NSEL_S : NSEL_P, NW = (NSELC + 63) / 64;
            unsigned T = 0u;
            for (int bit = 31; bit >= 0; --bit) { const unsigned cand = T | (1u << bit); int cnt = 0;
#pragma unroll
                for (int i = 0; i < NW; ++i) cnt += __popcll(__ballot(sc[i] >= cand));
                if (cnt >= keff) T = cand; }
            int need = keff;
#pragma unroll
            for (int i = 0; i < NW; ++i) need -= __popcll(__ballot(sc[i] > T));
#pragma unroll
            for (int i = 0; i < 3; ++i) { unsigned long long bal = 0ull;
                if (i < NW) { const unsigned long long e = __ballot(sc[i] == T && T != 0u); const int pre = at_bits_below(e, lane);
                    bal = __ballot(sc[i] > T || (sc[i] == T && T != 0u && pre < need)); need -= __popcll(e); }
                if (lane == 0) { selm[tkk * 3 + i] = bal; if (bal) __hip_atomic_fetch_or((LAS unsigned long long*)(lds + AT_UNI) + i, bal, __ATOMIC_RELAXED, __HIP_MEMORY_SCOPE_WORKGROUP); } }
            LDS_WAIT();
        }
        __syncthreads();
        const LAS unsigned long long* uni = (const LAS unsigned long long*)(lds + AT_UNI); int wi = 0; unsigned long long rem = uni[0]; int n = -1;
        auto next_tile = [&]() { while (rem == 0ull && wi < 2) { ++wi; rem = uni[wi]; } if (rem == 0ull) { n = -1; return; } const int bpos = __ffsll(rem) - 1; rem &= rem - 1ull; n = 64 * wi + bpos; };
        next_tile(); const int nA = n >= 0 ? n : 0; next_tile(); int nB = n >= 0 ? n : nA; next_tile(); int nC = n >= 0 ? n : nB;
        const int left = __popcll(uni[0]) + __popcll(uni[1]) + __popcll(uni[2]);
        {
            m = NEG_BIG; l = 0.f; o[0] = (f32x16){}; o[1] = (f32x16){};
            if (!SAMP && nw == 1) { k2 = at_load_rt<SAMP>(F, u, 1, nA, 0); v2 = at_load_rt<SAMP>(F, u, 1, nA, 1); }
            for (int j = 0; j < nw; ++j) {
                const int j2 = j + PD, br3 = j2 < nw ? 2 : 1, ti3 = j2 < nw ? tfirst + j2 : (j2 == nw ? nA : nB);
                const AtPiece k3 = at_load_rt<SAMP>(F, u, br3, ti3, 0), v3 = at_load_rt<SAMP>(F, u, br3, ti3, 1);
                { const int kq = kp0 + 64 * (tfirst + j), tmax = u.t0 + u.ntok - 1;
                  if (kq + 63 <= u.t0 && tmax - kq < WINDOW) at_tile<2, 1, true, PROBE>(lds + AT_K + buf * AT_TILE, lds + AT_V + buf * AT_VTILE, qf, L, kq, true, WINDOW, m, l, o, 0.f, imp_row, 0, impw);
                  else at_tile<2, 1, false, PROBE>(lds + AT_K + buf * AT_TILE, lds + AT_V + buf * AT_VTILE, qf, L, kq, true, WINDOW, m, l, o, 0.f, imp_row, 0, impw); }
                if (SAMP) AT_STAGE(buf ^ 1, k3, v3); else AT_STAGE(buf ^ 1, k2, v2);
                buf ^= 1;
                __syncthreads();
                if (!SAMP) { k2 = k3; v2 = v3; }
            }
            l += __shfl_xor(l, 32); const float sc2 = l > 0.f ? g2 / l : 0.f;
#pragma unroll
            for (int db = 0; db < 2; ++db)
#pragma unroll
                for (int r = 0; r < 16; ++r) oacc[(16 * db + r) * 64] += sc2 * o[db][r];
        }
        {
            m = NEG_BIG; l = 0.f; o[0] = (f32x16){}; o[1] = (f32x16){};
            int ncur = nA;
            for (int j = 0; j < left; ++j) {
                const AtPiece k3 = at_load_rt<SAMP>(F, u, 1, SAMP ? nB : nC, 0), v3 = at_load_rt<SAMP>(F, u, 1, SAMP ? nB : nC, 1);
                const bool selok = L.rowok && ((selm[tk * 3 + (ncur >> 6)] >> (ncur & 63)) & 1ull);
                if (__any(selok)) { if (64 * ncur + 63 <= u.t0) at_tile<2, 1, true, PROBE>(lds + AT_K + buf * AT_TILE, lds + AT_V + buf * AT_VTILE, qf, L, 64 * ncur, selok, 0x7fffffff, m, l, o, 0.f, imp_row, 0, impw);
                    else at_tile<2, 1, false, PROBE>(lds + AT_K + buf * AT_TILE, lds + AT_V + buf * AT_VTILE, qf, L, 64 * ncur, selok, 0x7fffffff, m, l, o, 0.f, imp_row, 0, impw); }
                if (SAMP) AT_STAGE(buf ^ 1, k3, v3); else AT_STAGE(buf ^ 1, k2, v2);
                buf ^= 1;
                __syncthreads();
                if (!SAMP) { k2 = k3; v2 = v3; } ncur = nB; nB = nC; next_tile(); if (n >= 0) nC = n;
            }
            l += __shfl_xor(l, 32); const float sc1 = l > 0.f ? g1 / l : 0.f;
#pragma unroll
            for (int db = 0; db < 2; ++db)
#pragma unroll
                for (int r = 0; r < 16; ++r) o[db][r] = oacc[(16 * db + r) * 64] + sc1 * o[db][r];
        }
        if (L.rowok) { bf16* op = wsp<bf16>(F, PROBE ? WS_MISC + ((size_t)300 << 20) : WS_AO) + (size_t)qrow * 1024 + u.g * 256 + hh * 64 + 4 * hi;
#pragma unroll
            for (int db = 0; db < 2; ++db)
#pragma unroll
                for (int r4 = 0; r4 < 4; ++r4) { v2u w; w.x = cvt_pk_bf16(o[db][4 * r4], o[db][4 * r4 + 1]); w.y = cvt_pk_bf16(o[db][4 * r4 + 2], o[db][4 * r4 + 3]); *(GAS v2u*)(op + 32 * db + 8 * r4) = w; } }
        __syncthreads();
}
constexpr int CW_ATQ = 2560;
__device__ __forceinline__ void nsa_attn_phase(Frame& F, int rep = 0) {
    constexpr int NQT = SEQ / 64, NBG = BATCH * 4, UNITS_S = DEC_BATCH * 4;
    LAS unsigned* qslot = (LAS unsigned*)(F.lds + RING_OFF + AT_UNI + 32);
    const int xcd = (int)(xb_xcc_id() & 7u);
    unsigned long long cdone = 0ull;
    static_assert(BATCH + DEC_BATCH <= 64, "cdone mask");
    for (int xo = 0; xo < 8; ++xo) { const int x = (xcd + xo) & 7;
        const int ns = x < UNITS_S ? (UNITS_S - x + 7) / 8 : 0, nb = x < NBG ? (NBG - x + 7) / 8 : 0, total = ns + nb * NQT;
        for (;;) {
            __syncthreads();
            if (F.tid == 0) {
                const int k0 = (int)__hip_atomic_fetch_add(F.ctl + CW_ATQ + 64 * (rep * 8 + x), 1u, __ATOMIC_RELAXED, __HIP_MEMORY_SCOPE_AGENT);
                if (k0 < total) { const bool us = k0 < ns; const int ub = us ? (x + 8 * k0) >> 2 : (x + 8 * ((k0 - ns) % nb)) >> 2, ci = us ? BATCH + ub : ub;
                    if (!((cdone >> ci) & 1ull)) { gu32* cw = F.ctl + CW_CMPC + 64 * ci; const unsigned want = us ? (unsigned)CMP_NT_S : (unsigned)CMP_NT_P; unsigned spins = 0;
                        while (__hip_atomic_load(cw, __ATOMIC_RELAXED, __HIP_MEMORY_SCOPE_AGENT) < want) { __builtin_amdgcn_s_sleep(2); if (++spins > (1u << 22)) { __hip_atomic_store(F.ctl + CW_TMO, 1u, __ATOMIC_RELAXED, __HIP_MEMORY_SCOPE_AGENT); break; } }
                        cdone |= 1ull << ci; } }
                *qslot = (unsigned)k0; }
            __syncthreads();
            const int k = (int)*qslot;
            if (k >= total) break;
            if (AT_PROBE == 8 && rep && k >= ns) break;
            if (AT_PROBE == 9 && rep && k < ns) continue;
            AtUnit u;
            __builtin_amdgcn_fence(__ATOMIC_ACQUIRE, "agent"); ASMV("s_waitcnt vmcnt(0)" ::: "memory");
            if (k < ns) { const int sidx = x + 8 * k; u.samp = true; u.b = sidx >> 2; u.g = sidx & 3; u.t0 = PAST_LEN; u.row0 = MPR + u.b * DEC_SEQ; u.ntok = DEC_SEQ; { if (AT_PROBE && rep) nsa_attn_unit<true, AT_PROBE>(F, u); else nsa_attn_unit<true>(F, u); } }
            else { const int v = k - ns, bg = x + 8 * (v % nb), qt = NQT - 1 - v / nb; u.samp = false; u.b = bg >> 2; u.g = bg & 3; u.t0 = 64 * qt; u.row0 = u.b * SEQ + u.t0; u.ntok = 64; { if (AT_PROBE && rep) nsa_attn_unit<false, AT_PROBE>(F, u); else nsa_attn_unit<false>(F, u); } }
        }
    }
}
constexpr int NCK = SEQ / 64, NBH = BATCH * 8;
constexpr size_t MS_M = 0, MS_D = MS_M + al4k((size_t)NBH * (NCK + 1) * 4), MS_DC = MS_D + al4k((size_t)NBH * NCK * 4), MS_DN = MS_DC + al4k((size_t)NBH * NCK * 8192 * 4),
    MS_CST = MS_DN + al4k((size_t)NBH * NCK * 64 * 4), MS_NST = MS_CST + al4k((size_t)NBH * NCK * 8192 * 2), MS_END = MS_NST + al4k((size_t)NBH * NCK * 64 * 4);
static_assert(MS_END <= ((size_t)512 << 20), "mLSTM scratch");
constexpr float LOG2E = 1.4426950408889634f;
__device__ __forceinline__ float log_sigmoidf_(float x) { return fminf(x, 0.f) - 0.6931471805599453f * __builtin_amdgcn_logf(1.0f + __builtin_amdgcn_exp2f(-fabsf(x) * LOG2E)); }
__device__ __forceinline__ float expf_(float x) { return __builtin_amdgcn_exp2f(x * LOG2E); }
__device__ __forceinline__ float wave_incl_sum(float v, int lane) {
#pragma unroll
    for (int o = 1; o < 64; o <<= 1) { const float t = __shfl(v, lane - o < 0 ? 0 : lane - o); if (lane >= o) v += t; }
    return v;
}
__device__ __forceinline__ float wave_incl_max(float v, int lane) {
#pragma unroll
    for (int o = 1; o < 64; o <<= 1) { const float t = __shfl(v, lane - o < 0 ? 0 : lane - o); if (lane >= o) v = fmaxf(v, t); }
    return v;
}
constexpr int ML_KSTR = 144, ML_VSTR = 272;
__device__ __forceinline__ bf16x8 mk8(v4i16 a, v4i16 b) { return (bf16x8){a[0], a[1], a[2], a[3], b[0], b[1], b[2], b[3]}; }
__device__ __forceinline__ void mlstm_phase_a(Frame& F) {
    LAS unsigned char* lds = F.lds + RING_OFF;
    LAS float* sB = (LAS float*)lds; LAS float* sA = sB + NCK; LAS float* sM = sA + NCK;
    LAS unsigned char* Kt = lds + 4096; LAS unsigned char* Vt = Kt + 64 * ML_KSTR;
    static_assert((3 * NCK + 1) * 4 <= 4096 && 4096 + 64 * ML_KSTR + 64 * ML_VSTR <= RING_BYTES, "phase A LDS");
    const GAS float* MG = (const GAS float*)wsp<float>(F, WS_MG); const GAS bf16* MK = (const GAS bf16*)wsp<bf16>(F, WS_MK); const GAS bf16* MV = (const GAS bf16*)wsp<bf16>(F, WS_MV);
    GAS float* MSTm = (GAS float*)wsp<float>(F, WS_MISC + MS_M); GAS float* MSTd = (GAS float*)wsp<float>(F, WS_MISC + MS_D); GAS float* DC = (GAS float*)wsp<float>(F, WS_MISC + MS_DC); GAS float* DN = (GAS float*)wsp<float>(F, WS_MISC + MS_DN);
    const int lane = F.lane, l32 = lane & 31, hi = lane >> 5;
    constexpr int NCG = NCK / 8, UNITS = NBH * NCG;
    for (int un = F.vcu; un < UNITS; un += F.G) {
        const int bh = un / NCG, cg = un % NCG, b = bh >> 3, h = bh & 7, cend = 8 * cg + 8;
        const float bi = inp(F, 16)[h], bfg = inp(F, 16)[8 + h];
        __syncthreads();
        for (int j0 = F.wave; j0 < cend; j0 += 4 * NWAVES) {
            float igr[4], fgr[4];
#pragma unroll
            for (int q = 0; q < 4; ++q) { const int j = j0 + q * NWAVES, jj = j < cend ? j : j0; const size_t row = (size_t)b * SEQ + 64 * jj + lane; igr[q] = MG[row * 16 + h]; fgr[q] = MG[row * 16 + 8 + h]; }
#pragma unroll
            for (int q = 0; q < 4; ++q) { const int j = j0 + q * NWAVES; const float ig = igr[q] + bi, fg = log_sigmoidf_(fgr[q] + bfg);
                const float bb = wave_incl_sum(fg, lane), Bj = __shfl(bb, 63), aj = wave_max(Bj - bb + ig);
                if (lane == 0 && j < cend) { sB[j] = Bj; sA[j] = aj; } } }
        __syncthreads();
        if (F.tid == 0) { float m = 0.f; sM[0] = 0.f; for (int j = 0; j < cend; ++j) { m = fmaxf(sB[j] + m, sA[j]); sM[j + 1] = m; } }
        __syncthreads();
        if (F.tid < 8) { const int c = 8 * cg + F.tid; MSTm[bh * (NCK + 1) + c] = sM[c]; MSTd[bh * NCK + c] = expf_(sB[c] + sM[c] - sM[c + 1]);
            if (c == NCK - 1) { MSTm[bh * (NCK + 1) + NCK] = sM[NCK]; F.out[O_MP + bh] = sM[NCK]; } }
        float n_ig, n_fg; v4u n_kk, n_v0, n_v1;
#define ML_A_LOAD(cx) do { const size_t r0_ = (size_t)b * SEQ + 64 * (size_t)(8 * cg + (cx)); n_ig = MG[(r0_ + lane) * 16 + h]; n_fg = MG[(r0_ + lane) * 16 + 8 + h]; \
            n_kk = *(const GAS v4u*)(MK + (r0_ + (F.tid >> 3)) * 512 + h * 64 + (F.tid & 7) * 8); \
            n_v0 = *(const GAS v4u*)(MV + (r0_ + (F.tid >> 4)) * 1024 + h * 128 + (F.tid & 15) * 8); n_v1 = *(const GAS v4u*)(MV + (r0_ + (F.tid >> 4) + 32) * 1024 + h * 128 + (F.tid & 15) * 8); } while (0)
        ML_A_LOAD(0);
        for (int cc = 0; cc < 8; ++cc) { const int c = 8 * cg + cc;
            const float c_ig = n_ig, c_fg = n_fg; const v4u kk = n_kk, cv0 = n_v0, cv1 = n_v1;
            ML_A_LOAD(cc < 7 ? cc + 1 : 7);
            const float ig = c_ig + bi, fg = log_sigmoidf_(c_fg + bfg);
            const float bb = wave_incl_sum(fg, lane), Bc = __shfl(bb, 63); const float ws = expf_(Bc - bb + ig - sM[c + 1]);
            { const int r = F.tid >> 3, ch = F.tid & 7; const float wr = __shfl(ws, r & 63);
              v4u o;
#pragma unroll
              for (int e = 0; e < 4; ++e) o[e] = cvt_pk_bf16(bflo(kk[e]) * wr, bfhi(kk[e]) * wr);
              *(LAS v4u*)(Kt + r * ML_KSTR + ch * 16) = o;
              *(LAS v4u*)(Vt + (F.tid >> 4) * ML_VSTR + (F.tid & 15) * 16) = cv0; *(LAS v4u*)(Vt + ((F.tid >> 4) + 32) * ML_VSTR + (F.tid & 15) * 16) = cv1; }
            __syncthreads();
            { const int vb = F.wave >> 1, db = F.wave & 1, gi = l32 & 15; f32x16 acc = (f32x16){};
              const LAS unsigned char* va = Vt + (8 * hi + (gi >> 2)) * ML_VSTR + (32 * vb + 16 * ((l32 >> 4) & 1) + 4 * (gi & 3)) * 2;
              const LAS unsigned char* ka = Kt + (8 * hi + (gi >> 2)) * ML_KSTR + (32 * db + 16 * ((l32 >> 4) & 1) + 4 * (gi & 3)) * 2;
#pragma unroll
              for (int ks = 0; ks < 4; ++ks) {
                  const v4i16 a0 = __builtin_amdgcn_ds_read_tr16_b64_v4i16((LAS v4i16*)(va + 16 * ks * ML_VSTR)), a1 = __builtin_amdgcn_ds_read_tr16_b64_v4i16((LAS v4i16*)(va + (16 * ks + 4) * ML_VSTR));
                  const v4i16 b0 = __builtin_amdgcn_ds_read_tr16_b64_v4i16((LAS v4i16*)(ka + 16 * ks * ML_KSTR)), b1 = __builtin_amdgcn_ds_read_tr16_b64_v4i16((LAS v4i16*)(ka + (16 * ks + 4) * ML_KSTR));
                  acc = __builtin_amdgcn_mfma_f32_32x32x16_bf16(mk8(a0, a1), mk8(b0, b1), acc, 0, 0, 0); }
              GAS float* dc = DC + ((size_t)bh * NCK + c) * 8192 + (32 * vb + 4 * hi) * 64 + 32 * db + l32;
#pragma unroll
              for (int r = 0; r < 16; ++r) dc[((r & 3) + 8 * (r >> 2)) * 64] = acc[r];
              if (F.tid < 64) { float s = 0.f; for (int r = 0; r < 64; ++r) s += bf2f(*(const LAS unsigned short*)(Kt + r * ML_KSTR + F.tid * 2)); DN[((size_t)bh * NCK + c) * 64 + F.tid] = s; } }
            __syncthreads();
        }
    }
}
#undef ML_A_LOAD
__device__ __forceinline__ void mlstm_phase_b(Frame& F) {
    LAS float* part = (LAS float*)(F.lds + RING_OFF);
    const GAS float* MG = (const GAS float*)wsp<float>(F, WS_MG); const GAS bf16* MQ = (const GAS bf16*)wsp<bf16>(F, WS_MQ); const GAS bf16* MK = (const GAS bf16*)wsp<bf16>(F, WS_MK); const GAS bf16* MV = (const GAS bf16*)wsp<bf16>(F, WS_MV); const GAS bf16* MO = (const GAS bf16*)wsp<bf16>(F, WS_MO);
    for (int un = F.vcu; un < DEC_BATCH * 8; un += F.G) {
        const int b = un >> 3, h = un & 7, v = F.tid >> 2, dq = F.tid & 3; const size_t r0 = (size_t)MPR + b * DEC_SEQ;
        const float bi = inp(F, 16)[h], bfg = inp(F, 16)[8 + h], m0 = inp(F, 6)[un];
        float ig[4], bb[4], mt[4]; float run = 0.f;
#pragma unroll
        for (int t = 0; t < 4; ++t) { ig[t] = MG[(r0 + t) * 16 + h] + bi; run += log_sigmoidf_(MG[(r0 + t) * 16 + 8 + h] + bfg); bb[t] = run; }
#pragma unroll
        for (int t = 0; t < 4; ++t) { float mx = bb[t] + m0;
#pragma unroll
            for (int s = 0; s <= t; ++s) mx = fmaxf(mx, bb[t] - bb[s] + ig[s]); mt[t] = mx; }
        float qk[4][4], nq[4] = {0.f, 0.f, 0.f, 0.f};
#pragma unroll
        for (int t = 0; t < 4; ++t)
#pragma unroll
            for (int s = 0; s < 4; ++s) qk[t][s] = 0.f;
        const float* n0 = inp(F, 5) + (size_t)un * 64;
#pragma unroll 2
        for (int dc = 0; dc < 8; ++dc) {
            v4u qv[4], kv[4]; f32x4 na, nb;
#pragma unroll
            for (int t = 0; t < 4; ++t) { qv[t] = *(const GAS v4u*)(MQ + (r0 + t) * 512 + h * 64 + 8 * dc); kv[t] = *(const GAS v4u*)(MK + (r0 + t) * 512 + h * 64 + 8 * dc); }
            na = *(const GAS f32x4*)(n0 + 8 * dc); nb = *(const GAS f32x4*)(n0 + 8 * dc + 4);
#pragma unroll
            for (int e = 0; e < 8; ++e) { float q[4], k[4];
#pragma unroll
                for (int t = 0; t < 4; ++t) { const unsigned qw = qv[t][e >> 1], kw = kv[t][e >> 1]; q[t] = (e & 1) ? bfhi(qw) : bflo(qw); k[t] = (e & 1) ? bfhi(kw) : bflo(kw); }
                const float nn = e < 4 ? na[e & 3] : nb[e & 3];
#pragma unroll
                for (int t = 0; t < 4; ++t) { nq[t] += nn * q[t];
#pragma unroll
                    for (int s2 = 0; s2 <= t; ++s2) qk[t][s2] += q[t] * k[s2]; } } }
        const float* C0 = inp(F, 4) + ((size_t)un * 128 + v) * 64 + 16 * dq;
        float c0[16], cq[4] = {0.f, 0.f, 0.f, 0.f};
        v4u qd[4][2], kd[4][2];
#pragma unroll
        for (int t = 0; t < 4; ++t)
#pragma unroll
            for (int i = 0; i < 2; ++i) { qd[t][i] = *(const GAS v4u*)(MQ + (r0 + t) * 512 + h * 64 + 16 * dq + 8 * i); kd[t][i] = *(const GAS v4u*)(MK + (r0 + t) * 512 + h * 64 + 16 * dq + 8 * i); }
#pragma unroll
        for (int e = 0; e < 16; e += 4) { const f32x4 cc = *(const GAS f32x4*)(C0 + e); c0[e] = cc[0]; c0[e + 1] = cc[1]; c0[e + 2] = cc[2]; c0[e + 3] = cc[3]; }
#pragma unroll
        for (int t = 0; t < 4; ++t) {
#pragma unroll
            for (int e = 0; e < 16; ++e) { const unsigned w = qd[t][e >> 3][(e & 7) >> 1]; cq[t] += c0[e] * ((e & 1) ? bfhi(w) : bflo(w)); }
            cq[t] += __shfl_xor(cq[t], 1); cq[t] += __shfl_xor(cq[t], 2); }
        float vv[4], hv[4], ssq[4];
#pragma unroll
        for (int t = 0; t < 4; ++t) vv[t] = bf2f(MV[(r0 + t) * 1024 + h * 128 + v]);
#pragma unroll
        for (int t = 0; t < 4; ++t) { const float wi = expf_(bb[t] + m0 - mt[t]); float num = wi * cq[t], den = wi * nq[t];
#pragma unroll
            for (int s = 0; s <= t; ++s) { const float S = qk[t][s] * expf_(bb[t] - bb[s] + ig[s] - mt[t]); num += S * vv[s]; den += S; }
            hv[t] = num / fmaxf(fabsf(den), expf_(-mt[t])); float q2 = (dq == 0) ? hv[t] * hv[t] : 0.f;
#pragma unroll
            for (int o = 1; o < 64; o <<= 1) q2 += __shfl_xor(q2, o);
            ssq[t] = q2; }
        __syncthreads();
        if (F.lane == 0) {
#pragma unroll
            for (int t = 0; t < 4; ++t) part[F.wave * 4 + t] = ssq[t]; }
        __syncthreads();
        if (dq == 0) {
#pragma unroll
            for (int t = 0; t < 4; ++t) { float tot = 0.f;
#pragma unroll
                for (int w = 0; w < 8; ++w) tot += part[w * 4 + t];
                const float rn = 1.0f / sqrtf(tot * (1.0f / 128.0f) + RMS_EPS);
                const float o = hv[t] * rn * inp(F, 17)[h * 128 + v] * sigmoidf_(bf2f(MO[(r0 + t) * 1024 + h * 128 + v]));
                wsp<bf16>(F, WS_AO)[(r0 + t) * 1024 + h * 128 + v] = (bf16)(cvt_pk_bf16(o, 0.f) & 0xffffu); } }
        const float mL = mt[3], decay = expf_(bb[3] + m0 - mL); float wsv[4];
#pragma unroll
        for (int s = 0; s < 4; ++s) wsv[s] = expf_(bb[3] - bb[s] + ig[s] - mL);
        float* Co = outp(F) + O_CS + ((size_t)un * 128 + v) * 64 + 16 * dq;
#pragma unroll
        for (int e = 0; e < 16; ++e) { float a = decay * c0[e];
#pragma unroll
            for (int s = 0; s < 4; ++s) { const unsigned w = kd[s][e >> 3][(e & 7) >> 1]; a += wsv[s] * vv[s] * ((e & 1) ? bfhi(w) : bflo(w)); }
            Co[e] = a; }
        if (F.tid < 64) { float a = decay * n0[F.tid];
#pragma unroll
            for (int s = 0; s < 4; ++s) a += wsv[s] * bf2f(MK[(r0 + s) * 512 + h * 64 + F.tid]);
            F.out[O_NS + (size_t)un * 64 + F.tid] = a; }
        if (F.tid == 0) F.out[O_MS + un] = mL;
    }
    const GAS float* MSTd = (const GAS float*)wsp<float>(F, WS_MISC + MS_D); const GAS float* DC = (const GAS float*)wsp<float>(F, WS_MISC + MS_DC); const GAS float* DN = (const GAS float*)wsp<float>(F, WS_MISC + MS_DN);
    GAS bf16* CST = (GAS bf16*)wsp<bf16>(F, WS_MISC + MS_CST); GAS float* NST = (GAS float*)wsp<float>(F, WS_MISC + MS_NST);
    const int gt = F.vcu * NTHREADS + F.tid, NGT = F.G * NTHREADS;
    constexpr int SB = NCK < 8 ? NCK : 8;
    for (int it = gt; it < NBH * 4096; it += NGT) { const int bh = it >> 12, e2 = (it & 4095) * 2; f32x2 C = (f32x2){0.f, 0.f};
        for (int c0 = 0; c0 < NCK; c0 += SB) { f32x2 d[SB]; float dcy[SB];
#pragma unroll
            for (int i = 0; i < SB; ++i) { d[i] = *(const GAS f32x2*)(DC + ((size_t)bh * NCK + c0 + i) * 8192 + e2); dcy[i] = MSTd[bh * NCK + c0 + i]; }
#pragma unroll
            for (int i = 0; i < SB; ++i) { *(GAS unsigned*)(CST + ((size_t)bh * NCK + c0 + i) * 8192 + e2) = cvt_pk_bf16(C.x, C.y); C = C * dcy[i] + d[i]; } }
        *(GAS f32x2*)(outp(F) + O_CP + (size_t)bh * 8192 + e2) = C; }
    for (int it = gt; it < NBH * 64; it += NGT) { const int bh = it >> 6, d = it & 63; float n = 0.f;
        for (int c0 = 0; c0 < NCK; c0 += SB) { float dn[SB], dcy[SB];
#pragma unroll
            for (int i = 0; i < SB; ++i) { dn[i] = DN[((size_t)bh * NCK + c0 + i) * 64 + d]; dcy[i] = MSTd[bh * NCK + c0 + i]; }
#pragma unroll
            for (int i = 0; i < SB; ++i) { NST[((size_t)bh * NCK + c0 + i) * 64 + d] = n; n = n * dcy[i] + dn[i]; } }
        *(GAS float*)(outp(F) + O_NP + (size_t)bh * 64 + d) = n; }
}
__device__ __forceinline__ void mlstm_phase_c(Frame& F) {
    constexpr int WAREA = 64 * ML_VSTR + 1024;
    static_assert(WAREA * 8 <= RING_BYTES, "phase C LDS");
    LAS unsigned char* wl = F.lds + RING_OFF + F.wave * WAREA; LAS unsigned char* Vt = wl; LAS float* sU = (LAS float*)(wl + 64 * ML_VSTR); LAS float* sW = sU + 64; LAS float* sBc = sW + 64;
    const GAS float* MG = (const GAS float*)wsp<float>(F, WS_MG); const GAS bf16* MQ = (const GAS bf16*)wsp<bf16>(F, WS_MQ); const GAS bf16* MK = (const GAS bf16*)wsp<bf16>(F, WS_MK); const GAS bf16* MV = (const GAS bf16*)wsp<bf16>(F, WS_MV); const GAS bf16* MO = (const GAS bf16*)wsp<bf16>(F, WS_MO);
    const GAS float* MSTm = (const GAS float*)wsp<float>(F, WS_MISC + MS_M); const GAS bf16* CST = (const GAS bf16*)wsp<bf16>(F, WS_MISC + MS_CST); const GAS float* NST = (const GAS float*)wsp<float>(F, WS_MISC + MS_NST);
    const int lane = F.lane, l32 = lane & 31, hi = lane >> 5, gw = F.vcu * NWAVES + F.wave, NGW = F.G * NWAVES;
    const int pi = (l32 & 19) | ((l32 >> 1) & 4) | ((l32 << 1) & 8);
    for (int un = gw; un < NBH * NCK; un += NGW) {
        const int bh = un / NCK, c = un % NCK, b = bh >> 3, h = bh & 7; const size_t row0 = (size_t)b * SEQ + 64 * c;
        const float mc = MSTm[bh * (NCK + 1) + c];
        { const float ig = MG[(row0 + lane) * 16 + h] + inp(F, 16)[h], fg = log_sigmoidf_(MG[(row0 + lane) * 16 + 8 + h] + inp(F, 16)[8 + h]);
          const float bb = wave_incl_sum(fg, lane), uu = ig - bb, gg = wave_incl_max(uu, lane);
          sU[lane] = uu * LOG2E; sW[lane] = fmaxf(mc, gg) * LOG2E; sBc[lane] = bb * LOG2E; }
        { LAS unsigned char* vd = Vt + (lane >> 4) * ML_VSTR + (lane & 15) * 16; const GAS bf16* vs = MV + (row0 + (lane >> 4)) * 1024 + h * 128 + (lane & 15) * 8;
#pragma unroll
          for (int i = 0; i < 16; ++i) *(LAS v4u*)(vd + i * 4 * ML_VSTR) = *(const GAS v4u*)(vs + (size_t)i * 4 * 1024); }
        LDS_WAIT();
        const GAS float* nst = NST + ((size_t)bh * NCK + c) * 64; const GAS bf16* cst = CST + ((size_t)bh * NCK + c) * 8192;
#pragma unroll
        for (int tb = 0; tb < 2; ++tb) {
            const int t = 32 * tb + l32; const float Wt = sW[t], wi = __builtin_amdgcn_exp2f(mc * LOG2E - Wt);
            bf16x8 qf[4]; float nq = 0.f;
#pragma unroll
            for (int kc = 0; kc < 4; ++kc) { qf[kc] = *(const GAS bf16x8*)(MQ + (row0 + t) * 512 + h * 64 + 16 * kc + 8 * hi);
                const f32x4 n0 = *(const GAS f32x4*)(nst + 16 * kc + 8 * hi), n1 = *(const GAS f32x4*)(nst + 16 * kc + 8 * hi + 4); const v4u qw = __builtin_bit_cast(v4u, qf[kc]);
                nq += n0[0] * bflo(qw.x) + n0[1] * bfhi(qw.x) + n0[2] * bflo(qw.y) + n0[3] * bfhi(qw.y) + n1[0] * bflo(qw.z) + n1[1] * bfhi(qw.z) + n1[2] * bflo(qw.w) + n1[3] * bfhi(qw.w); }
            nq += __shfl_xor(nq, 32);
            f32x16 p[2]; float rs = 0.f;
#pragma unroll
            for (int sb = 0; sb < 2; ++sb) { p[sb] = (f32x16){};
                if (sb <= tb) {
#pragma unroll
                    for (int kc = 0; kc < 4; ++kc) p[sb] = __builtin_amdgcn_mfma_f32_32x32x16_bf16(*(const GAS bf16x8*)(MK + (row0 + 32 * sb + pi) * 512 + h * 64 + 16 * kc + 8 * hi), qf[kc], p[sb], 0, 0, 0);
#pragma unroll
                    for (int hf = 0; hf < 2; ++hf) { const int s0 = 32 * sb + 16 * hf + 8 * hi; const f32x4 u0 = *(const LAS f32x4*)(sU + s0), u1 = *(const LAS f32x4*)(sU + s0 + 4);
#pragma unroll
                        for (int e = 0; e < 8; ++e) { const float uu = e < 4 ? u0[e & 3] : u1[e & 3]; const float w = (s0 + e <= t) ? __builtin_amdgcn_exp2f(uu - Wt) : 0.f; const float x = p[sb][8 * hf + e] * w; p[sb][8 * hf + e] = x; rs += x; } } } }
            rs += __shfl_xor(rs, 32);
            const float den = wi * nq + rs, inv = 1.0f / fmaxf(fabsf(den), __builtin_amdgcn_exp2f(-(sBc[t] + Wt)));
            unsigned hp[4][8]; float ssq = 0.f;
            const int gi = l32 & 15;
#pragma unroll
            for (int vq = 0; vq < 4; ++vq) { f32x16 acc = (f32x16){};
#pragma unroll
                for (int kc = 0; kc < 4; ++kc) acc = __builtin_amdgcn_mfma_f32_32x32x16_bf16(*(const GAS bf16x8*)(cst + (32 * vq + l32) * 64 + 16 * kc + 8 * hi), qf[kc], acc, 0, 0, 0);
#pragma unroll
                for (int r = 0; r < 16; ++r) acc[r] *= wi;
                const LAS unsigned char* va = Vt + (8 * hi + (gi >> 2)) * ML_VSTR + (32 * vq + 16 * ((l32 >> 4) & 1) + 4 * (gi & 3)) * 2;
#pragma unroll
                for (int sb = 0; sb < 2; ++sb) if (sb <= tb) {
#pragma unroll
                    for (int ks = 0; ks < 2; ++ks) { const int r0 = 8 * ks; v4u pw;
                        pw.x = cvt_pk_bf16(p[sb][r0], p[sb][r0 + 1]); pw.y = cvt_pk_bf16(p[sb][r0 + 2], p[sb][r0 + 3]); pw.z = cvt_pk_bf16(p[sb][r0 + 4], p[sb][r0 + 5]); pw.w = cvt_pk_bf16(p[sb][r0 + 6], p[sb][r0 + 7]);
                        const v4i16 a0 = __builtin_amdgcn_ds_read_tr16_b64_v4i16((LAS v4i16*)(va + (32 * sb + 16 * ks) * ML_VSTR)), a1 = __builtin_amdgcn_ds_read_tr16_b64_v4i16((LAS v4i16*)(va + (32 * sb + 16 * ks + 4) * ML_VSTR));
                        acc = __builtin_amdgcn_mfma_f32_32x32x16_bf16(mk8(a0, a1), __builtin_bit_cast(bf16x8, pw), acc, 0, 0, 0); } }
#pragma unroll
                for (int r = 0; r < 16; r += 2) { const float h0 = acc[r] * inv, h1 = acc[r + 1] * inv; ssq += h0 * h0 + h1 * h1; hp[vq][r >> 1] = cvt_pk_bf16(h0, h1); } }
            ssq += __shfl_xor(ssq, 32);
            const float rn = 1.0f / sqrtf(ssq * (1.0f / 128.0f) + RMS_EPS);
            const float* hn = inp(F, 17) + h * 128; const GAS bf16* mo = MO + (row0 + t) * 1024 + h * 128; GAS bf16* ao = (GAS bf16*)wsp<bf16>(F, WS_AO) + (row0 + t) * 1024 + h * 128;
#pragma unroll
            for (int vq = 0; vq < 4; ++vq)
#pragma unroll
                for (int r4 = 0; r4 < 4; ++r4) { const int v = 32 * vq + 8 * r4 + 4 * hi; const f32x4 g = *(const GAS f32x4*)(hn + v); const v2u ow = *(const GAS v2u*)(mo + v);
                    const float y0 = bflo(hp[vq][2 * r4]) * rn * g[0] * sigmoidf_(bflo(ow.x)), y1 = bfhi(hp[vq][2 * r4]) * rn * g[1] * sigmoidf_(bfhi(ow.x));
                    const float y2 = bflo(hp[vq][2 * r4 + 1]) * rn * g[2] * sigmoidf_(bflo(ow.y)), y3 = bfhi(hp[vq][2 * r4 + 1]) * rn * g[3] * sigmoidf_(bfhi(ow.y));
                    v2u w; w.x = cvt_pk_bf16(y0, y1); w.y = cvt_pk_bf16(y2, y3); *(GAS v2u*)(ao + v) = w; }
        }
        LDS_WAIT();
    }
}
#ifndef PH_LO
#define PH_LO 0
#endif
#ifndef PH_HI
#define PH_HI 20
#endif
struct Args { const float* in[23]; float* out; unsigned char* ws; int ph_lo, ph_hi; };
constexpr int N_PHASES = 20, KSPLIT_DN = D_FF >= 2048 ? 8 : 2;
__global__ void __launch_bounds__(NTHREADS, 2) mega_fwd(Args args) {
#ifdef EMU
    unsigned char* lds = emu_cur->blk->lds;
#else
    extern __shared__ __attribute__((aligned(16))) unsigned char lds[];
#endif
    Frame F;
    F.lds = (LAS unsigned char*)lds;
    F.MISC = (volatile LAS unsigned*)(F.lds + MISC_OFF);
    F.tid = threadIdx.x; F.lane = F.tid & 63; F.wave = __builtin_amdgcn_readfirstlane(F.tid >> 6);
    F.G = gridDim.x; { const int bx = blockIdx.x; F.vcu = (F.G % 8 == 0) ? (bx % 8) * (F.G / 8) + bx / 8 : bx; }
    F.ws = args.ws; F.out = args.out; F.ctl = (gu32*)(args.ws + WS_CTL);
#ifdef EMU
    F.in = args.in;
#else
    { const unsigned char __attribute__((address_space(4)))* ka = (const unsigned char __attribute__((address_space(4)))*)__builtin_amdgcn_kernarg_segment_ptr();
      F.in = (const float* const*)(const unsigned char*)ka; }
#endif
    for (int u = F.tid; u < (LDS_BYTES - LDSCTL_OFF) / 4; u += NTHREADS) ((LAS unsigned*)(F.lds + LDSCTL_OFF))[u] = 0u;
    __syncthreads();
    XcdBarrier bar = xcd_barrier_post((unsigned*)(F.ctl + CW_BAR), F.MISC + 8, (unsigned)F.wave);
    constexpr int lo = PH_LO, hi = PH_HI;
#ifdef EMU
#define LAUNDER() ((void)0)
#else
#define RFL64(x) (((unsigned long long)(unsigned)__builtin_amdgcn_readfirstlane((int)((x) >> 32)) << 32) | (unsigned long long)(unsigned)__builtin_amdgcn_readfirstlane((int)(x)))
#define LAUNDER() do { unsigned long long a_ = (unsigned long long)F.ws, b_ = (unsigned long long)F.out, c_ = (unsigned long long)F.in; int w_ = F.wave; \
    a_ = RFL64(a_); b_ = RFL64(b_); c_ = RFL64(c_); w_ = __builtin_amdgcn_readfirstlane(w_); asm volatile("" : "+s"(a_), "+s"(b_), "+s"(c_), "+s"(w_)); \
    int l_ = lane_id(); asm volatile("" : "+v"(l_)); F.wave = w_; F.lane = l_; F.tid = w_ * 64 + l_; \
    F.ws = (unsigned char*)a_; F.out = (float*)b_; F.in = (const float* const*)c_; F.ctl = (gu32*)(F.ws + WS_CTL); } while (0)
#endif
#ifndef DUP_MASK
#define DUP_MASK 0u
#endif
#define REP(k) for (int rep_ = 0; rep_ < (((DUP_MASK) >> (k)) & 1u ? 2 : 1); ++rep_, __syncthreads())
#define IN(k) (lo <= (k) && (k) < hi)
#define SEAM(k) do { if (IN(k) && IN((k) + 1)) xcd_barrier(bar); LAUNDER(); } while (0)
    const float* norm_g = inp(F, 9);

    if (IN(0)) REP(0) { p0_prologue(F); compress_prologue(F); } SEAM(0);
    if (IN(1)) REP(1) {
        pg8::Gemm g{wsp<bf16>(F, WS_H), wsp<bf16>(F, WS_WNSAIN), MPAD, NSA_IN_PAD, D}; pg8::StaticOrder S; S.init(MPAD, NSA_IN_PAD, F.G, (int)blockIdx.x);
        EpiNsaIn E{F.ws, F.out};
        pg8::gemm_phase<EpiNsaIn, pg8::StaticOrder, true, true>(F.lds + RING_OFF, g, S, E, F.wave);
    } SEAM(1);
    if (IN(2)) { compress_phase(F, 0); }
    if (IN(3)) { nsa_attn_phase(F, 0); if (AT_PROBE) { __syncthreads(); nsa_attn_phase(F, 1); } } SEAM(3);
#pragma unroll 1
    for (int layer = 0; layer < 2; ++layer) {
        const int pb = layer * 10;
        if (layer == 1) {
            if (IN(10)) REP(10) {
                pg8::Gemm g{wsp<bf16>(F, WS_H), wsp<bf16>(F, WS_WMLIN), MPAD, ML_IN_PAD, D}; pg8::StaticOrder S; S.init(MPAD, ML_IN_PAD, F.G, (int)blockIdx.x);
                EpiMlIn E{F.ws};
                pg8::gemm_phase<EpiMlIn, pg8::StaticOrder, true, true>(F.lds + RING_OFF, g, S, E, F.wave);
            } SEAM(10);
            if (IN(11)) REP(11) { mlstm_phase_a(F); } SEAM(11);
            if (IN(12)) REP(12) { mlstm_phase_b(F); } SEAM(12);
            if (IN(13)) REP(13) { mlstm_phase_c(F); } SEAM(13);
        }
        if (IN(pb + 4)) {
            pg8::Gemm g{wsp<bf16>(F, WS_AO), wsp<bf16>(F, layer ? WS_WMLOUT : WS_WNSAOUT), MPR, D, D}; pg8::StaticOrder S; S.init(MPR, D, F.G, (int)blockIdx.x);
            EpiRmsRes E{F.ws, F.out, norm_g + (size_t)(layer * 4 + 1) * D, norm_g + (size_t)(layer * 4 + 2) * D, F.ctl, layer * 2};
            pg8::gemm_phase<EpiRmsRes, pg8::StaticOrder, false, true>(F.lds + RING_OFF, g, S, E, F.wave);
            mini_gemm(F, wsp<bf16>(F, WS_AO), wsp<bf16>(F, layer ? WS_WMLOUT : WS_WNSAOUT), MPR, MSA, 0, D, D, 4, E);
        } SEAM(pb + 4);
        if (IN(pb + 6)) {
            gu32* gate = F.ctl + CW_SN + 64 * layer;
            norm_phase(F, MPR, wsp<float>(F, WS_Y), wsp<float>(F, WS_YS), 4, norm_g + (size_t)(layer * 4 + 1) * D, norm_g + (size_t)(layer * 4 + 2) * D, wsp<bf16>(F, WS_H), gate, F.G >= 64 + NSN ? 64 : 0); LAUNDER(); gate = F.ctl + CW_SN + 64 * layer;
            REP(6) {
            pg8::Gemm g{wsp<bf16>(F, WS_H), wsp<bf16>(F, WS_WUP) + (size_t)layer * FF2 * D, MPAD, FF2, D}; GatedOrder S; S.init(MPAD, FF2, F.G, (int)blockIdx.x); S.gate = gate; S.tmo = F.ctl + CW_TMO;
            EpiUpConv E{F.ws, F.out, F.in, layer, (LAS float*)(F.lds + RING_OFF + UPX_OFF)};
            pg8::gemm_phase<EpiUpConv, GatedOrder, true, false>(F.lds + RING_OFF, g, S, E, F.wave); }
        } SEAM(pb + 6);
        if (IN(pb + 7)) REP(7) { conv_fix_phase(F, layer); } SEAM(pb + 7);
        if (IN(pb + 8)) {
            pg8::Gemm g{wsp<bf16>(F, WS_ACT), wsp<bf16>(F, WS_WDOWN) + (size_t)layer * D * D_FF, MPR, D, D_FF}; pg8::StaticOrder S; S.init(MPR, D, F.G, (int)blockIdx.x);
            EpiRmsRes E{F.ws, F.out, norm_g + (size_t)(layer * 4 + 3) * D, layer == 0 ? norm_g + (size_t)4 * D : nullptr, F.ctl, layer * 2 + 1};
            pg8::gemm_phase<EpiRmsRes, pg8::StaticOrder, false, false>(F.lds + RING_OFF, g, S, E, F.wave);
            mini_gemm(F, wsp<bf16>(F, WS_ACT), wsp<bf16>(F, WS_WDOWN) + (size_t)layer * D * D_FF, MPR, MSA, 0, D, D_FF, KSPLIT_DN, E);
        } SEAM(pb + 8);
        if (IN(pb + 9)) { norm_phase(F, MPR, wsp<float>(F, WS_Y), wsp<float>(F, WS_YS), KSPLIT_DN, norm_g + (size_t)(layer * 4 + 3) * D, layer == 0 ? norm_g + (size_t)4 * D : nullptr, wsp<bf16>(F, WS_H)); }
        if (layer == 0) SEAM(9);
    }
#undef IN
#undef SEAM
}

extern "C" void kernel_launch(void* const* d_in, const int* in_sizes, int n_in, void* d_out, int out_size, void* d_ws, size_t ws_size, hipStream_t stream) {
    static int grid = 0;
    if (grid == 0) {
        if (n_in != 23 || (size_t)out_size != O_END || ws_size < WS_END) { fprintf(stderr, "kernel_launch: unexpected sizes n_in %d out %d (want %zu) ws %zu (want %zu)\n", n_in, out_size, (size_t)O_END, ws_size, (size_t)WS_END); grid = -1; return; }
        int dev = 0, cus = 0, per_cu = 0;
        if (hipGetDevice(&dev) != hipSuccess || hipDeviceGetAttribute(&cus, hipDeviceAttributeMultiprocessorCount, dev) != hipSuccess) { grid = -1; return; }
        if (hipFuncSetAttribute((const void*)mega_fwd, hipFuncAttributeMaxDynamicSharedMemorySize, LDS_BYTES) != hipSuccess) { fprintf(stderr, "kernel_launch: hipFuncSetAttribute failed\n"); grid = -1; return; }
        if (hipOccupancyMaxActiveBlocksPerMultiprocessor(&per_cu, (const void*)mega_fwd, NTHREADS, LDS_BYTES) != hipSuccess || per_cu < 1) fprintf(stderr, "kernel_launch: occupancy query says %d\n", per_cu);
        (void)hipGetLastError();
        grid = cus;
    }
    if (grid < 0) return;
    (void)hipMemsetAsync((char*)d_ws + WS_CTL, 0, CTL_ZERO_BYTES, stream);
    Args a{};
    for (int i = 0; i < 23; ++i) a.in[i] = (const float*)d_in[i];
    a.out = (float*)d_out; a.ws = (unsigned char*)d_ws; a.ph_lo = PH_LO; a.ph_hi = PH_HI;
    hipLaunchKernelGGL(mega_fwd, dim3(grid), dim3(NTHREADS), LDS_BYTES, stream, a);
}
#ifdef EMU
static void dump_region(const char* dir, const char* name, void* ws, size_t off, size_t bytes) { char p[512]; snprintf(p, sizeof p, "%s/ws_%s.bin", dir, name); FILE* f = fopen(p, "wb"); fwrite((char*)ws + off, 1, bytes, f); fclose(f); }
void emu_dump_ws(const char* dir, void* ws) {
    dump_region(dir, "H", ws, WS_H, (size_t)MPAD * D * 2); dump_region(dir, "Q", ws, WS_Q, (size_t)MPAD * D * 2); dump_region(dir, "KVB", ws, WS_KVB, (size_t)MPAD * D * 2);
    dump_region(dir, "WINB", ws, WS_WINB, (size_t)MPAD * 512 * 2); dump_region(dir, "GATES", ws, WS_GATES, (size_t)MPAD * 48 * 4); dump_region(dir, "AO", ws, WS_AO, (size_t)MPAD * D * 2);
    dump_region(dir, "Y", ws, WS_Y, (size_t)MPAD * D * 4); dump_region(dir, "U", ws, WS_U, (size_t)MPAD * FF2 * 2); dump_region(dir, "ACT", ws, WS_ACT, (size_t)MPAD * D_FF * 2);
    dump_region(dir, "KC", ws, WS_KC, (size_t)32 << 20); dump_region(dir, "MISC", ws, WS_MISC, (size_t)64 << 20);
    dump_region(dir, "MQ", ws, WS_MQ, (size_t)MPAD * 512 * 2); dump_region(dir, "MK", ws, WS_MK, (size_t)MPAD * 512 * 2); dump_region(dir, "MV", ws, WS_MV, (size_t)MPAD * D * 2);
    dump_region(dir, "MO", ws, WS_MO, (size_t)MPAD * D * 2); dump_region(dir, "MG", ws, WS_MG, (size_t)MPAD * 16 * 4);
    dump_region(dir, "WNSAIN", ws, WS_WNSAIN, (size_t)NSA_IN_PAD * D * 2);
    dump_region(dir, "CTL", ws, WS_CTL, 65536);
}
#endif
```

```cpp
#ifndef EMU
#include <hip/hip_runtime.h>
#endif
#include <cstdio>
#include <cstdint>
#ifdef EMU
#define LAS
#define GAS
#define ASMV(...) ((void)0)
#else
#define LAS __attribute__((address_space(3)))
#define GAS __attribute__((address_space(1)))
#define ASMV(...) asm volatile(__VA_ARGS__)
#endif

#ifdef EMU
static inline int lane_id() { return emu_cur->lane; }
#else
__device__ __forceinline__ int lane_id() { unsigned ones = ~0u; asm volatile("" : "+s"(ones)); return (int)__builtin_amdgcn_mbcnt_hi(ones, __builtin_amdgcn_mbcnt_lo(ones, 0u)); }
#endif
#ifdef EMU
static inline int bcast0(int v) { return (int)emu_xchg((unsigned)v, 0); }
#else
__device__ __forceinline__ int bcast0(int v) { return __builtin_amdgcn_readfirstlane(v); }
#endif
#ifdef EMU_CFG_SMALL
#ifndef EMU_DFF
#define EMU_DFF 512
#endif
#ifndef EMU_DECB
#define EMU_DECB 2
#endif
constexpr int BATCH = 1, SEQ = 512, DEC_BATCH = EMU_DECB, PAST_LEN = 512, SEL_TOPK = 4, WINDOW = 128, D_FF = EMU_DFF;
#else
constexpr int BATCH = 4, SEQ = 4096, DEC_BATCH = 32, PAST_LEN = 8192, SEL_TOPK = 16, WINDOW = 512, D_FF = 4096;
#endif
constexpr int DEC_SEQ = 4, PAGE_SIZE = 128, D = 1024, FF2 = 2 * D_FF;
constexpr int MPR = BATCH * SEQ, MSA = DEC_BATCH * DEC_SEQ, MT = MPR + MSA, MPAD = (MT + 255) / 256 * 256;
constexpr int NSA_IN = 2608, NSA_IN_PAD = 2816, ML_IN = 3088, ML_IN_PAD = 3328;
constexpr int N_PAGES = PAST_LEN / PAGE_SIZE, N_USED = DEC_BATCH * N_PAGES, N_PHYS = N_USED + (N_USED / 4 > 1 ? N_USED / 4 : 1);
constexpr int WB_LEN = WINDOW < PAST_LEN ? WINDOW : PAST_LEN, WKEEP = WINDOW < SEQ ? WINDOW : SEQ;
constexpr int NCH_P = SEQ / 16, NC_P = NCH_P - 1, TS = PAST_LEN + DEC_SEQ, NCH_S = TS / 16, NC_S = NCH_S - 1;
constexpr int NSEL_P = SEQ / 64, NSEL_S = (TS + 63) / 64;
constexpr float RMS_EPS = 1e-6f;
constexpr float QSCALE = 0.125f * 1.4426950408889634f;
static_assert(PAST_LEN % 64 == 0 && SEQ % 64 == 0 && DEC_SEQ == 4, "shape assumptions");

constexpr size_t O_Y = 0, O_KV = O_Y + (size_t)MT * D, O_WINP = O_KV + (size_t)MT * D, O_WINS = O_WINP + (size_t)BATCH * WKEEP * 512,
    O_CP = O_WINS + (size_t)DEC_BATCH * WB_LEN * 512, O_CS = O_CP + (size_t)BATCH * 8 * 128 * 64, O_NP = O_CS + (size_t)DEC_BATCH * 8 * 128 * 64,
    O_NS = O_NP + (size_t)BATCH * 8 * 64, O_MP = O_NS + (size_t)DEC_BATCH * 8 * 64, O_MS = O_MP + (size_t)BATCH * 8, O_CVP = O_MS + (size_t)DEC_BATCH * 8,
    O_CVS = O_CVP + (size_t)2 * BATCH * 2 * FF2, O_END = O_CVS + (size_t)2 * DEC_BATCH * 2 * FF2;

constexpr size_t al4k(size_t x) { return (x + 4095) & ~(size_t)4095; }
constexpr size_t WS_CTL = 0, CTL_ZERO_BYTES = 1u << 20;
constexpr size_t WS_WNSAIN = CTL_ZERO_BYTES;
constexpr size_t WS_WNSAOUT = WS_WNSAIN + al4k((size_t)NSA_IN_PAD * D * 2);
constexpr size_t WS_WMLIN = WS_WNSAOUT + al4k((size_t)D * D * 2);
constexpr size_t WS_WMLOUT = WS_WMLIN + al4k((size_t)ML_IN_PAD * D * 2);
constexpr size_t WS_WUP = WS_WMLOUT + al4k((size_t)D * D * 2);
constexpr size_t WS_WDOWN = WS_WUP + al4k((size_t)2 * FF2 * D * 2);
constexpr size_t WS_H = WS_WDOWN + al4k((size_t)2 * D * D_FF * 2);
constexpr size_t WS_Q = WS_H + al4k((size_t)MPAD * D * 2);
constexpr size_t WS_KVB = WS_Q + al4k((size_t)MPAD * D * 2);
constexpr size_t WS_WINB = WS_KVB + al4k((size_t)MPAD * D * 2);
constexpr size_t WS_GATES = WS_WINB + al4k((size_t)MPAD * 512 * 2);
constexpr size_t WS_AO = WS_GATES + al4k((size_t)MPAD * 48 * 4);
constexpr size_t WS_Y = WS_AO + al4k((size_t)MPAD * D * 2);
constexpr size_t WS_U = WS_Y + al4k((size_t)MPAD * D * 4);
constexpr size_t WS_ACT = WS_U + al4k((size_t)MPAD * FF2 * 2);
constexpr size_t WS_KC = WS_ACT + al4k((size_t)MPAD * D_FF * 2);
constexpr size_t KC_P_ELEMS = (size_t)BATCH * 4 * 256 * 64 * (NC_P + 255) / 256 * 1;
constexpr size_t WS_MQ = WS_KC + al4k((size_t)64 << 20);
constexpr size_t WS_MK = WS_MQ + al4k((size_t)MPAD * 512 * 2);
constexpr size_t WS_MV = WS_MK + al4k((size_t)MPAD * 512 * 2);
constexpr size_t WS_MO = WS_MV + al4k((size_t)MPAD * D * 2);
constexpr size_t WS_MG = WS_MO + al4k((size_t)MPAD * D * 2);
constexpr size_t WS_YS = WS_MG + al4k((size_t)MPAD * 16 * 4);
constexpr size_t WS_XS = WS_YS + al4k((size_t)8 * MSA * D * 4);
constexpr size_t WS_UB = WS_XS + al4k((size_t)8 * MPR * 4 * 4) - al4k((size_t)8 * MSA * D * 4) + al4k((size_t)8 * MSA * D * 4);
constexpr size_t WS_MISC = WS_UB + al4k((size_t)(MPR / 256) * 4 * FF2 * 2) - al4k((size_t)8 * MSA * D * 4) + al4k((size_t)8 * MSA * D * 4);
constexpr size_t WS_END = WS_MISC + ((size_t)512 << 20);
constexpr int CW_TMO = 0, CW_BAR = 4096;
namespace pg8 {
typedef unsigned short bf16_t;
typedef short bf16x8 __attribute__((ext_vector_type(8)));
typedef float f32x4 __attribute__((ext_vector_type(4)));
typedef unsigned u32x4 __attribute__((ext_vector_type(4)));
constexpr int BM = 256, BK = 64, HALF = 128, HTB = HALF * BK * 2  , STAGE_BYTES = 8 * HTB, NXCD = 8, WGM = 8;

__host__ __device__ __forceinline__ int lds_byte(int r, int c) { const int st = (r >> 4) * 2 + (c >> 5), rr = r & 15, cc = c & 31, ob = rr * 64 + cc * 2; return st * 1024 + (ob ^ (((ob >> 9) & 1) << 5)); }
__host__ __device__ __forceinline__ void stage_rc(int b, int& R, int& C) { const int st = b / 1024, sb = b % 1024, swz = sb ^ (((sb >> 9) & 1) << 5); R = (st >> 1) * 16 + swz / 64; C = (st & 1) * 32 + (swz % 64) / 2; }
__host__ __device__ __forceinline__ int perm32(int rho) { const int n = rho >> 4, i = rho & 15; return 8 * (i >> 2) + 4 * n + (i & 3); }

struct Unit { int pm, pn; };
struct Gemm { const bf16_t* A; const bf16_t* Bt; int M, N, K; };

struct StaticOrder {
    int nM, nN, nwg, G, c;
    __host__ __device__ void init(int M, int N, int G_, int c_) { nM = M / BM; nN = N / BM; nwg = nM * nN; G = G_; c = c_; }
    __host__ __device__ bool next(int i, Unit& u) const {
        const long L = (long)i * G + c; if (L >= nwg) return false;
        int wgid = (int)L; { const int q = nwg / NXCD, r = nwg % NXCD, xcd = wgid % NXCD, off = wgid / NXCD; wgid = (xcd < r ? xcd * (q + 1) : r * (q + 1) + (xcd - r) * q) + off; }
        const int nig = WGM * nN, gid = wgid / nig, fm = gid * WGM, gsz = (nM - fm) < WGM ? (nM - fm) : WGM;
        u.pm = fm + ((wgid % nig) % gsz); u.pn = (wgid % nig) / gsz; return true;
    }
    __device__ __forceinline__ void a_ready(const Unit&) const {}
    __device__ __forceinline__ void done(const Unit&) const {}
};

#ifdef EMU
__device__ __forceinline__ unsigned cvt_pk_bf16(float lo, float hi) { unsigned a = __builtin_bit_cast(unsigned, lo), b = __builtin_bit_cast(unsigned, hi);
    a = (a + 0x7fffu + ((a >> 16) & 1u)) >> 16; b = (b + 0x7fffu + ((b >> 16) & 1u)) >> 16; return a | (b << 16); }
#else
typedef float cvt_f32x2_t __attribute__((ext_vector_type(2))); typedef __bf16 cvt_bf16x2_t __attribute__((ext_vector_type(2)));
__device__ __forceinline__ unsigned cvt_pk_bf16(float lo, float hi) { const cvt_f32x2_t v = {lo, hi}; const cvt_bf16x2_t b = __builtin_convertvector(v, cvt_bf16x2_t); return __builtin_bit_cast(unsigned, b); }
#endif
template <class Epi, class Sched, bool ALIGN_EPI = false, bool SP2 = false>
__device__ __forceinline__ void gemm_phase(LAS unsigned char* lds, const Gemm g, const Sched& S, const Epi& E, int wave_id) {
    int tid_ = wave_id * 64 + lane_id(); ASMV("" : "+v"(tid_));
    const int tid = tid_, wid = __builtin_amdgcn_readfirstlane(tid >> 6), lane = tid & 63, wr = wid >> 2, wc = wid & 3, fr = lane & 15, fq = lane >> 4;
    const int K = g.K, nt = K / BK;
    unsigned voffA[2], voffB[2];
#pragma unroll
    for (int i = 0; i < 2; ++i) { int R, C; stage_rc(tid * 16 + i * 8192, R, C); const int Rb = Epi::PERM ? ((R & ~31) + perm32(R & 31)) : R;
        voffA[i] = (unsigned)(R * K + C) * 2u; voffB[i] = (unsigned)(Rb * K + C) * 2u; }
    const size_t kstep = (size_t)(BK * 2);
    const size_t hstep = (size_t)HALF * K * 2;
    const size_t tstep = 2 * hstep;
    const unsigned ldsw = (unsigned)wid * 1024u;
    const int aoff = lds_byte(wr * 64 + fr, fq * 8), boff = lds_byte(wc * 32 + fr, fq * 8);
#define PG8_SA(b, h) (((b) * 2 + (h)) * HTB)
#define PG8_SB(b, h) ((4 + (b) * 2 + (h)) * HTB)
#define PG8_STAGE(bufoff, gbase, voff) do { _Pragma("unroll") for (int _i = 0; _i < 2; ++_i) \
        __builtin_amdgcn_global_load_lds((const unsigned*)((const char*)(gbase) + (voff)[_i]), (LAS unsigned*)(lds + (bufoff) + ldsw + _i * 8192), 16, 0, 0); } while (0)
#define PG8_LDA(dst, b, h) do { _Pragma("unroll") for (int m = 0; m < 4; ++m) _Pragma("unroll") for (int k = 0; k < 2; ++k) dst[m][k] = *(const LAS bf16x8*)(lds + PG8_SA(b, h) + aoff + m * 2048 + k * 1024); } while (0)
#define PG8_LDB(dst, b, h) do { _Pragma("unroll") for (int n = 0; n < 2; ++n) _Pragma("unroll") for (int k = 0; k < 2; ++k) dst[n][k] = *(const LAS bf16x8*)(lds + PG8_SB(b, h) + boff + n * 2048 + k * 1024); } while (0)
#define PG8_MMA(ai, bj, At, Bt) do { __builtin_amdgcn_s_setprio(1); _Pragma("unroll") for (int m = 0; m < 4; ++m) _Pragma("unroll") for (int n = 0; n < 2; ++n) _Pragma("unroll") for (int k = 0; k < 2; ++k) \
        acc[ai][bj][m][n] = __builtin_amdgcn_mfma_f32_16x16x32_bf16(Bt[n][k], At[m][k], acc[ai][bj][m][n], 0, 0, 0); __builtin_amdgcn_s_setprio(0); } while (0)
#define PG8_WAIT_V(n) ASMV("s_waitcnt vmcnt(" #n ")" ::: "memory")
#define PG8_WAIT_L(n) ASMV("s_waitcnt lgkmcnt(" #n ")" ::: "memory")
#define PG8_BAR __builtin_amdgcn_s_barrier()
#define PG8_SCHED __builtin_amdgcn_sched_barrier(0)
    Unit cur, nxt; int ui = 0;
    if (!S.next(0, cur)) return;
    f32x4 acc[2][2][4][2];
#pragma unroll
    for (int a = 0; a < 2; ++a)
#pragma unroll
        for (int b = 0; b < 2; ++b)
#pragma unroll
            for (int m = 0; m < 4; ++m)
#pragma unroll
                for (int n = 0; n < 2; ++n) acc[a][b][m][n] = (f32x4){0.f, 0.f, 0.f, 0.f};
    bf16x8 At[4][2], B0[2][2], B1[2][2];
    const char* cA = (const char*)g.A + (size_t)cur.pm * tstep; const char* cB = (const char*)g.Bt + (size_t)cur.pn * tstep;
    S.a_ready(cur);
    if constexpr (SP2) {
        PG8_STAGE(PG8_SB(0, 0), cB, voffB); PG8_STAGE(PG8_SB(0, 1), cB + hstep, voffB); PG8_STAGE(PG8_SA(0, 0), cA, voffA); PG8_STAGE(PG8_SA(0, 1), cA + hstep, voffA);
        if (wr == 1) PG8_BAR;
        PG8_WAIT_V(2); PG8_BAR;
        PG8_STAGE(PG8_SB(1, 0), cB + kstep, voffB); PG8_STAGE(PG8_SA(1, 0), cA + kstep, voffA); PG8_STAGE(PG8_SB(1, 1), cB + hstep + kstep, voffB);
        PG8_WAIT_V(6); PG8_BAR;
    } else {
        PG8_STAGE(PG8_SB(0, 0), cB, voffB); PG8_STAGE(PG8_SA(0, 0), cA, voffA); PG8_STAGE(PG8_SB(0, 1), cB + hstep, voffB); PG8_STAGE(PG8_SA(0, 1), cA + hstep, voffA);
        if (wr == 1) PG8_BAR;
        PG8_WAIT_V(4); PG8_BAR;
        PG8_STAGE(PG8_SB(1, 0), cB + kstep, voffB); PG8_STAGE(PG8_SA(1, 0), cA + kstep, voffA); PG8_STAGE(PG8_SB(1, 1), cB + hstep + kstep, voffB);
        PG8_WAIT_V(6); PG8_BAR;
    }
    for (;;) {
        const bool has_next = S.next(ui + 1, nxt);
        const char* nA = has_next ? (const char*)g.A + (size_t)nxt.pm * tstep : cA; const char* nB = has_next ? (const char*)g.Bt + (size_t)nxt.pn * tstep : cB;
        for (int t = 0; t < nt; t += 2) {
            const bool last = (t == nt - 2);
            const char* a1 = cA + (size_t)(t + 1) * kstep;
            const char* a2 = last ? nA : cA + (size_t)(t + 2) * kstep; const char* b2 = last ? nB : cB + (size_t)(t + 2) * kstep;
            const char* a3 = a2 + kstep; const char* b3 = b2 + kstep;
            if (last && has_next) S.a_ready(nxt);
            if constexpr (SP2) {
            PG8_LDB(B0, 0, 0); PG8_LDB(B1, 0, 1); PG8_SCHED; PG8_LDA(At, 0, 0); PG8_STAGE(PG8_SA(1, 1), a1 + hstep, voffA);
            PG8_WAIT_V(8); PG8_WAIT_L(0); PG8_BAR; PG8_MMA(0, 0, At, B0); PG8_MMA(0, 1, At, B1); PG8_BAR; PG8_SCHED;
            PG8_LDA(At, 0, 1); PG8_STAGE(PG8_SB(0, 0), b2, voffB); PG8_STAGE(PG8_SB(0, 1), b2 + hstep, voffB); PG8_STAGE(PG8_SA(0, 0), a2, voffA);
            PG8_WAIT_V(8); PG8_WAIT_L(0); PG8_BAR; PG8_MMA(1, 0, At, B0); PG8_MMA(1, 1, At, B1); PG8_BAR; PG8_SCHED;
            PG8_LDB(B0, 1, 0); PG8_LDB(B1, 1, 1); PG8_SCHED; PG8_LDA(At, 1, 0); PG8_STAGE(PG8_SA(0, 1), a2 + hstep, voffA);
            PG8_WAIT_V(8); PG8_WAIT_L(0); PG8_BAR; PG8_MMA(0, 0, At, B0); PG8_MMA(0, 1, At, B1); PG8_BAR; PG8_SCHED;
            PG8_LDA(At, 1, 1); PG8_STAGE(PG8_SB(1, 0), b3, voffB); PG8_STAGE(PG8_SB(1, 1), b3 + hstep, voffB); PG8_STAGE(PG8_SA(1, 0), a3, voffA);
            PG8_WAIT_V(8); PG8_WAIT_L(0); PG8_BAR; PG8_MMA(1, 0, At, B0); PG8_MMA(1, 1, At, B1); PG8_BAR; PG8_SCHED;
            } else {
            PG8_LDB(B0, 0, 0); PG8_SCHED; PG8_LDA(At, 0, 0); PG8_STAGE(PG8_SA(1, 1), a1 + hstep, voffA);
            PG8_WAIT_L(8); PG8_BAR; PG8_WAIT_L(0); PG8_MMA(0, 0, At, B0); PG8_BAR; PG8_SCHED;
            PG8_LDB(B1, 0, 1); PG8_STAGE(PG8_SB(0, 0), b2, voffB);
            PG8_BAR; PG8_WAIT_L(0); PG8_MMA(0, 1, At, B1); PG8_BAR;
            PG8_LDA(At, 0, 1); PG8_STAGE(PG8_SA(0, 0), a2, voffA);
            PG8_BAR; PG8_WAIT_L(0); PG8_MMA(1, 0, At, B0); PG8_BAR; PG8_SCHED;
            PG8_STAGE(PG8_SB(0, 1), b2 + hstep, voffB);
            PG8_WAIT_V(6); PG8_BAR; PG8_MMA(1, 1, At, B1); PG8_BAR;
            PG8_LDB(B0, 1, 0); PG8_SCHED; PG8_LDA(At, 1, 0); PG8_STAGE(PG8_SA(0, 1), a2 + hstep, voffA);
            PG8_WAIT_L(8); PG8_BAR; PG8_WAIT_L(0); PG8_MMA(0, 0, At, B0); PG8_BAR; PG8_SCHED;
            PG8_LDB(B1, 1, 1); PG8_STAGE(PG8_SB(1, 0), b3, voffB);
            PG8_BAR; PG8_WAIT_L(0); PG8_MMA(0, 1, At, B1); PG8_BAR;
            PG8_LDA(At, 1, 1); PG8_STAGE(PG8_SA(1, 0), a3, voffA);
            PG8_BAR; PG8_WAIT_L(0); PG8_MMA(1, 0, At, B0); PG8_BAR; PG8_SCHED;
            PG8_STAGE(PG8_SB(1, 1), b3 + hstep, voffB);
            PG8_WAIT_V(6); PG8_BAR; PG8_MMA(1, 1, At, B1); PG8_BAR;
            }
        }
        if constexpr (ALIGN_EPI) { if (wr == 0) PG8_BAR; }
        if constexpr (!Epi::AFTER_DRAIN) { E(acc, cur, wr, wc, fr, fq); S.done(cur); }
        if (!has_next) break;
#pragma unroll
        for (int a = 0; a < 2; ++a)
#pragma unroll
            for (int b = 0; b < 2; ++b)
#pragma unroll
                for (int m = 0; m < 4; ++m)
#pragma unroll
                    for (int n = 0; n < 2; ++n) acc[a][b][m][n] = (f32x4){0.f, 0.f, 0.f, 0.f};
        cur = nxt; cA = nA; cB = nB; ++ui;
        if constexpr (ALIGN_EPI) { if (wr == 1) PG8_BAR; }
    }
    PG8_WAIT_V(0);
    if constexpr (!ALIGN_EPI) { if (wr == 0) PG8_BAR; }
    PG8_BAR;
    if constexpr (Epi::AFTER_DRAIN) { E.fused(acc, cur, wr, wc, fr, fq, lds, wid, lane); S.done(cur); }
#undef PG8_SA
#undef PG8_SB
#undef PG8_STAGE
#undef PG8_LDA
#undef PG8_LDB
#undef PG8_MMA
#undef PG8_WAIT_V
#undef PG8_WAIT_L
#undef PG8_BAR
#undef PG8_SCHED
}
}
typedef unsigned short bf16;
typedef unsigned v4u __attribute__((ext_vector_type(4)));
typedef unsigned v2u __attribute__((ext_vector_type(2)));
typedef float f32x4 __attribute__((ext_vector_type(4)));
typedef float f32x2 __attribute__((ext_vector_type(2)));
typedef float f32x16 __attribute__((ext_vector_type(16)));
typedef short bf16x8 __attribute__((ext_vector_type(8)));
typedef GAS unsigned gu32;
#define RLX_AGENT __ATOMIC_RELAXED, __HIP_MEMORY_SCOPE_AGENT
#ifdef EMU
#define LDS_WAIT() emu_wave_sync()
#else
#define LDS_WAIT() ASMV("s_waitcnt lgkmcnt(0)" ::: "memory")
#endif
#define VM_WAIT() ASMV("s_waitcnt vmcnt(0)" ::: "memory")
using pg8::cvt_pk_bf16;
__device__ __forceinline__ float bf2f(unsigned short h) { return __builtin_bit_cast(float, (unsigned)h << 16); }
__device__ __forceinline__ float bflo(unsigned w) { return __builtin_bit_cast(float, w << 16); }
__device__ __forceinline__ float bfhi(unsigned w) { return __builtin_bit_cast(float, w & 0xffff0000u); }
__device__ __forceinline__ float wave_sum(float v) {
#pragma unroll
    for (int o = 1; o < 64; o <<= 1) v += __shfl_xor(v, o);
    return v;
}
__device__ __forceinline__ float wave_max(float v) {
#pragma unroll
    for (int o = 1; o < 64; o <<= 1) v = fmaxf(v, __shfl_xor(v, o));
    return v;
}
__device__ __forceinline__ float gelu_tanh(float x) {
    constexpr float K1 = -2.0f * 1.4426950408889634f * 0.7978845608028654f, K2 = K1 * 0.044715f;
    const float t = x * __builtin_fmaf(x * x, K2, K1);
    return x * __builtin_amdgcn_rcpf(1.0f + __builtin_amdgcn_exp2f(t));
}
__device__ __forceinline__ float sigmoidf_(float x) { return __builtin_amdgcn_rcpf(1.0f + __builtin_amdgcn_exp2f(-1.4426950408889634f * x)); }
#define XB_TMO      128
#define XB_XCNT(j)  (256  + 64 * (j))
#define XB_XSUB(j)  (1280 + 64 * (j))
#define XB_XGEN(j)  (2304 + 64 * (j))
#define XB_TOP      3328
#define XB_TOPGEN   3392
#define XCD_BAR_WORDS 3456
#define XB_SPIN_CAP (1u << 18)

__device__ __forceinline__ unsigned xb_ld(unsigned* p)              { return __hip_atomic_load(p, __ATOMIC_RELAXED, __HIP_MEMORY_SCOPE_AGENT); }
__device__ __forceinline__ unsigned xb_add(unsigned* p, unsigned v) { return __hip_atomic_fetch_add(p, v, __ATOMIC_RELAXED, __HIP_MEMORY_SCOPE_AGENT); }
__device__ __forceinline__ unsigned xb_xcc_id() { return (unsigned)__builtin_amdgcn_s_getreg((3 << 11) | 20) & 0xFu; }
#define XB_SPIN(cond, bar) do { unsigned _sp = 0; while (cond) { __builtin_amdgcn_s_sleep(1); \
    if ((++_sp & 255u) == 0u) { if (xb_ld(&(bar)[XB_TMO])) break; if (_sp > XB_SPIN_CAP) { atomicAdd(&(bar)[XB_TMO], 1u); break; } } } } while (0)

struct XcdBarrier {
    unsigned* bar; unsigned x; unsigned wv;
    volatile LAS unsigned* st;
};

__device__ __forceinline__ XcdBarrier xcd_barrier_post(unsigned* bar, volatile LAS unsigned* st, unsigned wv) {
    XcdBarrier b; b.bar = bar; b.x = xb_xcc_id(); b.st = st; b.wv = wv;
    if (wv == 0u && lane_id() == 0) (void)xb_add(&bar[XB_XCNT(b.x)], 1u);
    return b;
}
__device__ __forceinline__ void xcd_barrier_complete(unsigned* bar, unsigned x, unsigned& nloc, unsigned& nx) {
    const unsigned G = gridDim.x * gridDim.y * gridDim.z;
    unsigned sum, cnt, mine, sp = 0u;
    for (;;) {
        sum = 0u; cnt = 0u; mine = 0u;
#pragma unroll
        for (unsigned j = 0; j < 16; ++j) { const unsigned c = xb_ld(&bar[XB_XCNT(j)]); sum += c; cnt += (c > 0u) ? 1u : 0u; mine = (j == x) ? c : mine; }
        if (sum == G) break;
        __builtin_amdgcn_s_sleep(1);
        if ((++sp & 255u) == 0u) { if (xb_ld(&bar[XB_TMO])) break; if (sp > XB_SPIN_CAP) { atomicAdd(&bar[XB_TMO], 1u); break; } }
    }
    nloc = mine > 0u ? mine : 1u; nx = cnt > 0u ? cnt : 1u;
}

__device__ __forceinline__ void xcd_barrier(const XcdBarrier& b) {
    ASMV("s_waitcnt vmcnt(0)" ::: "memory");
    __syncthreads();
    if (b.wv == 0u && lane_id() == 0) {
        unsigned* bar = b.bar; unsigned bx_ = b.x;
#ifndef EMU
        { unsigned long long p_ = (unsigned long long)bar; asm volatile("" : "+s"(p_), "+s"(bx_)); bar = (unsigned*)p_; }
#endif
        __builtin_amdgcn_s_waitcnt(0);
        unsigned nloc = b.st[0], nx = b.st[1];
        if (nloc == 0u) { xcd_barrier_complete(bar, bx_, nloc, nx); b.st[0] = nloc; b.st[1] = nx; }
        const unsigned old = xb_add(&bar[XB_XSUB(bx_)], 1u);
        const unsigned gen = old / nloc;
        if (old + 1u == (gen + 1u) * nloc) {
            __builtin_amdgcn_fence(__ATOMIC_RELEASE, "agent");
            ASMV("s_waitcnt vmcnt(0)" ::: "memory");
            const unsigned og = xb_add(&bar[XB_TOP], 1u);
            const unsigned tg = og / nx;
            if (og + 1u == (tg + 1u) * nx) xb_add(&bar[XB_TOPGEN], 1u);
            else XB_SPIN(xb_ld(&bar[XB_TOPGEN]) == tg, bar);
            __builtin_amdgcn_fence(__ATOMIC_ACQUIRE, "agent");
            xb_add(&bar[XB_XGEN(bx_)], 1u);
            ASMV("s_waitcnt vmcnt(0)" ::: "memory");
        } else {
            XB_SPIN(xb_ld(&bar[XB_XGEN(bx_)]) == gen, bar);
            __builtin_amdgcn_fence(__ATOMIC_ACQUIRE, "agent");
            ASMV("s_waitcnt vmcnt(0)" ::: "memory");
        }
    }
    __syncthreads();
}
constexpr int NWAVES = 8, NTHREADS = 512;
constexpr int RING_OFF = 0, RING_BYTES = 147456;
constexpr int LDSCTL_OFF = RING_BYTES, MISC_OFF = LDSCTL_OFF + 320;
constexpr int LDS_BYTES = 149504;
static_assert(MISC_OFF + 128 <= LDS_BYTES, "LDS map");
struct Frame {
    LAS unsigned char* lds;
    volatile LAS unsigned* MISC;
    gu32* ctl;
    int tid, lane, wave, vcu, G;
    const float* const* in;
    float* out;
    unsigned char* ws;
};
#ifdef EMU
#define AS_GLOBAL(T, p) ((T*)(p))
#else
#define AS_GLOBAL(T, p) ((T*)(GAS T*)(p))
#endif
template <class T> __device__ __forceinline__ T* wsp(const Frame& F, size_t off) { return AS_GLOBAL(T, F.ws + off); }
__device__ __forceinline__ const float* inp(const Frame& F, int i) { return AS_GLOBAL(const float, F.in[i]); }
__device__ __forceinline__ float* outp(const Frame& F) { return AS_GLOBAL(float, F.out); }

__device__ __forceinline__ int up_orig_col(int np) { return (np >> 8) * 128 + (np & 127) + ((np >> 7) & 1) * D_FF; }
__device__ __forceinline__ void st_bf16x8(bf16* p, const f32x4& a, const f32x4& b, float s) {
    v4u w; w.x = cvt_pk_bf16(a[0] * s, a[1] * s); w.y = cvt_pk_bf16(a[2] * s, a[3] * s); w.z = cvt_pk_bf16(b[0] * s, b[1] * s); w.w = cvt_pk_bf16(b[2] * s, b[3] * s);
    *(GAS v4u*)p = w;
}
#define EPI_BIG_LOOP \
    __device__ __forceinline__ void operator()(const f32x4 (&acc)[2][2][4][2], const pg8::Unit& u, int wr, int wc, int fr, int fq) const { \
    _Pragma("unroll") for (int ai = 0; ai < 2; ++ai) _Pragma("unroll") for (int m = 0; m < 4; ++m) { const int row = u.pm * 256 + ai * 128 + wr * 64 + m * 16 + fr; if (row < MT) { \
    _Pragma("unroll") for (int bj = 0; bj < 2; ++bj) put(row, u.pn * 256 + bj * 128 + wc * 32 + 8 * fq, u.pn, 0, acc[ai][bj][m][0], acc[ai][bj][m][1]); } } }

struct EpiNsaIn {
    static constexpr bool PERM = true, AFTER_DRAIN = false;
    unsigned char* ws; float* out;
    __device__ __forceinline__ void put(int row, int col, int pn, int ks, const f32x4& v0, const f32x4& v1) const {
            bf16* const Q = AS_GLOBAL(bf16, ws + WS_Q); bf16* const KVB = AS_GLOBAL(bf16, ws + WS_KVB); bf16* const WINB = AS_GLOBAL(bf16, ws + WS_WINB); float* const GATES = AS_GLOBAL(float, ws + WS_GATES);
            if (pn < 4) { st_bf16x8(Q + (size_t)row * 1024 + col, v0, v1, QSCALE); }
            else if (pn < 8) { const int c = col - 1024; st_bf16x8(KVB + (size_t)row * 1024 + c, v0, v1, 1.f);
                float* o = AS_GLOBAL(float, out) + O_KV + (size_t)row * 1024 + c; *(GAS f32x4*)o = v0; *(GAS f32x4*)(o + 4) = v1; }
            else if (pn < 10) { const int c = col - 2048; st_bf16x8(WINB + (size_t)row * 512 + c, v0, v1, 1.f);
                float* o = nullptr;
                if (row < MPR) { const int b = row / SEQ, t = row % SEQ; if (t >= SEQ - WKEEP) o = AS_GLOBAL(float, out) + O_WINP + ((size_t)b * WKEEP + (t - (SEQ - WKEEP))) * 512 + c; }
                else { const int r = row - MPR, b = r / DEC_SEQ, t = r % DEC_SEQ; o = AS_GLOBAL(float, out) + O_WINS + ((size_t)b * WB_LEN + (WB_LEN - DEC_SEQ + t)) * 512 + c; }
                if (o) { *(GAS f32x4*)o = v0; *(GAS f32x4*)(o + 4) = v1; } }
            else { const int c = col - 2560; if (c < 48) { float* o = GATES + (size_t)row * 48 + c; *(GAS f32x4*)o = v0; *(GAS f32x4*)(o + 4) = v1; } }
            }
    EPI_BIG_LOOP
};
struct EpiF32 {
    static constexpr bool PERM = true, AFTER_DRAIN = false;
    unsigned char* ws;
    __device__ __forceinline__ void put(int row, int col, int pn, int ks, const f32x4& v0, const f32x4& v1) const {
            float* const Y = AS_GLOBAL(float, ws + WS_Y); float* const YS = AS_GLOBAL(float, ws + WS_YS); constexpr int ldc = D;
            float* o = row < MPR ? Y + (size_t)row * ldc + col : YS + ((size_t)ks * MSA + (row - MPR)) * ldc + col; *(GAS f32x4*)o = v0; *(GAS f32x4*)(o + 4) = v1;
            }
    EPI_BIG_LOOP
};
constexpr int UPX_OFF = 131072;
constexpr int UPT_OFF = UPX_OFF + 4 * 2 * 256 * 4;
static_assert(UPT_OFF + 4 * 256 * 4 <= RING_BYTES && pg8::STAGE_BYTES <= UPX_OFF, "exchange region");
template <int N> __device__ __forceinline__ f32x4 ror4(const f32x4& v) {
    f32x4 r;
#pragma unroll
    for (int e = 0; e < 4; ++e) { const float x = v[e]; r[e] = __builtin_bit_cast(float, __builtin_amdgcn_update_dpp(0, __builtin_bit_cast(int, x), 0x120 + N, 0xf, 0xf, false)); }
    return r; }
__device__ __forceinline__ f32x4 shfl4(const f32x4& v, int src) { f32x4 r; r[0] = __shfl(v[0], src); r[1] = __shfl(v[1], src); r[2] = __shfl(v[2], src); r[3] = __shfl(v[3], src); return r; }
struct EpiUpConv {
    static constexpr bool PERM = true, AFTER_DRAIN = false;
    unsigned char* ws; float* out; const float* const* in; int layer; LAS float* exch;
    __device__ __forceinline__ void st4(bf16* p, const f32x4& v) const { v2u w; w.x = cvt_pk_bf16(v[0], v[1]); w.y = cvt_pk_bf16(v[2], v[3]); *(GAS v2u*)p = w; }
    __device__ __forceinline__ void put(int row, int col, int pn, int ks, const f32x4& v0, const f32x4& v1) const {
        bf16* const U = AS_GLOBAL(bf16, ws + WS_U); const int oc = up_orig_col(col), r = row - MPR, b = r / DEC_SEQ, t = r % DEC_SEQ;
        st4(U + (size_t)row * FF2 + oc, v0); st4(U + (size_t)row * FF2 + oc + 4, v1);
        if (t >= DEC_SEQ - 2) { float* o = AS_GLOBAL(float, out) + O_CVS + (((size_t)layer * DEC_BATCH + b) * 2 + (t - (DEC_SEQ - 2))) * FF2 + oc; *(GAS f32x4*)o = v0; *(GAS f32x4*)(o + 4) = v1; }
    }
    __device__ __forceinline__ void operator()(const f32x4 (&acc)[2][2][4][2], const pg8::Unit& u, int wr, int wc, int fr, int fq) const {
        const int lane = fq * 16 + fr, gcol0 = 128 * u.pn + 32 * wc + 8 * fq;
        bf16* const ACT = AS_GLOBAL(bf16, ws + WS_ACT); bf16* const U = AS_GLOBAL(bf16, ws + WS_U); bf16* const UB = AS_GLOBAL(bf16, ws + WS_UB);
        if (u.pm >= MPR / 256) {
#pragma unroll
            for (int ai = 0; ai < 2; ++ai)
#pragma unroll
                for (int m = 0; m < 4; ++m) { const int row = u.pm * 256 + ai * 128 + wr * 64 + m * 16 + fr; if (row < MT) { const int r = row - MPR, b = r / DEC_SEQ, t = r % DEC_SEQ;
#pragma unroll
                    for (int bj = 0; bj < 2; ++bj)
#pragma unroll
                        for (int n = 0; n < 2; ++n) { const int col = bj * D_FF + gcol0 + 4 * n; st4(U + (size_t)row * FF2 + col, acc[ai][bj][m][n]);
                            if (t >= DEC_SEQ - 2) *(GAS f32x4*)(AS_GLOBAL(float, out) + O_CVS + (((size_t)layer * DEC_BATCH + b) * 2 + (t - (DEC_SEQ - 2))) * FF2 + col) = acc[ai][bj][m][n]; } } }
            return;
        }
        LAS float* taps = exch + 4 * 2 * 256;
        { const int tid = (wr * 4 + wc) * 64 + lane, ci = tid & 255, hf = tid >> 8, oc = (ci >> 7) * D_FF + 128 * u.pn + (ci & 127);
          const float* cw = AS_GLOBAL(const float, in[20]) + (size_t)layer * 3 * FF2; const float* cb = AS_GLOBAL(const float, in[21]) + (size_t)layer * FF2;
          taps[(2 * hf) * 256 + ci] = hf ? cw[2 * FF2 + oc] : cw[oc]; taps[(2 * hf + 1) * 256 + ci] = hf ? cb[oc] : cw[FF2 + oc]; }
        if (fr >= 14) {
#pragma unroll
            for (int ai = 0; ai < 2; ++ai)
#pragma unroll
                for (int bj = 0; bj < 2; ++bj)
#pragma unroll
                    for (int n = 0; n < 2; ++n) *(LAS f32x4*)(exch + ((ai * 2 + wr) * 2 + (fr - 14)) * 256 + 128 * bj + 32 * wc + 8 * fq + 4 * n) = acc[ai][bj][3][n]; }
        LDS_WAIT(); __builtin_amdgcn_s_barrier(); ASMV("" ::: "memory");
        const int s1 = (lane & 48) | ((lane - 1) & 15), s2 = (lane & 48) | ((lane - 2) & 15);
        constexpr int TPS = SEQ / 256;
        const bool seq_last = (u.pm % TPS) == TPS - 1; const int bseq = u.pm / TPS;
#pragma unroll
        for (int n = 0; n < 2; ++n) {
            f32x4 w0[2], w1[2], w2[2], bb[2];
#pragma unroll
            for (int bj = 0; bj < 2; ++bj) { const LAS float* tp = taps + 128 * bj + 32 * wc + 8 * fq + 4 * n; w0[bj] = *(const LAS f32x4*)tp; w1[bj] = *(const LAS f32x4*)(tp + 256); w2[bj] = *(const LAS f32x4*)(tp + 512); bb[bj] = *(const LAS f32x4*)(tp + 768); }
#pragma unroll
            for (int ai = 0; ai < 2; ++ai) {
                const int gp = ai * 2 + wr - 1; f32x4 h62[2], h63[2];
#pragma unroll
                for (int bj = 0; bj < 2; ++bj) { const int gpc = gp < 0 ? 0 : gp; const LAS float* hp = exch + (gpc * 2) * 256 + 128 * bj + 32 * wc + 8 * fq + 4 * n; h62[bj] = *(const LAS f32x4*)hp; h63[bj] = *(const LAS f32x4*)(hp + 256); }
#pragma unroll
                for (int m = 0; m < 4; ++m) { f32x4 c[2];
#pragma unroll
                    for (int bj = 0; bj < 2; ++bj) { const f32x4 cur = acc[ai][bj][m][n];
                        f32x4 p1, p2; if (m == 0) { p1 = h63[bj]; p2 = fr == 14 ? h62[bj] : h63[bj]; } else { p1 = acc[ai][bj][m > 0 ? m - 1 : 0][n]; p2 = p1; }
                        const f32x4 x1 = shfl4(fr == 15 ? p1 : cur, s1), x2 = shfl4(fr >= 14 ? p2 : cur, s2);
                        c[bj] = bb[bj] + w0[bj] * x2 + w1[bj] * x1 + w2[bj] * cur; }
                    const int row = u.pm * 256 + ai * 128 + wr * 64 + m * 16 + fr;
                    if (!(gp < 0 && m == 0 && fr < 2)) { f32x4 a; a[0] = gelu_tanh(c[0][0]) * c[1][0]; a[1] = gelu_tanh(c[0][1]) * c[1][1]; a[2] = gelu_tanh(c[0][2]) * c[1][2]; a[3] = gelu_tanh(c[0][3]) * c[1][3];
                        st4(ACT + (size_t)row * D_FF + gcol0 + 4 * n, a); }
                }
            }
            __builtin_amdgcn_sched_barrier(0);
#pragma unroll
            for (int bj = 0; bj < 2; ++bj) { const int col = bj * D_FF + gcol0 + 4 * n;
                if (wr == 0 && fr < 2) st4(UB + ((size_t)u.pm * 4 + fr) * FF2 + col, acc[0][bj][0][n]);
                if (wr == 1 && fr >= 14) { st4(UB + ((size_t)u.pm * 4 + 2 + (fr - 14)) * FF2 + col, acc[1][bj][3][n]);
                    if (seq_last) *(GAS f32x4*)(AS_GLOBAL(float, out) + O_CVP + (((size_t)layer * BATCH + bseq) * 2 + (fr - 14)) * FF2 + col) = acc[1][bj][3][n]; } }
            __builtin_amdgcn_sched_barrier(0);
        }
    }
};
struct EpiMlIn {
    static constexpr bool PERM = true, AFTER_DRAIN = false;
    unsigned char* ws;
    __device__ __forceinline__ void put(int row, int col, int pn, int ks, const f32x4& v0, const f32x4& v1) const {
            bf16* const MQ = AS_GLOBAL(bf16, ws + WS_MQ); bf16* const MK = AS_GLOBAL(bf16, ws + WS_MK); bf16* const MV = AS_GLOBAL(bf16, ws + WS_MV); bf16* const MO = AS_GLOBAL(bf16, ws + WS_MO); float* const MG = AS_GLOBAL(float, ws + WS_MG);
            if (pn < 2) st_bf16x8(MQ + (size_t)row * 512 + col, v0, v1, 1.f);
            else if (pn < 4) st_bf16x8(MK + (size_t)row * 512 + (col - 512), v0, v1, 0.125f);
            else if (pn < 8) st_bf16x8(MV + (size_t)row * 1024 + (col - 1024), v0, v1, 1.f);
            else if (pn < 12) st_bf16x8(MO + (size_t)row * 1024 + (col - 2048), v0, v1, 1.f);
            else { const int c = col - 3072; if (c < 16) { float* o = MG + (size_t)row * 16 + c; *(GAS f32x4*)o = v0; *(GAS f32x4*)(o + 4) = v1; } }
            }
    EPI_BIG_LOOP
};

constexpr int CW_PAN = 16384;
struct EpiRmsRes {
    static constexpr bool PERM = true, AFTER_DRAIN = true;
    unsigned char* ws; float* out; const float* ga; const float* gb; gu32* ctl; int site;
    __device__ __forceinline__ bool stats(const f32x4 (&v)[2][2][4][2], const pg8::Unit& u, int wr, int wc, int fr, int fq, LAS unsigned char* lds, int wid, int lane, int e) const {
        LAS float* P = (LAS float*)lds; LAS float* S = (LAS float*)(lds + 4096); LAS unsigned* flag = (LAS unsigned*)(lds + 4096 + 1024);
        GAS float* slots = (GAS float*)AS_GLOBAL(float, ws + WS_XS) + (size_t)(site * 2 + e) * MPR * 4; gu32* cnt = ctl + CW_PAN + ((site * 2 + e) * 64 + u.pm) * 64;
#pragma unroll
        for (int ai = 0; ai < 2; ++ai)
#pragma unroll
            for (int m = 0; m < 4; ++m) { float q = 0.f;
#pragma unroll
                for (int bj = 0; bj < 2; ++bj)
#pragma unroll
                    for (int n = 0; n < 2; ++n) { const f32x4 x = v[ai][bj][m][n]; q += (x[0] * x[0] + x[1] * x[1]) + (x[2] * x[2] + x[3] * x[3]); }
                q += __shfl_xor(q, 16); q += __shfl_xor(q, 32);
                if (fq == 0) P[(ai * 128 + wr * 64 + m * 16 + fr) * 4 + wc] = q; }
        LDS_WAIT(); __builtin_amdgcn_s_barrier(); ASMV("" ::: "memory");
        const int row = wid * 32 + (lane & 31);
        if (lane < 32) { const float tot = (P[row * 4] + P[row * 4 + 1]) + (P[row * 4 + 2] + P[row * 4 + 3]);
            __hip_atomic_store((GAS unsigned*)(slots + ((size_t)u.pm * 256 + row) * 4 + u.pn), __builtin_bit_cast(unsigned, tot), __ATOMIC_RELAXED, __HIP_MEMORY_SCOPE_AGENT); }
        ASMV("s_waitcnt vmcnt(0)" ::: "memory");
        if (lane == 0) __hip_atomic_fetch_add(cnt, 1u, __ATOMIC_RELAXED, __HIP_MEMORY_SCOPE_AGENT);
        if (wid == 0) { bool dead = false; unsigned spins = 0;
            for (;;) { if ((unsigned)__builtin_amdgcn_readfirstlane((int)__hip_atomic_load(cnt, __ATOMIC_RELAXED, __HIP_MEMORY_SCOPE_AGENT)) >= 32u) break;
                if (++spins > (1u << 22)) { if (lane == 0) __hip_atomic_store(ctl + CW_TMO, 1u, __ATOMIC_RELAXED, __HIP_MEMORY_SCOPE_AGENT); dead = true; break; }
                __builtin_amdgcn_s_sleep(2); }
            __builtin_amdgcn_fence(__ATOMIC_ACQUIRE, "agent");
            if (lane == 0) flag[0] = dead ? 1u : 0u; }
        ASMV("s_waitcnt vmcnt(0) lgkmcnt(0)" ::: "memory"); LDS_WAIT(); __builtin_amdgcn_s_barrier(); ASMV("" ::: "memory");
        const bool bad = flag[0] != 0u;
        if (lane < 32) { const GAS unsigned* sp = (const GAS unsigned*)(slots + ((size_t)u.pm * 256 + row) * 4); float q = 0.f;
#pragma unroll
            for (int t = 0; t < 4; ++t) q += __builtin_bit_cast(float, __hip_atomic_load(sp + t, __ATOMIC_RELAXED, __HIP_MEMORY_SCOPE_AGENT));
            S[row] = 1.0f / sqrtf(q * (1.0f / D) + RMS_EPS); }
        LDS_WAIT(); __builtin_amdgcn_s_barrier(); ASMV("" ::: "memory");
        return bad;
    }
    __device__ __forceinline__ void fused(f32x4 (&acc)[2][2][4][2], const pg8::Unit& u, int wr, int wc, int fr, int fq, LAS unsigned char* lds, int wid, int lane) const {
        const LAS float* S = (const LAS float*)(lds + 4096); const int col0 = u.pn * 256 + wc * 32 + 8 * fq;
        GAS float* xres = (GAS float*)AS_GLOBAL(float, out) + O_Y; const float qnan = __builtin_nanf("");
        bool bad = stats(acc, u, wr, wc, fr, fq, lds, wid, lane, 0);
        f32x4 g[2][2];
#pragma unroll
        for (int bj = 0; bj < 2; ++bj)
#pragma unroll
            for (int n = 0; n < 2; ++n) g[bj][n] = *(const GAS f32x4*)(ga + col0 + bj * 128 + 4 * n);
#pragma unroll
        for (int ai = 0; ai < 2; ++ai)
#pragma unroll
            for (int m = 0; m < 4; ++m) { const int r = ai * 128 + wr * 64 + m * 16 + fr; const float rs = S[r]; GAS float* xp = xres + (size_t)(u.pm * 256 + r) * D + col0;
#pragma unroll
                for (int bj = 0; bj < 2; ++bj)
#pragma unroll
                    for (int n = 0; n < 2; ++n) { const f32x4 x = *(const GAS f32x4*)(xp + bj * 128 + 4 * n); f32x4 o = x + acc[ai][bj][m][n] * rs * g[bj][n];
                        if (bad) o = (f32x4){qnan, qnan, qnan, qnan}; acc[ai][bj][m][n] = o; if (!gb) *(GAS f32x4*)(xp + bj * 128 + 4 * n) = o; }
                ASMV("" : "+v"(acc[ai][0][m][0]), "+v"(acc[ai][0][m][1]), "+v"(acc[ai][1][m][0]), "+v"(acc[ai][1][m][1]));
                if (m & 1) ASMV("" ::: "memory"); }
        if (!gb) return;
        bad = stats(acc, u, wr, wc, fr, fq, lds, wid, lane, 1) || bad;
#pragma unroll
        for (int bj = 0; bj < 2; ++bj)
#pragma unroll
            for (int n = 0; n < 2; ++n) g[bj][n] = *(const GAS f32x4*)(gb + col0 + bj * 128 + 4 * n);
        GAS bf16* H = (GAS bf16*)AS_GLOBAL(bf16, ws + WS_H);
#pragma unroll
        for (int ai = 0; ai < 2; ++ai)
#pragma unroll
            for (int m = 0; m < 4; ++m) { const int r = ai * 128 + wr * 64 + m * 16 + fr; const float rs = bad ? qnan : S[r]; const size_t ro = (size_t)(u.pm * 256 + r) * D + col0;
#pragma unroll
                for (int bj = 0; bj < 2; ++bj) { const f32x4 a = acc[ai][bj][m][0], b = acc[ai][bj][m][1];
                    *(GAS f32x4*)(xres + ro + bj * 128) = a; *(GAS f32x4*)(xres + ro + bj * 128 + 4) = b;
                    const f32x4 ha = a * rs * g[bj][0], hb = b * rs * g[bj][1]; v4u w; w.x = cvt_pk_bf16(ha[0], ha[1]); w.y = cvt_pk_bf16(ha[2], ha[3]); w.z = cvt_pk_bf16(hb[0], hb[1]); w.w = cvt_pk_bf16(hb[2], hb[3]);
                    *(GAS v4u*)(H + ro + bj * 128) = w; }
                ASMV("" ::: "memory"); }
    }
    __device__ __forceinline__ void put(int row, int col, int pn, int ks, const f32x4& v0, const f32x4& v1) const {
        float* o = AS_GLOBAL(float, ws + WS_YS) + ((size_t)ks * MSA + (row - MPR)) * D + col; *(GAS f32x4*)o = v0; *(GAS f32x4*)(o + 4) = v1; }
};
template <class Epi> __device__ __forceinline__ void mini_gemm(const Frame& F, const bf16* A, const bf16* Bt, int row_lo, int nrows, int col_lo, int ncols, int K, int ksplit, const Epi& E) {
    const int lane = F.lane, fr = lane & 15, fq = lane >> 4, gw = F.vcu * NWAVES + F.wave, NGW = F.G * NWAVES;
    const int nct = ncols / 32, nrt = (nrows + 15) / 16, ntile = nrt * nct, klen = K / ksplit;
    for (int un = gw; un < ntile * ksplit; un += NGW) {
        const int ks = un / ntile, t = un % ntile, rt = t / nct, ct = t % nct, row = row_lo + rt * 16 + fr, colb = col_lo + ct * 32;
        const GAS bf16* ap = (const GAS bf16*)A + (size_t)(row < row_lo + nrows ? row : row_lo) * K + ks * klen + fq * 8;
        const GAS bf16* bp0 = (const GAS bf16*)Bt + (size_t)(colb + 8 * (fr >> 2) + (fr & 3)) * K + ks * klen + fq * 8; const GAS bf16* bp1 = bp0 + (size_t)4 * K;
        f32x4 acc0 = (f32x4){0.f, 0.f, 0.f, 0.f}, acc1 = acc0;
        for (int k0 = 0; k0 < klen; k0 += 256) {
            bf16x8 a[8], b0[8], b1[8];
#pragma unroll
            for (int i = 0; i < 8; ++i) { a[i] = *(const GAS bf16x8*)(ap + k0 + 32 * i); b0[i] = *(const GAS bf16x8*)(bp0 + k0 + 32 * i); b1[i] = *(const GAS bf16x8*)(bp1 + k0 + 32 * i); }
#pragma unroll
            for (int i = 0; i < 8; ++i) { acc0 = __builtin_amdgcn_mfma_f32_16x16x32_bf16(b0[i], a[i], acc0, 0, 0, 0); acc1 = __builtin_amdgcn_mfma_f32_16x16x32_bf16(b1[i], a[i], acc1, 0, 0, 0); }
        }
        if (row < row_lo + nrows) E.put(row, colb + 8 * fq, colb >> 8, ks, acc0, acc1);
    }
}
__device__ __forceinline__ void transpose_item(const float* W, int K, int N, int Npad, bf16* WT, LAS float* scr, int item, int lane, bool upmap = false) {
    const int nblk = Npad / 32, kb = item / nblk, nb = item % nblk, k0 = 64 * kb, n0 = 32 * nb;
    const int nn = (upmap ? up_orig_col(n0) : n0) + (lane & 31);
#pragma unroll
    for (int hb = 0; hb < 2; ++hb) { float tv[16];
#pragma unroll
        for (int i = 0; i < 16; ++i) { const int kk = 2 * (16 * hb + i) + (lane >> 5); tv[i] = nn < N ? ((const GAS float*)W)[(size_t)(k0 + kk) * N + nn] : 0.f; }
#pragma unroll
        for (int i = 0; i < 16; ++i) scr[(2 * (16 * hb + i) + (lane >> 5)) * 33 + (lane & 31)] = tv[i]; }
    LDS_WAIT(); ASMV("" ::: "memory");
    const int c = lane & 7;
#pragma unroll
    for (int j = 0; j < 4; ++j) { const int n = (lane >> 3) + 8 * j; const LAS float* s = scr + (8 * c) * 33 + n;
        v4u o; o.x = cvt_pk_bf16(s[0 * 33], s[1 * 33]); o.y = cvt_pk_bf16(s[2 * 33], s[3 * 33]); o.z = cvt_pk_bf16(s[4 * 33], s[5 * 33]); o.w = cvt_pk_bf16(s[6 * 33], s[7 * 33]);
        *(GAS v4u*)(WT + (size_t)(n0 + n) * K + k0 + 8 * c) = o; }
    LDS_WAIT(); ASMV("" ::: "memory");
}
__device__ __forceinline__ const float* x_in_row(const Frame& F, int m) { return m < MPR ? inp(F, 0) + (size_t)m * D : inp(F, 1) + (size_t)(m - MPR) * D; }
__device__ __forceinline__ void rms_rows2_to_bf16(const Frame& F, int m0, int m1, bool two, const float* g) {
    typedef const GAS f32x4* gcp; const int mm[2] = {m0, two ? m1 : m0}; f32x4 v[2][4];
#pragma unroll
    for (int q = 0; q < 2; ++q) { gcp xr = (gcp)x_in_row(F, mm[q]) + F.lane;
#pragma unroll
        for (int j = 0; j < 4; ++j) v[q][j] = xr[64 * j]; }
#pragma unroll
    for (int q = 0; q < 2; ++q) { if (q == 1 && !two) break; const int m = mm[q]; float s = 0.f;
#pragma unroll
        for (int j = 0; j < 4; ++j) s += (v[q][j].x * v[q][j].x + v[q][j].y * v[q][j].y) + (v[q][j].z * v[q][j].z + v[q][j].w * v[q][j].w);
        const float rstd = 1.f / sqrtf(wave_sum(s) * (1.f / D) + RMS_EPS);
        GAS v2u* o8 = (GAS v2u*)(wsp<bf16>(F, WS_H) + (size_t)m * D) + F.lane; GAS f32x4* xc = (GAS f32x4*)(outp(F) + O_Y + (size_t)m * D) + F.lane;
#pragma unroll
        for (int j = 0; j < 4; ++j) { const f32x4 gg = ((gcp)g + F.lane)[64 * j]; xc[64 * j] = v[q][j];
            v2u w; w.x = cvt_pk_bf16(v[q][j].x * rstd * gg.x, v[q][j].y * rstd * gg.y); w.y = cvt_pk_bf16(v[q][j].z * rstd * gg.z, v[q][j].w * rstd * gg.w); o8[64 * j] = w; } }
}
__device__ __forceinline__ void p0_prologue(Frame& F) {
    LAS float* scr = (LAS float*)(F.lds + RING_OFF + F.wave * 16384);
    const int gw = F.vcu * NWAVES + F.wave, NGW = F.G * NWAVES;
    constexpr int I_NI = (D / 64) * (NSA_IN_PAD / 32), I_DD = (D / 64) * (D / 32), I_MI = (D / 64) * (ML_IN_PAD / 32), I_UP = (D / 64) * (FF2 / 32), I_DN = (D_FF / 64) * (D / 32);
    constexpr int NITEMS = I_NI + 2 * I_DD + I_MI + 2 * I_UP + 2 * I_DN;
    for (int it = gw; it < NITEMS; it += NGW) {
        int r = it;
        if (r < I_NI) { transpose_item(inp(F, 10), D, NSA_IN, NSA_IN_PAD, wsp<bf16>(F, WS_WNSAIN), scr, r, F.lane); continue; } r -= I_NI;
        if (r < I_DD) { transpose_item(inp(F, 11), D, D, D, wsp<bf16>(F, WS_WNSAOUT), scr, r, F.lane); continue; } r -= I_DD;
        if (r < I_MI) { transpose_item(inp(F, 15), D, ML_IN, ML_IN_PAD, wsp<bf16>(F, WS_WMLIN), scr, r, F.lane); continue; } r -= I_MI;
        if (r < I_DD) { transpose_item(inp(F, 18), D, D, D, wsp<bf16>(F, WS_WMLOUT), scr, r, F.lane); continue; } r -= I_DD;
        if (r < 2 * I_UP) { const int l = r / I_UP; transpose_item(inp(F, 19) + (size_t)l * D * FF2, D, FF2, FF2, wsp<bf16>(F, WS_WUP) + (size_t)l * FF2 * D, scr, r % I_UP, F.lane, true); continue; } r -= 2 * I_UP;
        { const int l = r / I_DN; transpose_item(inp(F, 22) + (size_t)l * D_FF * D, D_FF, D, D, wsp<bf16>(F, WS_WDOWN) + (size_t)l * D * D_FF, scr, r % I_DN, F.lane); }
    }
    for (int m = gw; m < MT; m += 2 * NGW) rms_rows2_to_bf16(F, m, m + NGW, m + NGW < MT, inp(F, 9));
    { const size_t per_b = (size_t)(WB_LEN - DEC_SEQ) * 512 / 4, total = per_b * DEC_BATCH;
      for (size_t i = (size_t)blockIdx.x * NTHREADS + F.tid; i < total; i += (size_t)F.G * NTHREADS) { const size_t b = i / per_b, r = i % per_b;
          ((f32x4*)(outp(F) + O_WINS + b * WB_LEN * 512))[r] = ((const f32x4*)(inp(F, 3) + b * WB_LEN * 512 + DEC_SEQ * 512))[r]; } }
}
constexpr int NSN = (MSA + NWAVES - 1) / NWAVES, CW_SN = 60000;
__device__ __forceinline__ void norm_phase(Frame& F, int row_lo, const float* Y, const float* YS, int ksplit, const float* ga, const float* gb, bf16* H, gu32* gate = nullptr, int wg_base = 0) {
    const int vrel = (int)blockIdx.x - wg_base;
    if (gate && (vrel < 0 || vrel >= NSN)) return;
    const int gw = row_lo + (gate ? vrel : F.vcu) * NWAVES + F.wave, NGW = (gate ? NSN : F.G) * NWAVES;
    typedef const GAS f32x4* gcp; typedef GAS f32x4* gp4;
    f32x4 gA[4], gB[4];
#pragma unroll
    for (int j = 0; j < 4; ++j) { gA[j] = ((gcp)ga + F.lane)[64 * j]; gB[j] = gb ? ((gcp)gb + F.lane)[64 * j] : (f32x4){0.f, 0.f, 0.f, 0.f}; }
    for (int m0 = gw; m0 < MT; m0 += 2 * NGW) {
        const int m1 = m0 + NGW; const bool two = m1 < MT; const int mm[2] = {m0, two ? m1 : m0};
        f32x4 y[2][4], x[2][4];
#pragma unroll
        for (int q = 0; q < 2; ++q) { const int m = mm[q]; gcp yr = (gcp)(Y + (size_t)m * D) + F.lane; gcp xr = (gcp)(outp(F) + O_Y + (size_t)m * D) + F.lane;
#pragma unroll
            for (int j = 0; j < 4; ++j) { y[q][j] = yr[64 * j]; x[q][j] = xr[64 * j]; } }
#pragma unroll
        for (int q = 0; q < 2; ++q) { const int m = mm[q];
            if (m >= MPR) {
#pragma unroll
                for (int j = 0; j < 4; ++j) { y[q][j] = (f32x4){0.f, 0.f, 0.f, 0.f}; for (int k = 0; k < ksplit; ++k) y[q][j] = y[q][j] + ((gcp)(YS + ((size_t)k * MSA + (m - MPR)) * D) + F.lane)[64 * j]; } } }
#pragma unroll
        for (int q = 0; q < 2; ++q) { const int m = mm[q]; if (q == 1 && !two) break;
            float s = 0.f;
#pragma unroll
            for (int j = 0; j < 4; ++j) s += (y[q][j].x * y[q][j].x + y[q][j].y * y[q][j].y) + (y[q][j].z * y[q][j].z + y[q][j].w * y[q][j].w);
            const float r1 = 1.f / sqrtf(wave_sum(s) * (1.f / D) + RMS_EPS); float s2 = 0.f; gp4 xw = (gp4)(outp(F) + O_Y + (size_t)m * D) + F.lane;
#pragma unroll
            for (int j = 0; j < 4; ++j) { x[q][j] = x[q][j] + y[q][j] * r1 * gA[j]; xw[64 * j] = x[q][j];
                s2 += (x[q][j].x * x[q][j].x + x[q][j].y * x[q][j].y) + (x[q][j].z * x[q][j].z + x[q][j].w * x[q][j].w); }
            if (gb) { const float r2 = 1.f / sqrtf(wave_sum(s2) * (1.f / D) + RMS_EPS); GAS v2u* o8 = (GAS v2u*)(H + (size_t)m * D) + F.lane;
#pragma unroll
                for (int j = 0; j < 4; ++j) { v2u w; w.x = cvt_pk_bf16(x[q][j].x * r2 * gB[j].x, x[q][j].y * r2 * gB[j].y); w.y = cvt_pk_bf16(x[q][j].z * r2 * gB[j].z, x[q][j].w * r2 * gB[j].w);
                    if (gate) __hip_atomic_store((GAS unsigned long long*)(o8 + 64 * j), ((unsigned long long)w.y << 32) | w.x, __ATOMIC_RELAXED, __HIP_MEMORY_SCOPE_AGENT); else o8[64 * j] = w; } }
        }
        if (gate) { ASMV("s_waitcnt vmcnt(0)" ::: "memory"); if (F.lane == 0) __hip_atomic_fetch_add(gate, two ? 2u : 1u, __ATOMIC_RELAXED, __HIP_MEMORY_SCOPE_AGENT); }
    }
}
struct GatedOrder : pg8::StaticOrder {
    gu32* gate; gu32* tmo;
    __device__ __forceinline__ void a_ready(const pg8::Unit& u) const {
        if (u.pm == MPR / 256) { unsigned spins = 0;
            while (__hip_atomic_load(gate, __ATOMIC_RELAXED, __HIP_MEMORY_SCOPE_AGENT) < (unsigned)MSA) { __builtin_amdgcn_s_sleep(2); if (++spins > (1u << 22)) { __hip_atomic_store(tmo, 1u, __ATOMIC_RELAXED, __HIP_MEMORY_SCOPE_AGENT); break; } }
            __builtin_amdgcn_fence(__ATOMIC_ACQUIRE, "agent"); } }
};
__device__ __forceinline__ void conv_fix_phase(Frame& F, int layer) {
    constexpr int NCB = D_FF / 512, NPT = MPR / 256, TPS = SEQ / 256, UNITS_P = NPT * NCB, UNITS_S = DEC_BATCH * NCB;
    const bf16* U = wsp<bf16>(F, WS_U); const bf16* UB = wsp<bf16>(F, WS_UB); bf16* ACT = wsp<bf16>(F, WS_ACT);
    const float* cw = inp(F, 20) + (size_t)layer * 3 * FF2; const float* cb = inp(F, 21) + (size_t)layer * FF2; const float* sbuf = inp(F, 7) + (size_t)layer * DEC_BATCH * 2 * FF2;
    const int gw = F.vcu * NWAVES + F.wave, NGW = F.G * NWAVES;
    for (int un = gw; un < UNITS_P + UNITS_S; un += NGW) {
        const bool samp = un >= UNITS_P; const int q = samp ? un - UNITS_P : un, cbk = q % NCB, id = q / NCB, j0 = cbk * 512 + F.lane * 8;
        const int nrows = samp ? DEC_SEQ : 2, row0 = samp ? MPR + id * DEC_SEQ : id * 256;
        float w[3][2][8], bb[2][8], p2[2][8], p1[2][8];
#pragma unroll
        for (int h = 0; h < 2; ++h) { const int c0 = j0 + h * D_FF;
#pragma unroll
            for (int e = 0; e < 8; ++e) { bb[h][e] = cb[c0 + e]; w[0][h][e] = cw[c0 + e]; w[1][h][e] = cw[FF2 + c0 + e]; w[2][h][e] = cw[2 * FF2 + c0 + e]; p2[h][e] = 0.f; p1[h][e] = 0.f; }
            if (samp) {
#pragma unroll
                for (int e = 0; e < 8; ++e) { p2[h][e] = sbuf[((size_t)id * 2 + 0) * FF2 + c0 + e]; p1[h][e] = sbuf[((size_t)id * 2 + 1) * FF2 + c0 + e]; } }
            else if (id % TPS != 0) { const v4u a = *(const GAS v4u*)(UB + ((size_t)(id - 1) * 4 + 2) * FF2 + c0), b = *(const GAS v4u*)(UB + ((size_t)(id - 1) * 4 + 3) * FF2 + c0);
#pragma unroll
                for (int e = 0; e < 4; ++e) { p2[h][2 * e] = bflo(a[e]); p2[h][2 * e + 1] = bfhi(a[e]); p1[h][2 * e] = bflo(b[e]); p1[h][2 * e + 1] = bfhi(b[e]); } }
        }
        v4u ur[DEC_SEQ][2];
#pragma unroll
        for (int r = 0; r < DEC_SEQ; ++r) { const int rr = r < nrows ? r : 0;
#pragma unroll
            for (int h = 0; h < 2; ++h) ur[r][h] = samp ? *(const GAS v4u*)(U + (size_t)(row0 + rr) * FF2 + j0 + h * D_FF) : *(const GAS v4u*)(UB + ((size_t)id * 4 + rr) * FF2 + j0 + h * D_FF); }
#pragma unroll
        for (int r = 0; r < DEC_SEQ; ++r) { if (r >= nrows) break;
            float cv[2][8];
#pragma unroll
            for (int h = 0; h < 2; ++h) { const v4u a = ur[r][h];
#pragma unroll
                for (int e = 0; e < 4; ++e) { const float u0 = bflo(a[e]), u1 = bfhi(a[e]);
                    cv[h][2 * e] = bb[h][2 * e] + w[0][h][2 * e] * p2[h][2 * e] + w[1][h][2 * e] * p1[h][2 * e] + w[2][h][2 * e] * u0;
                    cv[h][2 * e + 1] = bb[h][2 * e + 1] + w[0][h][2 * e + 1] * p2[h][2 * e + 1] + w[1][h][2 * e + 1] * p1[h][2 * e + 1] + w[2][h][2 * e + 1] * u1;
                    p2[h][2 * e] = p1[h][2 * e]; p2[h][2 * e + 1] = p1[h][2 * e + 1]; p1[h][2 * e] = u0; p1[h][2 * e + 1] = u1; } }
            v4u o;
#pragma unroll
            for (int e = 0; e < 4; ++e) o[e] = cvt_pk_bf16(gelu_tanh(cv[0][2 * e]) * cv[1][2 * e], gelu_tanh(cv[0][2 * e + 1]) * cv[1][2 * e + 1]);
            *(GAS v4u*)(ACT + (size_t)(row0 + r) * D_FF + j0) = o;
        }
    }
}
constexpr int NCPAD_P = (NC_P + 63) / 64 * 64, NCPAD_S = (NC_S + 63) / 64 * 64;
constexpr size_t KC_P_OFF = 0, VC_P_OFF = KC_P_OFF + (size_t)BATCH * 4 * NCPAD_P * 64 * 2, KC_S_OFF = VC_P_OFF + (size_t)BATCH * 4 * NCPAD_P * 64 * 2,
    VC_S_OFF = KC_S_OFF + (size_t)DEC_BATCH * 4 * NCPAD_S * 64 * 2, W1T_OFF = VC_S_OFF + (size_t)DEC_BATCH * 4 * NCPAD_S * 64 * 2,
    W2T_OFF = W1T_OFF + (size_t)2 * 64 * 2048 * 2,
    CB_OFF = W2T_OFF + (size_t)2 * 64 * 64 * 2, KC_END = CB_OFF + 2 * 64 * 4;
static_assert(KC_END <= ((size_t)64 << 20), "KC region");
__device__ __forceinline__ void compress_prologue(Frame& F) {
    LAS float* scr = (LAS float*)(F.lds + RING_OFF + F.wave * 16384);
    const int gw = F.vcu * NWAVES + F.wave, NGW = F.G * NWAVES;
    constexpr int I2 = (64 / 64) * (64 / 32);
    for (int it = gw; it < 2 * I2; it += NGW) { const int c = it / I2, r = it % I2;
        transpose_item(inp(F, 13) + (size_t)c * 64 * 64, 64, 64, 64, wsp<bf16>(F, WS_KC + W2T_OFF) + (size_t)c * 64 * 64, scr, r, F.lane); }
    for (int p = (int)blockIdx.x * NTHREADS + F.tid; p < 2 * 16 * 4 * 4 * 64; p += F.G * NTHREADS) {
        const int ln = p & 63, rh = (p >> 6) & 3, s4 = (p >> 8) & 3, l = (p >> 10) & 15, c = p >> 14; const int h = 32 * (rh & 1) + (ln & 31), d0 = 16 * s4 + 8 * (ln >> 5);
        const float* src = inp(F, 12) + (((size_t)c * 32 + 16 * (rh >> 1) + l) * 64 + d0) * 64 + h;
        v4u w; w.x = cvt_pk_bf16(src[0], src[64]); w.y = cvt_pk_bf16(src[128], src[192]); w.z = cvt_pk_bf16(src[256], src[320]); w.w = cvt_pk_bf16(src[384], src[448]);
        *(GAS v4u*)(wsp<bf16>(F, WS_KC + W1T_OFF) + (size_t)p * 8) = w; }
    const int cb = F.G - 1 - (int)blockIdx.x;
    if (cb >= 0 && cb < 2) { __syncthreads();
        const int c = cb, h4 = F.tid & 15, seg = F.tid >> 4; const float* w1 = inp(F, 12) + (size_t)c * 2048 * 64; const float* pos = inp(F, 14);
        LAS float* red = (LAS float*)(F.lds + RING_OFF); LAS float* P = red + 2048;
        for (int i = F.tid; i < 2048; i += NTHREADS) P[i] = pos[((i >> 6) * 2 + c) * 64 + (i & 63)];
        __syncthreads();
        f32x4 s = (f32x4){0.f, 0.f, 0.f, 0.f};
        for (int kk = 0; kk < 64; kk += 16) { f32x4 w[16];
#pragma unroll
            for (int j = 0; j < 16; ++j) w[j] = *(const GAS f32x4*)(w1 + (size_t)(seg * 64 + kk + j) * 64 + 4 * h4);
#pragma unroll
            for (int j = 0; j < 16; ++j) { const float pv = P[seg * 64 + kk + j]; s[0] += pv * w[j][0]; s[1] += pv * w[j][1]; s[2] += pv * w[j][2]; s[3] += pv * w[j][3]; } }
        *(LAS f32x4*)(red + seg * 64 + 4 * h4) = s; __syncthreads();
        if (F.tid < 64) { float t = 0.f;
#pragma unroll
            for (int i = 0; i < 32; ++i) t += red[i * 64 + F.tid];
            wsp<float>(F, WS_KC + CB_OFF)[c * 64 + F.tid] = t; }
        __syncthreads(); }
}
__device__ __forceinline__ bf16x8 ld_bf8_f32(const float* p) { const f32x4 a = *(const GAS f32x4*)p, b = *(const GAS f32x4*)(p + 4);
    v4u w; w.x = cvt_pk_bf16(a[0], a[1]); w.y = cvt_pk_bf16(a[2], a[3]); w.z = cvt_pk_bf16(b[0], b[1]); w.w = cvt_pk_bf16(b[2], b[3]); return __builtin_bit_cast(bf16x8, w); }
constexpr int CW_CMPQ = 2048;
constexpr int CMP_RSTR = 144, CMP_WBUF = 32 * CMP_RSTR;
template <bool SAMP> __device__ __forceinline__ void compress_unit(Frame& F, int b, int tile, int g, int c) {
    const int lane = F.lane, l32 = lane & 31, hi = lane >> 5;
    const bf16* W1F = wsp<bf16>(F, WS_KC + W1T_OFF); const bf16* W2T = wsp<bf16>(F, WS_KC + W2T_OFF); const float* CB = wsp<float>(F, WS_KC + CB_OFF);
    LAS unsigned char* stg = F.lds + RING_OFF + F.wave * (2 * CMP_WBUF);
    constexpr int nch = SAMP ? NCH_S : NCH_P, nc = SAMP ? NC_S : NC_P, ncpad = SAMP ? NCPAD_S : NCPAD_P;
    constexpr int NLD = SAMP ? 8 : 4, LPS = SAMP ? 16 : 8;
    const int ch0 = 31 * tile;
    const char* src[NLD];
#pragma unroll
    for (int i = 0; i < NLD; ++i) { int chn = ch0 + i * (64 / LPS) + lane / LPS; if (chn > nch - 1) chn = nch - 1; const int tok = 16 * chn;
        if (SAMP) { const int page = ((const int*)inp(F, 8))[b * N_PAGES + tok / PAGE_SIZE]; src[i] = (const char*)(inp(F, 2) + ((size_t)page * PAGE_SIZE + tok % PAGE_SIZE) * 1024 + c * 256 + g * 64) + (lane % LPS) * 16; }
        else src[i] = (const char*)(wsp<bf16>(F, WS_KVB) + (size_t)(b * SEQ + tok) * 1024 + c * 256 + g * 64) + (lane % LPS) * 16; }
    constexpr int TOKB = SAMP ? 4096 : 2048;
    f32x16 acc[2][2];
#pragma unroll
    for (int r = 0; r < 2; ++r)
#pragma unroll
        for (int hb = 0; hb < 2; ++hb) acc[r][hb] = (f32x16){};
    v4u nx[NLD];
#pragma unroll
    for (int i = 0; i < NLD; ++i) nx[i] = *(const GAS v4u*)(src[i]);
#pragma unroll 1
    for (int l = 0; l < 16; ++l) {
        LAS unsigned char* sb = stg + (l & 1) * CMP_WBUF;
#pragma unroll
        for (int i = 0; i < NLD; ++i) { const int row = i * (64 / LPS) + lane / LPS;
            if (SAMP) { const f32x4 f = __builtin_bit_cast(f32x4, nx[i]); v2u w; w.x = cvt_pk_bf16(f[0], f[1]); w.y = cvt_pk_bf16(f[2], f[3]); *(LAS v2u*)(sb + row * CMP_RSTR + (lane % LPS) * 8) = w; }
            else *(LAS v4u*)(sb + row * CMP_RSTR + (lane % LPS) * 16) = nx[i]; }
        const bf16* wl = W1F + (size_t)((c * 16 + l) * 16) * 512 + lane * 8;
        bf16x8 wf[16];
#pragma unroll
        for (int i = 0; i < 16; ++i) wf[i] = *(const GAS bf16x8*)(wl + i * 512);
        ASMV("" ::: "memory");
        { const int ln = l < 15 ? l + 1 : 15;
#pragma unroll
            for (int i = 0; i < NLD; ++i) nx[i] = *(const GAS v4u*)(src[i] + (size_t)ln * TOKB); }
        LDS_WAIT();
#pragma unroll
        for (int s4 = 0; s4 < 4; ++s4) { const bf16x8 kv = *(const LAS bf16x8*)(sb + l32 * CMP_RSTR + s4 * 32 + hi * 16);
#pragma unroll
            for (int rh = 0; rh < 4; ++rh)
                acc[rh >> 1][rh & 1] = __builtin_amdgcn_mfma_f32_32x32x16_bf16(wf[s4 * 4 + rh], kv, acc[rh >> 1][rh & 1], 0, 0, 0); }
    }
    f32x16 o[2]; o[0] = (f32x16){}; o[1] = (f32x16){};
#pragma unroll
    for (int hb = 0; hb < 2; ++hb) {
        float gv[16];
#pragma unroll
        for (int r = 0; r < 16; ++r) { const int h = 32 * hb + (r & 3) + 8 * (r >> 2) + 4 * hi; gv[r] = gelu_tanh(acc[0][hb][r] + __shfl(acc[1][hb][r], (lane + 1) & 63) + CB[c * 64 + h]); }
#pragma unroll
        for (int s = 0; s < 2; ++s) {
            v4u pw; pw.x = cvt_pk_bf16(gv[8 * s + 0], gv[8 * s + 1]); pw.y = cvt_pk_bf16(gv[8 * s + 2], gv[8 * s + 3]); pw.z = cvt_pk_bf16(gv[8 * s + 4], gv[8 * s + 5]); pw.w = cvt_pk_bf16(gv[8 * s + 6], gv[8 * s + 7]);
            const bf16x8 gf = __builtin_bit_cast(bf16x8, pw);
#pragma unroll
            for (int db = 0; db < 2; ++db) {
                const bf16* wp = W2T + (size_t)c * 64 * 64 + (size_t)(32 * db + l32) * 64 + 32 * hb + 16 * s + 4 * hi;
                const v2u a0 = *(const GAS v2u*)wp, a1 = *(const GAS v2u*)(wp + 8); v4u aw; aw.x = a0.x; aw.y = a0.y; aw.z = a1.x; aw.w = a1.y;
                o[db] = __builtin_amdgcn_mfma_f32_32x32x16_bf16(__builtin_bit_cast(bf16x8, aw), gf, o[db], 0, 0, 0);
            }
        }
    }
    const int j = ch0 + l32;
    if (l32 < 31 && j < ncpad) {
        bf16* dst = wsp<bf16>(F, WS_KC + (SAMP ? (c ? VC_S_OFF : KC_S_OFF) : (c ? VC_P_OFF : KC_P_OFF))) + ((size_t)(b * 4 + g) * ncpad + j) * 64;
        const bool live = j < nc;
#pragma unroll
        for (int db = 0; db < 2; ++db)
#pragma unroll
            for (int r4 = 0; r4 < 4; ++r4) { v2u w; w.x = live ? cvt_pk_bf16(o[db][4 * r4], o[db][4 * r4 + 1]) : 0u; w.y = live ? cvt_pk_bf16(o[db][4 * r4 + 2], o[db][4 * r4 + 3]) : 0u;
                __hip_atomic_store((GAS unsigned long long*)(dst + 32 * db + 8 * r4 + 4 * hi), ((unsigned long long)w.y << 32) | w.x, __ATOMIC_RELAXED, __HIP_MEMORY_SCOPE_AGENT); }
    }
}
constexpr int CW_CMPC = 8192;
constexpr int CMP_NT_P = (NCPAD_P + 30) / 31, CMP_NT_S = (NCPAD_S + 30) / 31;
__device__ __forceinline__ void compress_phase(Frame& F, int rep = 0) {
    constexpr int UN_S = DEC_BATCH * CMP_NT_S, UN_P = BATCH * CMP_NT_P;
    LAS unsigned* qslot = (LAS unsigned*)(F.lds + RING_OFF + NWAVES * 2 * CMP_WBUF);
    const int g = F.wave & 3, c = F.wave >> 2;
    for (;;) {
        __syncthreads();
        if (F.tid == 0) *qslot = __hip_atomic_fetch_add(F.ctl + CW_CMPQ + 64 * rep, 1u, __ATOMIC_RELAXED, __HIP_MEMORY_SCOPE_AGENT);
        __syncthreads();
        const int un = (int)*qslot;
        if (un >= UN_S + UN_P) break;
        int cw;
        if (un < UN_P) { compress_unit<false>(F, un / CMP_NT_P, un % CMP_NT_P, g, c); cw = CW_CMPC + 64 * (un / CMP_NT_P); }
        else { const int v = un - UN_P; compress_unit<true>(F, v / CMP_NT_S, v % CMP_NT_S, g, c); cw = CW_CMPC + 64 * (BATCH + v / CMP_NT_S); }
        ASMV("s_waitcnt vmcnt(0)" ::: "memory");
        __syncthreads();
        if (F.tid == 0) __hip_atomic_fetch_add(F.ctl + cw, 1u, __ATOMIC_RELAXED, __HIP_MEMORY_SCOPE_AGENT);
    }
}
#ifndef AT_PROBE
#define AT_PROBE 0
#endif
typedef short v4i16 __attribute__((ext_vector_type(4)));
constexpr int AT_KSTR = 144, AT_TILE = 64 * AT_KSTR;
constexpr int AT_VSTR = 192, AT_VTILE = 64 * AT_VSTR;
constexpr int AT_K = 0, AT_V = 2 * AT_TILE, AT_IMP = 2 * AT_TILE + 2 * AT_VTILE, IMPW_P = 65, IMPW_S = 132, AT_IMP_BYTES = 64 * IMPW_P * 4 + 256;
constexpr int AT_SEL = AT_IMP + AT_IMP_BYTES, AT_SC = AT_SEL + 64 * 3 * 8, AT_UNI = AT_SC + 8 * 192 * 4, AT_OACC = AT_UNI + 64, AT_END = AT_OACC + 32 * NTHREADS * 4;
static_assert((AT_OACC % 16) == 0 && AT_END <= RING_BYTES && 4 * IMPW_S * 4 <= AT_IMP_BYTES && (AT_IMP % 16) == 0 && (AT_SEL % 8) == 0, "attention LDS map");
constexpr float NEG_BIG = -1.0e30f;
struct AtUnit { bool samp; int b, g, t0, row0, ntok; };

struct AtPiece { v4u a, b; int kind; };
template <int BRX, bool SAMP> __device__ __forceinline__ AtPiece at_load_raw(const Frame& F, const AtUnit& u, int ti, int isv) {
    constexpr int BR = BRX & 15;
    int t_ = F.tid; ASMV("" : "+v"(t_));
    if (AT_PROBE == 5 && BRX >= 16) { AtPiece Z; Z.a = (v4u){0u,0u,0u,0u}; Z.b = Z.a; Z.kind = 1; return Z; }
    const int row = t_ >> 3, ch = t_ & 7; AtPiece P; P.b = (v4u){0u, 0u, 0u, 0u};
    if (!SAMP) { const bf16* pb;
        if (BR == 0) pb = wsp<bf16>(F, WS_KC + (isv ? VC_P_OFF : KC_P_OFF)) + ((size_t)(u.b * 4 + u.g) * NCPAD_P + 64 * ti + row) * 64 + ch * 8;
        else if (BR == 1) pb = wsp<bf16>(F, WS_KVB) + (size_t)(u.b * SEQ + 64 * ti + row) * 1024 + 512 + isv * 256 + u.g * 64 + ch * 8;
        else pb = wsp<bf16>(F, WS_WINB) + (size_t)(u.b * SEQ + 64 * ti + row) * 512 + isv * 256 + u.g * 64 + ch * 8;
        P.a = *(const GAS v4u*)pb; P.kind = 1; return P; }
    if (BR == 0) { P.a = *(const GAS v4u*)(wsp<bf16>(F, WS_KC + (isv ? VC_S_OFF : KC_S_OFF)) + ((size_t)(u.b * 4 + u.g) * NCPAD_S + 64 * ti + row) * 64 + ch * 8); P.kind = 1; return P; }
    const char* p; int kind;
    if (BR == 1) { const int co = 512 + isv * 256 + u.g * 64 + ch * 8;
        if (ti < PAST_LEN / 64) { const int page = ((const GAS int*)inp(F, 8))[u.b * N_PAGES + (64 * ti) / PAGE_SIZE]; p = (const char*)(inp(F, 2) + ((size_t)page * PAGE_SIZE + (64 * ti) % PAGE_SIZE + row) * 1024 + co); kind = 2; }
        else { const int rr = row < DEC_SEQ ? row : 0; p = (const char*)(wsp<bf16>(F, WS_KVB) + (size_t)(MPR + u.b * DEC_SEQ + rr) * 1024 + co); kind = row < DEC_SEQ ? 1 : 0; } }
    else { const int co = isv * 256 + u.g * 64 + ch * 8, i = 64 * ti + row;
        const char* pc = (const char*)(inp(F, 3) + ((size_t)u.b * WB_LEN + (i < WB_LEN ? i : 0)) * 512 + co);
        const int rr = (i >= WB_LEN && i < WB_LEN + DEC_SEQ) ? i - WB_LEN : 0; const char* pn = (const char*)(wsp<bf16>(F, WS_WINB) + (size_t)(MPR + u.b * DEC_SEQ + rr) * 512 + co);
        p = i < WB_LEN ? pc : pn; kind = i < WB_LEN ? 2 : (i < WB_LEN + DEC_SEQ ? 1 : 0); }
    P.a = *(const GAS v4u*)p; P.b = *(const GAS v4u*)(p + (kind == 2 ? 16 : 0)); P.kind = kind; return P;
}
template <bool SAMP> __device__ __forceinline__ AtPiece at_load_rt(const Frame& F, const AtUnit& u, int br, int ti, int isv) {
    int t_ = F.tid; ASMV("" : "+v"(t_));
    const int row = t_ >> 3, ch = t_ & 7; AtPiece P; P.b = (v4u){0u, 0u, 0u, 0u};
    if (!SAMP) {
        const bf16* b0 = wsp<bf16>(F, WS_KC + (isv ? VC_P_OFF : KC_P_OFF)) + (size_t)(u.b * 4 + u.g) * NCPAD_P * 64;
        const bf16* b1 = wsp<bf16>(F, WS_KVB) + (size_t)u.b * SEQ * 1024 + 512 + isv * 256 + u.g * 64;
        const bf16* b2 = wsp<bf16>(F, WS_WINB) + (size_t)u.b * SEQ * 512 + isv * 256 + u.g * 64;
        const bf16* base = br == 0 ? b0 : (br == 1 ? b1 : b2); const int stride = br == 0 ? 64 : (br == 1 ? 1024 : 512);
        P.a = *(const GAS v4u*)(base + (size_t)(64 * ti + row) * stride + ch * 8); P.kind = 1; return P; }
    const char* p; int kind;
    if (br == 0) { p = (const char*)(wsp<bf16>(F, WS_KC + (isv ? VC_S_OFF : KC_S_OFF)) + ((size_t)(u.b * 4 + u.g) * NCPAD_S + 64 * ti + row) * 64 + ch * 8); kind = 1; }
    else if (br == 1) { const int co = 512 + isv * 256 + u.g * 64 + ch * 8;
        if (ti < PAST_LEN / 64) { const int page = ((const GAS int*)inp(F, 8))[u.b * N_PAGES + (64 * ti) / PAGE_SIZE]; p = (const char*)(inp(F, 2) + ((size_t)page * PAGE_SIZE + (64 * ti) % PAGE_SIZE + row) * 1024 + co); kind = 2; }
        else { const int rr = row < DEC_SEQ ? row : 0; p = (const char*)(wsp<bf16>(F, WS_KVB) + (size_t)(MPR + u.b * DEC_SEQ + rr) * 1024 + co); kind = row < DEC_SEQ ? 1 : 0; } }
    else { const int co = isv * 256 + u.g * 64 + ch * 8, i = 64 * ti + row;
        const char* pc = (const char*)(inp(F, 3) + ((size_t)u.b * WB_LEN + (i < WB_LEN ? i : 0)) * 512 + co);
        const int rr = (i >= WB_LEN && i < WB_LEN + DEC_SEQ) ? i - WB_LEN : 0; const char* pn = (const char*)(wsp<bf16>(F, WS_WINB) + (size_t)(MPR + u.b * DEC_SEQ + rr) * 512 + co);
        p = i < WB_LEN ? pc : pn; kind = i < WB_LEN ? 2 : (i < WB_LEN + DEC_SEQ ? 1 : 0); }
    P.a = *(const GAS v4u*)p; P.b = *(const GAS v4u*)(p + (kind == 2 ? 16 : 0)); P.kind = kind; return P;
}
__device__ __forceinline__ v4u at_piece_bf16(const AtPiece& P) {
    const f32x4 a = __builtin_bit_cast(f32x4, P.a), b = __builtin_bit_cast(f32x4, P.b); v4u w; w.x = cvt_pk_bf16(a[0], a[1]); w.y = cvt_pk_bf16(a[2], a[3]); w.z = cvt_pk_bf16(b[0], b[1]); w.w = cvt_pk_bf16(b[2], b[3]);
    return P.kind == 2 ? w : (P.kind == 1 ? P.a : (v4u){0u, 0u, 0u, 0u});
}
#ifdef EMU
__device__ __forceinline__ int at_bits_below(unsigned long long e, int lane) { return __popcll(e & ((1ull << lane) - 1ull)); }
#else
__device__ __forceinline__ int at_bits_below(unsigned long long e, int lane) { (void)lane; return (int)__builtin_amdgcn_mbcnt_hi((unsigned)(e >> 32), __builtin_amdgcn_mbcnt_lo((unsigned)e, 0u)); }
#endif
struct AtLane { int t; float slope2; bool rowok; int l32, hi; };
template <int MODE, int KSTEP, bool INTERIOR = false, int PROBE = 0> __device__ __forceinline__ void at_tile(const LAS unsigned char* Kt, const LAS unsigned char* Vt, const bf16x8 (&qf)[4], const AtLane& L,
        int kpos0, bool selok, int wlimit, float& m, float& l, f32x16 (&o)[2], float inv_l, LAS unsigned* imp_row, int j8base, int impw) {
    if (PROBE == 6) return;
    const int l32 = L.l32, hi = L.hi; const int pi = (l32 & 19) | ((l32 >> 1) & 4) | ((l32 << 1) & 8);
    f32x16 p[2];
#pragma unroll
    for (int kb = 0; kb < 2; ++kb) { p[kb] = (f32x16){};
        const LAS unsigned char* kr = Kt + (32 * kb + pi) * AT_KSTR + hi * 16;
        if (PROBE != 3)
#pragma unroll
        for (int kc = 0; kc < 4; ++kc) p[kb] = __builtin_amdgcn_mfma_f32_32x32x16_bf16(*(const LAS bf16x8*)(kr + kc * 32), qf[kc], p[kb], 0, 0, 0); }
    float ls = 0.f;
    if (PROBE != 1) {
    const bool rok = selok && L.rowok;
    int dbase = L.t - kpos0 - KSTEP * 8 * hi; ASMV("" : "+v"(dbase));
    if (INTERIOR) {
        const float sk = L.slope2 * (float)KSTEP, off = -L.slope2 * (float)dbase; float mx = NEG_BIG;
#pragma unroll
        for (int kb = 0; kb < 2; ++kb)
#pragma unroll
            for (int r = 0; r < 16; ++r) { const float s = p[kb][r] + sk * (float)(32 * kb + 16 * (r >> 3) + (r & 7)); p[kb][r] = s; mx = fmaxf(mx, s); }
        mx = rok ? mx + off : NEG_BIG; mx = fmaxf(mx, __shfl_xor(mx, 32));
        const float mn = fmaxf(m, mx);
        if (__any(mn > m)) { const float alpha = __builtin_amdgcn_exp2f(m - mn); l *= alpha;
#pragma unroll
            for (int db = 0; db < 2; ++db)
#pragma unroll
                for (int r = 0; r < 16; ++r) o[db][r] *= alpha; }
        m = mn; const float mref = rok ? mn - off : 1.0e30f;
#pragma unroll
        for (int kb = 0; kb < 2; ++kb)
#pragma unroll
            for (int r = 0; r < 16; ++r) { const float e = __builtin_amdgcn_exp2f(p[kb][r] - mref); p[kb][r] = e; ls += e; }
    } else {
    float mx = NEG_BIG;
#pragma unroll
    for (int kb = 0; kb < 2; ++kb)
#pragma unroll
        for (int r = 0; r < 16; ++r) { const int dist = dbase - KSTEP * (32 * kb + 16 * (r >> 3) + (r & 7));
            const bool ok = rok && dist >= 0 && dist < wlimit; const float s = ok ? p[kb][r] - L.slope2 * (float)dist : NEG_BIG; p[kb][r] = s; mx = fmaxf(mx, s); }
    float mref = m;
    if (MODE != 1) { mx = fmaxf(mx, __shfl_xor(mx, 32)); const float mn = fmaxf(m, mx); mref = mn;
        if (__any(mn > m)) { const float alpha = __builtin_amdgcn_exp2f(m - mn); l *= alpha;
            if (MODE == 2) {
#pragma unroll
                for (int db = 0; db < 2; ++db)
#pragma unroll
                    for (int r = 0; r < 16; ++r) o[db][r] *= alpha; } }
        m = mn; }
#pragma unroll
    for (int kb = 0; kb < 2; ++kb)
#pragma unroll
        for (int r = 0; r < 16; ++r) { const float s = p[kb][r]; float e = (s > -1.0e29f) ? __builtin_amdgcn_exp2f(s - mref) : 0.f; if (MODE == 1) e *= inv_l; p[kb][r] = e; ls += e; }
    }
    }
    if (MODE != 1) l += ls;
    if (MODE == 0) return;
    if (MODE == 1) {
#pragma unroll
        for (int kb = 0; kb < 2; ++kb)
#pragma unroll
            for (int hf = 0; hf < 2; ++hf) { const int na = (j8base + 32 * kb + 16 * hf + 8 * hi) >> 2; const int r0 = 8 * hf;
                const float a = (p[kb][r0] + p[kb][r0 + 1]) + (p[kb][r0 + 2] + p[kb][r0 + 3]), b = (p[kb][r0 + 4] + p[kb][r0 + 5]) + (p[kb][r0 + 6] + p[kb][r0 + 7]) + p[kb][r0 + 3], c = p[kb][r0 + 7];
                if (L.rowok) { __hip_atomic_fetch_add(imp_row + na, (unsigned)(a * 67108864.f + 0.5f), __ATOMIC_RELAXED, __HIP_MEMORY_SCOPE_WORKGROUP);
                    if (na + 1 < impw) __hip_atomic_fetch_add(imp_row + na + 1, (unsigned)(b * 67108864.f + 0.5f), __ATOMIC_RELAXED, __HIP_MEMORY_SCOPE_WORKGROUP);
                    if (na + 2 < impw) __hip_atomic_fetch_add(imp_row + na + 2, (unsigned)(c * 67108864.f + 0.5f), __ATOMIC_RELAXED, __HIP_MEMORY_SCOPE_WORKGROUP); } }
    }
    if (PROBE == 2) return;
    const int gi = L.l32 & 15;
    const LAS unsigned char* vbase = Vt + (8 * hi + (gi >> 2)) * AT_VSTR + (16 * ((L.l32 >> 4) & 1) + 4 * (gi & 3)) * 2;
#pragma unroll
    for (int kb = 0; kb < 2; ++kb)
#pragma unroll
        for (int s = 0; s < 2; ++s) { v4u pw; const int r0 = 8 * s;
            pw.x = cvt_pk_bf16(p[kb][r0], p[kb][r0 + 1]); pw.y = cvt_pk_bf16(p[kb][r0 + 2], p[kb][r0 + 3]); pw.z = cvt_pk_bf16(p[kb][r0 + 4], p[kb][r0 + 5]); pw.w = cvt_pk_bf16(p[kb][r0 + 6], p[kb][r0 + 7]);
            const bf16x8 pf = __builtin_bit_cast(bf16x8, pw);
#pragma unroll
            for (int db = 0; db < 2; ++db) { const LAS unsigned char* vp = vbase + (32 * kb + 16 * s) * AT_VSTR + 64 * db;
                const v4i16 lo = __builtin_amdgcn_ds_read_tr16_b64_v4i16((LAS v4i16*)vp), hh = __builtin_amdgcn_ds_read_tr16_b64_v4i16((LAS v4i16*)(vp + 4 * AT_VSTR));
                const bf16x8 vf = (bf16x8){lo[0], lo[1], lo[2], lo[3], hh[0], hh[1], hh[2], hh[3]};
                o[db] = __builtin_amdgcn_mfma_f32_32x32x16_bf16(vf, pf, o[db], 0, 0, 0); } }
}
#define AT_STAGE(bufi, kreg, vreg) do { int _t = F.tid; ASMV("" : "+v"(_t)); const int _o = (_t >> 3) * AT_KSTR + (_t & 7) * 16; *(LAS v4u*)(lds + AT_K + (bufi) * AT_TILE + _o) = SAMP ? at_piece_bf16(kreg) : (kreg).a; *(LAS v4u*)(lds + AT_V + (bufi) * AT_VTILE + (_t >> 3) * AT_VSTR + (_t & 7) * 16) = SAMP ? at_piece_bf16(vreg) : (vreg).a; } while (0)

template <bool SAMP, int PROBE = 0> __device__ __forceinline__ void nsa_attn_unit(Frame& F, const AtUnit& u) {
    LAS unsigned char* lds = F.lds + RING_OFF;
    LAS unsigned* imp = (LAS unsigned*)(lds + AT_IMP); LAS unsigned long long* selm = (LAS unsigned long long*)(lds + AT_SEL); LAS unsigned* scw = (LAS unsigned*)(lds + AT_SC) + F.wave * 192;
    int lane_ = F.lane; ASMV("" : "+v"(lane_));
    const int lane = lane_, l32 = lane & 31, hi = lane >> 5, hh = F.wave >> 1, th = F.wave & 1;
        const int impw = SAMP ? IMPW_S : IMPW_P, nsel = SAMP ? NSEL_S : NSEL_P, keff = SEL_TOPK < nsel ? SEL_TOPK : nsel;
        AtLane L; L.l32 = l32; L.hi = hi; const int tk = 32 * th + l32; L.rowok = tk < u.ntok; L.t = u.t0 + (L.rowok ? tk : 0);
        L.slope2 = __builtin_amdgcn_exp2f(-0.5f * (float)(u.g * 4 + hh + 1)) * 1.4426950408889634f;
        const int qrow = u.row0 + (L.rowok ? tk : 0);
        bf16x8 qf[4];
        { const bf16* qp = wsp<bf16>(F, WS_Q) + (size_t)qrow * 1024 + u.g * 256 + hh * 64 + hi * 8;
#pragma unroll
          for (int kc = 0; kc < 4; ++kc) qf[kc] = *(const GAS bf16x8*)(qp + kc * 16); }
        for (int i = F.tid; i < AT_IMP_BYTES / 4; i += NTHREADS) imp[i] = 0u;
        if (F.tid < 3) ((LAS unsigned long long*)(lds + AT_UNI))[F.tid] = 0ull;
        LAS unsigned* imp_row = imp + (L.rowok ? tk : 0) * impw;
        f32x16 o[2]; LAS float* oacc = (LAS float*)(lds + AT_OACC) + F.wave * 2048 + lane;
        const float* gp = wsp<float>(F, WS_GATES) + (size_t)qrow * 48 + u.g * 12 + hh * 3;
        const float g0 = sigmoidf_(gp[0]), g1 = sigmoidf_(gp[1]), g2 = sigmoidf_(gp[2]);
        constexpr int PD = SAMP ? 1 : 2;
        const int nct = SAMP ? NCPAD_S / 64 : ((((u.t0 + 32) >> 4) >> 6) + 1 < NCPAD_P / 64 ? (((u.t0 + 32) >> 4) >> 6) + 1 : NCPAD_P / 64);
        int tfirst, tlast, kp0;
        if (SAMP) { tfirst = 0; tlast = (WB_LEN + DEC_SEQ + 63) / 64 - 1; kp0 = PAST_LEN - WB_LEN; }
        else { const int lo = u.t0 - WINDOW + 1; tfirst = lo > 0 ? lo >> 6 : 0; tlast = u.t0 >> 6; kp0 = 0; }
        const int nw = tlast - tfirst + 1;
        float m = NEG_BIG, l = 0.f, inv_l = 0.f; int buf = 0;
        AtPiece k2, v2;
        {
#define AT_CW(ii2, br, ti) const int _q = (ii2), br = _q < 2 * nct ? 0 : 2, ti = _q < 2 * nct ? (_q < nct ? _q : _q - nct) : tfirst + (_q - 2 * nct < nw ? _q - 2 * nct : nw - 1)
            { AT_CW(0, br0, ti0); const AtPiece k1 = at_load_rt<SAMP>(F, u, br0, ti0, 0), v1 = at_load_rt<SAMP>(F, u, br0, ti0, 1); k2 = k1; v2 = v1;
              if (!SAMP) { AT_CW(1, br1, ti1); k2 = at_load_rt<SAMP>(F, u, br1, ti1, 0); v2 = at_load_rt<SAMP>(F, u, br1, ti1, 1); }
              __syncthreads();
              AT_STAGE(0, k1, v1); __syncthreads(); }
            for (int ii = 0; ii < 2 * nct; ++ii) {
                AT_CW(ii + PD, br3, ti3);
                const AtPiece k3 = at_load_rt<SAMP>(F, u, br3, ti3, 0), v3 = at_load_rt<SAMP>(F, u, br3, ti3, 1);
                if (ii == nct) { l += __shfl_xor(l, 32); inv_l = l > 0.f ? 1.0f / l : 0.f; o[0] = (f32x16){}; o[1] = (f32x16){}; }
                const int i = ii < nct ? ii : ii - nct;
                const LAS unsigned char* Kt = lds + AT_K + buf * AT_TILE; const LAS unsigned char* Vt = lds + AT_V + buf * AT_VTILE;
                if (ii < nct) at_tile<0, 16, false, PROBE>(Kt, Vt, qf, L, 16 * 64 * i + 31, true, 0x7fffffff, m, l, o, 0.f, imp_row, 0, impw);
                else at_tile<1, 16, false, PROBE>(Kt, Vt, qf, L, 16 * 64 * i + 31, true, 0x7fffffff, m, l, o, inv_l, imp_row, 64 * i, impw);
                if (SAMP) AT_STAGE(buf ^ 1, k3, v3); else AT_STAGE(buf ^ 1, k2, v2);
                buf ^= 1;
                __syncthreads();
                if (!SAMP) { k2 = k3; v2 = v3; }
            }
#undef AT_CW
        }
#pragma unroll
        for (int db = 0; db < 2; ++db)
#pragma unroll
            for (int r = 0; r < 16; ++r) oacc[(16 * db + r) * 64] = g0 * o[db][r];
        for (int tkk = F.wave; tkk < u.ntok; tkk += NWAVES) {
            const int t = u.t0 + tkk, cur = t >> 6; unsigned sc[3];
#pragma unroll
            for (int i = 0; i < 3; ++i) { const int n = lane + 64 * i; unsigned s = 0u;
                if (n < nsel && 64 * n <= t) { s = imp[tkk * impw + n] + 1u; if (n == 0 || n == cur || n == cur - 1) s += 0x80000000u; }
                sc[i] = s; }
            constexpr int NSELC = SAMP ? NSEL_S : NSEL_P, NW = (NSELC + 63) / 64;
            unsigned T = 0u;
            for (int bit = 31; bit >= 0; --bit) { const unsigned cand = T | (1u << bit); int cnt = 0;
#pragma unroll
                for (int i = 0; i < NW; ++i) cnt += __popcll(__ballot(sc[i] >= cand));
                if (cnt >= keff) T = cand; }
            int need = keff;
#pragma unroll
            for (int i = 0; i < NW; ++i) need -= __popcll(__ballot(sc[i] > T));
#pragma unroll
            for (int i = 0; i < 3; ++i) { unsigned long long bal = 0ull;
                if (i < NW) { const unsigned long long e = __ballot(sc[i] == T && T != 0u); const int pre = at_bits_below(e, lane);
                    bal = __ballot(sc[i] > T || (sc[i] == T && T != 0u && pre < need)); need -= __popcll(e); }
                if (lane == 0) { selm[tkk * 3 + i] = bal; if (bal) __hip_atomic_fetch_or((LAS unsigned long long*)(lds + AT_UNI) + i, bal, __ATOMIC_RELAXED, __HIP_MEMORY_SCOPE_WORKGROUP); } }
            LDS_WAIT();
        }
        __syncthreads();
        const LAS unsigned long long* uni = (const LAS unsigned long long*)(lds + AT_UNI); int wi = 0; unsigned long long rem = uni[0]; int n = -1;
        auto next_tile = [&]() { while (rem == 0ull && wi < 2) { ++wi; rem = uni[wi]; } if (rem == 0ull) { n = -1; return; } const int bpos = __ffsll(rem) - 1; rem &= rem - 1ull; n = 64 * wi + bpos; };
        next_tile(); const int nA = n >= 0 ? n : 0; next_tile(); int nB = n >= 0 ? n : nA; next_tile(); int nC = n >= 0 ? n : nB;
        const int left = __popcll(uni[0]) + __popcll(uni[1]) + __popcll(uni[2]);
        {
            m = NEG_BIG; l = 0.f; o[0] = (f32x16){}; o[1] = (f32x16){};
            if (!SAMP && nw == 1) { k2 = at_load_rt<SAMP>(F, u, 1, nA, 0); v2 = at_load_rt<SAMP>(F, u, 1, nA, 1); }
            for (int j = 0; j < nw; ++j) {
                const int j2 = j + PD, br3 = j2 < nw ? 2 : 1, ti3 = j2 < nw ? tfirst + j2 : (j2 == nw ? nA : nB);
                const AtPiece k3 = at_load_rt<SAMP>(F, u, br3, ti3, 0), v3 = at_load_rt<SAMP>(F, u, br3, ti3, 1);
                { const int kq = kp0 + 64 * (tfirst + j), tmax = u.t0 + u.ntok - 1;
                  if (kq + 63 <= u.t0 && tmax - kq < WINDOW) at_tile<2, 1, true, PROBE>(lds + AT_K + buf * AT_TILE, lds + AT_V + buf * AT_VTILE, qf, L, kq, true, WINDOW, m, l, o, 0.f, imp_row, 0, impw);
                  else at_tile<2, 1, false, PROBE>(lds + AT_K + buf * AT_TILE, lds + AT_V + buf * AT_VTILE, qf, L, kq, true, WINDOW, m, l, o, 0.f, imp_row, 0, impw); }
                if (SAMP) AT_STAGE(buf ^ 1, k3, v3); else AT_STAGE(buf ^ 1, k2, v2);
                buf ^= 1;
                __syncthreads();
                if (!SAMP) { k2 = k3; v2 = v3; }
            }
            l += __shfl_xor(l, 32); const float sc2 = l > 0.f ? g2 / l : 0.f;
#pragma unroll
            for (int db = 0; db < 2; ++db)
#pragma unroll
                for (int r = 0; r < 16; ++r) oacc[(16 * db + r) * 64] += sc2 * o[db][r];
        }
        {
            m = NEG_BIG; l = 0.f; o[0] = (f32x16){}; o[1] = (f32x16){};
            int ncur = nA;
            for (int j = 0; j < left; ++j) {
                const AtPiece k3 = at_load_rt<SAMP>(F, u, 1, SAMP ? nB : nC, 0), v3 = at_load_rt<SAMP>(F, u, 1, SAMP ? nB : nC, 1);
                const bool selok = L.rowok && ((selm[tk * 3 + (ncur >> 6)] >> (ncur & 63)) & 1ull);
                if (__any(selok)) { if (64 * ncur + 63 <= u.t0) at_tile<2, 1, true, PROBE>(lds + AT_K + buf * AT_TILE, lds + AT_V + buf * AT_VTILE, qf, L, 64 * ncur, selok, 0x7fffffff, m, l, o, 0.f, imp_row, 0, impw);
                    else at_tile<2, 1, false, PROBE>(lds + AT_K + buf * AT_TILE, lds + AT_V + buf * AT_VTILE, qf, L, 64 * ncur, selok, 0x7fffffff, m, l, o, 0.f, imp_row, 0, impw); }
                if (SAMP) AT_STAGE(buf ^ 1, k3, v3); else AT_STAGE(buf ^ 1, k2, v2);
                buf ^= 1;
                __syncthreads();
                if (!SAMP) { k2 = k3; v2 = v3; } ncur = nB; nB = nC; next_tile(); if (n >= 0) nC = n;
            }
            l += __shfl_xor(l, 32); const float sc1 = l > 0.f ? g1 / l : 0.f;
#pragma unroll
            for (int db = 0; db < 2; ++db)
#pragma unroll
                for (int r = 0; r < 16; ++r) o[db][r] = oacc[(16 * db + r) * 64] + sc1 * o[db][r];
        }
        if (L.rowok) { bf16* op = wsp<bf16>(F, PROBE ? WS_MISC + ((size_t)300 << 20) : WS_AO) + (size_t)qrow * 1024 + u.g * 256 + hh * 64 + 4 * hi;
#pragma unroll
            for (int db = 0; db < 2; ++db)
#pragma unroll
                for (int r4 = 0; r4 < 4; ++r4) { v2u w; w.x = cvt_pk_bf16(o[db][4 * r4], o[db][4 * r4 + 1]); w.y = cvt_pk_bf16(o[db][4 * r4 + 2], o[db][4 * r4 + 3]); *(GAS v2u*)(op + 32 * db + 8 * r4) = w; } }
        __syncthreads();
}
constexpr int CW_ATQ = 2560;
__device__ __forceinline__ void nsa_attn_phase(Frame& F, int rep = 0) {
    constexpr int NQT = SEQ / 64, NBG = BATCH * 4, UNITS_S = DEC_BATCH * 4;
    LAS unsigned* qslot = (LAS unsigned*)(F.lds + RING_OFF + AT_UNI + 32);
    const int xcd = (int)(xb_xcc_id() & 7u);
    unsigned long long cdone = 0ull;
    static_assert(BATCH + DEC_BATCH <= 64, "cdone mask");
    for (int xo = 0; xo < 8; ++xo) { const int x = (xcd + xo) & 7;
        const int ns = x < UNITS_S ? (UNITS_S - x + 7) / 8 : 0, nb = x < NBG ? (NBG - x + 7) / 8 : 0, total = ns + nb * NQT;
        for (;;) {
            __syncthreads();
            if (F.tid == 0) {
                const int k0 = (int)__hip_atomic_fetch_add(F.ctl + CW_ATQ + 64 * (rep * 8 + x), 1u, __ATOMIC_RELAXED, __HIP_MEMORY_SCOPE_AGENT);
                if (k0 < total) { const bool us = k0 < ns; const int ub = us ? (x + 8 * k0) >> 2 : (x + 8 * ((k0 - ns) % nb)) >> 2, ci = us ? BATCH + ub : ub;
                    if (!((cdone >> ci) & 1ull)) { gu32* cw = F.ctl + CW_CMPC + 64 * ci; const unsigned want = us ? (unsigned)CMP_NT_S : (unsigned)CMP_NT_P; unsigned spins = 0;
                        while (__hip_atomic_load(cw, __ATOMIC_RELAXED, __HIP_MEMORY_SCOPE_AGENT) < want) { __builtin_amdgcn_s_sleep(2); if (++spins > (1u << 22)) { __hip_atomic_store(F.ctl + CW_TMO, 1u, __ATOMIC_RELAXED, __HIP_MEMORY_SCOPE_AGENT); break; } }
                        cdone |= 1ull << ci; } }
                *qslot = (unsigned)k0; }
            __syncthreads();
            const int k = (int)*qslot;
            if (k >= total) break;
            if (AT_PROBE == 8 && rep && k >= ns) break;
            if (AT_PROBE == 9 && rep && k < ns) continue;
            AtUnit u;
            __builtin_amdgcn_fence(__ATOMIC_ACQUIRE, "agent"); ASMV("s_waitcnt vmcnt(0)" ::: "memory");
            if (k < ns) { const int sidx = x + 8 * k; u.samp = true; u.b = sidx >> 2; u.g = sidx & 3; u.t0 = PAST_LEN; u.row0 = MPR + u.b * DEC_SEQ; u.ntok = DEC_SEQ; { if (AT_PROBE && rep) nsa_attn_unit<true, AT_PROBE>(F, u); else nsa_attn_unit<true>(F, u); } }
            else { const int v = k - ns, bg = x + 8 * (v % nb), qt = NQT - 1 - v / nb; u.samp = false; u.b = bg >> 2; u.g = bg & 3; u.t0 = 64 * qt; u.row0 = u.b * SEQ + u.t0; u.ntok = 64; { if (AT_PROBE && rep) nsa_attn_unit<false, AT_PROBE>(F, u); else nsa_attn_unit<false>(F, u); } }
        }
    }
}
constexpr int NCK = SEQ / 64, NBH = BATCH * 8;
constexpr size_t MS_M = 0, MS_D = MS_M + al4k((size_t)NBH * (NCK + 1) * 4), MS_DC = MS_D + al4k((size_t)NBH * NCK * 4), MS_DN = MS_DC + al4k((size_t)NBH * NCK * 8192 * 4),
    MS_CST = MS_DN + al4k((size_t)NBH * NCK * 64 * 4), MS_NST = MS_CST + al4k((size_t)NBH * NCK * 8192 * 2), MS_END = MS_NST + al4k((size_t)NBH * NCK * 64 * 4);
static_assert(MS_END <= ((size_t)512 << 20), "mLSTM scratch");
constexpr float LOG2E = 1.4426950408889634f;
__device__ __forceinline__ float log_sigmoidf_(float x) { return fminf(x, 0.f) - 0.6931471805599453f * __builtin_amdgcn_logf(1.0f + __builtin_amdgcn_exp2f(-fabsf(x) * LOG2E)); }
__device__ __forceinline__ float expf_(float x) { return __builtin_amdgcn_exp2f(x * LOG2E); }
__device__ __forceinline__ float wave_incl_sum(float v, int lane) {
#pragma unroll
    for (int o = 1; o < 64; o <<= 1) { const float t = __shfl(v, lane - o < 0 ? 0 : lane - o); if (lane >= o) v += t; }
    return v;
}
__device__ __forceinline__ float wave_incl_max(float v, int lane) {
#pragma unroll
    for (int o = 1; o < 64; o <<= 1) { const float t = __shfl(v, lane - o < 0 ? 0 : lane - o); if (lane >= o) v = fmaxf(v, t); }
    return v;
}
constexpr int ML_KSTR = 144, ML_VSTR = 272;
__device__ __forceinline__ bf16x8 mk8(v4i16 a, v4i16 b) { return (bf16x8){a[0], a[1], a[2], a[3], b[0], b[1], b[2], b[3]}; }
__device__ __forceinline__ void mlstm_phase_a(Frame& F) {
    LAS unsigned char* lds = F.lds + RING_OFF;
    LAS float* sB = (LAS float*)lds; LAS float* sA = sB + NCK; LAS float* sM = sA + NCK;
    LAS unsigned char* Kt = lds + 4096; LAS unsigned char* Vt = Kt + 64 * ML_KSTR;
    static_assert((3 * NCK + 1) * 4 <= 4096 && 4096 + 64 * ML_KSTR + 64 * ML_VSTR <= RING_BYTES, "phase A LDS");
    const GAS float* MG = (const GAS float*)wsp<float>(F, WS_MG); const GAS bf16* MK = (const GAS bf16*)wsp<bf16>(F, WS_MK); const GAS bf16* MV = (const GAS bf16*)wsp<bf16>(F, WS_MV);
    GAS float* MSTm = (GAS float*)wsp<float>(F, WS_MISC + MS_M); GAS float* MSTd = (GAS float*)wsp<float>(F, WS_MISC + MS_D); GAS float* DC = (GAS float*)wsp<float>(F, WS_MISC + MS_DC); GAS float* DN = (GAS float*)wsp<float>(F, WS_MISC + MS_DN);
    const int lane = F.lane, l32 = lane & 31, hi = lane >> 5;
    constexpr int NCG = NCK / 8, UNITS = NBH * NCG;
    for (int un = F.vcu; un < UNITS; un += F.G) {
        const int bh = un / NCG, cg = un % NCG, b = bh >> 3, h = bh & 7, cend = 8 * cg + 8;
        const float bi = inp(F, 16)[h], bfg = inp(F, 16)[8 + h];
        __syncthreads();
        for (int j0 = F.wave; j0 < cend; j0 += 4 * NWAVES) {
            float igr[4], fgr[4];
#pragma unroll
            for (int q = 0; q < 4; ++q) { const int j = j0 + q * NWAVES, jj = j < cend ? j : j0; const size_t row = (size_t)b * SEQ + 64 * jj + lane; igr[q] = MG[row * 16 + h]; fgr[q] = MG[row * 16 + 8 + h]; }
#pragma unroll
            for (int q = 0; q < 4; ++q) { const int j = j0 + q * NWAVES; const float ig = igr[q] + bi, fg = log_sigmoidf_(fgr[q] + bfg);
                const float bb = wave_incl_sum(fg, lane), Bj = __shfl(bb, 63), aj = wave_max(Bj - bb + ig);
                if (lane == 0 && j < cend) { sB[j] = Bj; sA[j] = aj; } } }
        __syncthreads();
        if (F.tid == 0) { float m = 0.f; sM[0] = 0.f; for (int j = 0; j < cend; ++j) { m = fmaxf(sB[j] + m, sA[j]); sM[j + 1] = m; } }
        __syncthreads();
        if (F.tid < 8) { const int c = 8 * cg + F.tid; MSTm[bh * (NCK + 1) + c] = sM[c]; MSTd[bh * NCK + c] = expf_(sB[c] + sM[c] - sM[c + 1]);
            if (c == NCK - 1) { MSTm[bh * (NCK + 1) + NCK] = sM[NCK]; F.out[O_MP + bh] = sM[NCK]; } }
        float n_ig, n_fg; v4u n_kk, n_v0, n_v1;
#define ML_A_LOAD(cx) do { const size_t r0_ = (size_t)b * SEQ + 64 * (size_t)(8 * cg + (cx)); n_ig = MG[(r0_ + lane) * 16 + h]; n_fg = MG[(r0_ + lane) * 16 + 8 + h]; \
            n_kk = *(const GAS v4u*)(MK + (r0_ + (F.tid >> 3)) * 512 + h * 64 + (F.tid & 7) * 8); \
            n_v0 = *(const GAS v4u*)(MV + (r0_ + (F.tid >> 4)) * 1024 + h * 128 + (F.tid & 15) * 8); n_v1 = *(const GAS v4u*)(MV + (r0_ + (F.tid >> 4) + 32) * 1024 + h * 128 + (F.tid & 15) * 8); } while (0)
        ML_A_LOAD(0);
        for (int cc = 0; cc < 8; ++cc) { const int c = 8 * cg + cc;
            const float c_ig = n_ig, c_fg = n_fg; const v4u kk = n_kk, cv0 = n_v0, cv1 = n_v1;
            ML_A_LOAD(cc < 7 ? cc + 1 : 7);
            const float ig = c_ig + bi, fg = log_sigmoidf_(c_fg + bfg);
            const float bb = wave_incl_sum(fg, lane), Bc = __shfl(bb, 63); const float ws = expf_(Bc - bb + ig - sM[c + 1]);
            { const int r = F.tid >> 3, ch = F.tid & 7; const float wr = __shfl(ws, r & 63);
              v4u o;
#pragma unroll
              for (int e = 0; e < 4; ++e) o[e] = cvt_pk_bf16(bflo(kk[e]) * wr, bfhi(kk[e]) * wr);
              *(LAS v4u*)(Kt + r * ML_KSTR + ch * 16) = o;
              *(LAS v4u*)(Vt + (F.tid >> 4) * ML_VSTR + (F.tid & 15) * 16) = cv0; *(LAS v4u*)(Vt + ((F.tid >> 4) + 32) * ML_VSTR + (F.tid & 15) * 16) = cv1; }
            __syncthreads();
            { const int vb = F.wave >> 1, db = F.wave & 1, gi = l32 & 15; f32x16 acc = (f32x16){};
              const LAS unsigned char* va = Vt + (8 * hi + (gi >> 2)) * ML_VSTR + (32 * vb + 16 * ((l32 >> 4) & 1) + 4 * (gi & 3)) * 2;
              const LAS unsigned char* ka = Kt + (8 * hi + (gi >> 2)) * ML_KSTR + (32 * db + 16 * ((l32 >> 4) & 1) + 4 * (gi & 3)) * 2;
#pragma unroll
              for (int ks = 0; ks < 4; ++ks) {
                  const v4i16 a0 = __builtin_amdgcn_ds_read_tr16_b64_v4i16((LAS v4i16*)(va + 16 * ks * ML_VSTR)), a1 = __builtin_amdgcn_ds_read_tr16_b64_v4i16((LAS v4i16*)(va + (16 * ks + 4) * ML_VSTR));
                  const v4i16 b0 = __builtin_amdgcn_ds_read_tr16_b64_v4i16((LAS v4i16*)(ka + 16 * ks * ML_KSTR)), b1 = __builtin_amdgcn_ds_read_tr16_b64_v4i16((LAS v4i16*)(ka + (16 * ks + 4) * ML_KSTR));
                  acc = __builtin_amdgcn_mfma_f32_32x32x16_bf16(mk8(a0, a1), mk8(b0, b1), acc, 0, 0, 0); }
              GAS float* dc = DC + ((size_t)bh * NCK + c) * 8192 + (32 * vb + 4 * hi) * 64 + 32 * db + l32;
#pragma unroll
              for (int r = 0; r < 16; ++r) dc[((r & 3) + 8 * (r >> 2)) * 64] = acc[r];
              if (F.tid < 64) { float s = 0.f; for (int r = 0; r < 64; ++r) s += bf2f(*(const LAS unsigned short*)(Kt + r * ML_KSTR + F.tid * 2)); DN[((size_t)bh * NCK + c) * 64 + F.tid] = s; } }
            __syncthreads();
        }
    }
}
#undef ML_A_LOAD
__device__ __forceinline__ void mlstm_phase_b(Frame& F) {
    LAS float* part = (LAS float*)(F.lds + RING_OFF);
    const GAS float* MG = (const GAS float*)wsp<float>(F, WS_MG); const GAS bf16* MQ = (const GAS bf16*)wsp<bf16>(F, WS_MQ); const GAS bf16* MK = (const GAS bf16*)wsp<bf16>(F, WS_MK); const GAS bf16* MV = (const GAS bf16*)wsp<bf16>(F, WS_MV); const GAS bf16* MO = (const GAS bf16*)wsp<bf16>(F, WS_MO);
    for (int un = F.vcu; un < DEC_BATCH * 8; un += F.G) {
        const int b = un >> 3, h = un & 7, v = F.tid >> 2, dq = F.tid & 3; const size_t r0 = (size_t)MPR + b * DEC_SEQ;
        const float bi = inp(F, 16)[h], bfg = inp(F, 16)[8 + h], m0 = inp(F, 6)[un];
        float ig[4], bb[4], mt[4]; float run = 0.f;
#pragma unroll
        for (int t = 0; t < 4; ++t) { ig[t] = MG[(r0 + t) * 16 + h] + bi; run += log_sigmoidf_(MG[(r0 + t) * 16 + 8 + h] + bfg); bb[t] = run; }
#pragma unroll
        for (int t = 0; t < 4; ++t) { float mx = bb[t] + m0;
#pragma unroll
            for (int s = 0; s <= t; ++s) mx = fmaxf(mx, bb[t] - bb[s] + ig[s]); mt[t] = mx; }
        float qk[4][4], nq[4] = {0.f, 0.f, 0.f, 0.f};
#pragma unroll
        for (int t = 0; t < 4; ++t)
#pragma unroll
            for (int s = 0; s < 4; ++s) qk[t][s] = 0.f;
        const float* n0 = inp(F, 5) + (size_t)un * 64;
#pragma unroll 2
        for (int dc = 0; dc < 8; ++dc) {
            v4u qv[4], kv[4]; f32x4 na, nb;
#pragma unroll
            for (int t = 0; t < 4; ++t) { qv[t] = *(const GAS v4u*)(MQ + (r0 + t) * 512 + h * 64 + 8 * dc); kv[t] = *(const GAS v4u*)(MK + (r0 + t) * 512 + h * 64 + 8 * dc); }
            na = *(const GAS f32x4*)(n0 + 8 * dc); nb = *(const GAS f32x4*)(n0 + 8 * dc + 4);
#pragma unroll
            for (int e = 0; e < 8; ++e) { float q[4], k[4];
#pragma unroll
                for (int t = 0; t < 4; ++t) { const unsigned qw = qv[t][e >> 1], kw = kv[t][e >> 1]; q[t] = (e & 1) ? bfhi(qw) : bflo(qw); k[t] = (e & 1) ? bfhi(kw) : bflo(kw); }
                const float nn = e < 4 ? na[e & 3] : nb[e & 3];
#pragma unroll
                for (int t = 0; t < 4; ++t) { nq[t] += nn * q[t];
#pragma unroll
                    for (int s2 = 0; s2 <= t; ++s2) qk[t][s2] += q[t] * k[s2]; } } }
        const float* C0 = inp(F, 4) + ((size_t)un * 128 + v) * 64 + 16 * dq;
        float c0[16], cq[4] = {0.f, 0.f, 0.f, 0.f};
        v4u qd[4][2], kd[4][2];
#pragma unroll
        for (int t = 0; t < 4; ++t)
#pragma unroll
            for (int i = 0; i < 2; ++i) { qd[t][i] = *(const GAS v4u*)(MQ + (r0 + t) * 512 + h * 64 + 16 * dq + 8 * i); kd[t][i] = *(const GAS v4u*)(MK + (r0 + t) * 512 + h * 64 + 16 * dq + 8 * i); }
#pragma unroll
        for (int e = 0; e < 16; e += 4) { const f32x4 cc = *(const GAS f32x4*)(C0 + e); c0[e] = cc[0]; c0[e + 1] = cc[1]; c0[e + 2] = cc[2]; c0[e + 3] = cc[3]; }
#pragma unroll
        for (int t = 0; t < 4; ++t) {
#pragma unroll
            for (int e = 0; e < 16; ++e) { const unsigned w = qd[t][e >> 3][(e & 7) >> 1]; cq[t] += c0[e] * ((e & 1) ? bfhi(w) : bflo(w)); }
            cq[t] += __shfl_xor(cq[t], 1); cq[t] += __shfl_xor(cq[t], 2); }
        float vv[4], hv[4], ssq[4];
#pragma unroll
        for (int t = 0; t < 4; ++t) vv[t] = bf2f(MV[(r0 + t) * 1024 + h * 128 + v]);
#pragma unroll
        for (int t = 0; t < 4; ++t) { const float wi = expf_(bb[t] + m0 - mt[t]); float num = wi * cq[t], den = wi * nq[t];
#pragma unroll
            for (int s = 0; s <= t; ++s) { const float S = qk[t][s] * expf_(bb[t] - bb[s] + ig[s] - mt[t]); num += S * vv[s]; den += S; }
            hv[t] = num / fmaxf(fabsf(den), expf_(-mt[t])); float q2 = (dq == 0) ? hv[t] * hv[t] : 0.f;
#pragma unroll
            for (int o = 1; o < 64; o <<= 1) q2 += __shfl_xor(q2, o);
            ssq[t] = q2; }
        __syncthreads();
        if (F.lane == 0) {
#pragma unroll
            for (int t = 0; t < 4; ++t) part[F.wave * 4 + t] = ssq[t]; }
        __syncthreads();
        if (dq == 0) {
#pragma unroll
            for (int t = 0; t < 4; ++t) { float tot = 0.f;
#pragma unroll
                for (int w = 0; w < 8; ++w) tot += part[w * 4 + t];
                const float rn = 1.0f / sqrtf(tot * (1.0f / 128.0f) + RMS_EPS);
                const float o = hv[t] * rn * inp(F, 17)[h * 128 + v] * sigmoidf_(bf2f(MO[(r0 + t) * 1024 + h * 128 + v]));
                wsp<bf16>(F, WS_AO)[(r0 + t) * 1024 + h * 128 + v] = (bf16)(cvt_pk_bf16(o, 0.f) & 0xffffu); } }
        const float mL = mt[3], decay = expf_(bb[3] + m0 - mL); float wsv[4];
#pragma unroll
        for (int s = 0; s < 4; ++s) wsv[s] = expf_(bb[3] - bb[s] + ig[s] - mL);
        float* Co = outp(F) + O_CS + ((size_t)un * 128 + v) * 64 + 16 * dq;
#pragma unroll
        for (int e = 0; e < 16; ++e) { float a = decay * c0[e];
#pragma unroll
            for (int s = 0; s < 4; ++s) { const unsigned w = kd[s][e >> 3][(e & 7) >> 1]; a += wsv[s] * vv[s] * ((e & 1) ? bfhi(w) : bflo(w)); }
            Co[e] = a; }
        if (F.tid < 64) { float a = decay * n0[F.tid];
#pragma unroll
            for (int s = 0; s < 4; ++s) a += wsv[s] * bf2f(MK[(r0 + s) * 512 + h * 64 + F.tid]);
            F.out[O_NS + (size_t)un * 64 + F.tid] = a; }
        if (F.tid == 0) F.out[O_MS + un] = mL;
    }
    const GAS float* MSTd = (const GAS float*)wsp<float>(F, WS_MISC + MS_D); const GAS float* DC = (const GAS float*)wsp<float>(F, WS_MISC + MS_DC); const GAS float* DN = (const GAS float*)wsp<float>(F, WS_MISC + MS_DN);
    GAS bf16* CST = (GAS bf16*)wsp<bf16>(F, WS_MISC + MS_CST); GAS float* NST = (GAS float*)wsp<float>(F, WS_MISC + MS_NST);
    const int gt = F.vcu * NTHREADS + F.tid, NGT = F.G * NTHREADS;
    constexpr int SB = NCK < 8 ? NCK : 8;
    for (int it = gt; it < NBH * 4096; it += NGT) { const int bh = it >> 12, e2 = (it & 4095) * 2; f32x2 C = (f32x2){0.f, 0.f};
        for (int c0 = 0; c0 < NCK; c0 += SB) { f32x2 d[SB]; float dcy[SB];
#pragma unroll
            for (int i = 0; i < SB; ++i) { d[i] = *(const GAS f32x2*)(DC + ((size_t)bh * NCK + c0 + i) * 8192 + e2); dcy[i] = MSTd[bh * NCK + c0 + i]; }
#pragma unroll
            for (int i = 0; i < SB; ++i) { *(GAS unsigned*)(CST + ((size_t)bh * NCK + c0 + i) * 8192 + e2) = cvt_pk_bf16(C.x, C.y); C = C * dcy[i] + d[i]; } }
        *(GAS f32x2*)(outp(F) + O_CP + (size_t)bh * 8192 + e2) = C; }
    for (int it = gt; it < NBH * 64; it += NGT) { const int bh = it >> 6, d = it & 63; float n = 0.f;
        for (int c0 = 0; c0 < NCK; c0 += SB) { float dn[SB], dcy[SB];
#pragma unroll
            for (int i = 0; i < SB; ++i) { dn[i] = DN[((size_t)bh * NCK + c0 + i) * 64 + d]; dcy[i] = MSTd[bh * NCK + c0 + i]; }
#pragma unroll
            for (int i = 0; i < SB; ++i) { NST[((size_t)bh * NCK + c0 + i) * 64 + d] = n; n = n * dcy[i] + dn[i]; } }
        *(GAS float*)(outp(F) + O_NP + (size_t)bh * 64 + d) = n; }
}
__device__ __forceinline__ void mlstm_phase_c(Frame& F) {
    constexpr int WAREA = 64 * ML_VSTR + 1024;
    static_assert(WAREA * 8 <= RING_BYTES, "phase C LDS");
    LAS unsigned char* wl = F.lds + RING_OFF + F.wave * WAREA; LAS unsigned char* Vt = wl; LAS float* sU = (LAS float*)(wl + 64 * ML_VSTR); LAS float* sW = sU + 64; LAS float* sBc = sW + 64;
    const GAS float* MG = (const GAS float*)wsp<float>(F, WS_MG); const GAS bf16* MQ = (const GAS bf16*)wsp<bf16>(F, WS_MQ); const GAS bf16* MK = (const GAS bf16*)wsp<bf16>(F, WS_MK); const GAS bf16* MV = (const GAS bf16*)wsp<bf16>(F, WS_MV); const GAS bf16* MO = (const GAS bf16*)wsp<bf16>(F, WS_MO);
    const GAS float* MSTm = (const GAS float*)wsp<float>(F, WS_MISC + MS_M); const GAS bf16* CST = (const GAS bf16*)wsp<bf16>(F, WS_MISC + MS_CST); const GAS float* NST = (const GAS float*)wsp<float>(F, WS_MISC + MS_NST);
    const int lane = F.lane, l32 = lane & 31, hi = lane >> 5, gw = F.vcu * NWAVES + F.wave, NGW = F.G * NWAVES;
    const int pi = (l32 & 19) | ((l32 >> 1) & 4) | ((l32 << 1) & 8);
    for (int un = gw; un < NBH * NCK; un += NGW) {
        const int bh = un / NCK, c = un % NCK, b = bh >> 3, h = bh & 7; const size_t row0 = (size_t)b * SEQ + 64 * c;
        const float mc = MSTm[bh * (NCK + 1) + c];
        { const float ig = MG[(row0 + lane) * 16 + h] + inp(F, 16)[h], fg = log_sigmoidf_(MG[(row0 + lane) * 16 + 8 + h] + inp(F, 16)[8 + h]);
          const float bb = wave_incl_sum(fg, lane), uu = ig - bb, gg = wave_incl_max(uu, lane);
          sU[lane] = uu * LOG2E; sW[lane] = fmaxf(mc, gg) * LOG2E; sBc[lane] = bb * LOG2E; }
        { LAS unsigned char* vd = Vt + (lane >> 4) * ML_VSTR + (lane & 15) * 16; const GAS bf16* vs = MV + (row0 + (lane >> 4)) * 1024 + h * 128 + (lane & 15) * 8;
#pragma unroll
          for (int i = 0; i < 16; ++i) *(LAS v4u*)(vd + i * 4 * ML_VSTR) = *(const GAS v4u*)(vs + (size_t)i * 4 * 1024); }
        LDS_WAIT();
        const GAS float* nst = NST + ((size_t)bh * NCK + c) * 64; const GAS bf16* cst = CST + ((size_t)bh * NCK + c) * 8192;
#pragma unroll
        for (int tb = 0; tb < 2; ++tb) {
            const int t = 32 * tb + l32; const float Wt = sW[t], wi = __builtin_amdgcn_exp2f(mc * LOG2E - Wt);
            bf16x8 qf[4]; float nq = 0.f;
#pragma unroll
            for (int kc = 0; kc < 4; ++kc) { qf[kc] = *(const GAS bf16x8*)(MQ + (row0 + t) * 512 + h * 64 + 16 * kc + 8 * hi);
                const f32x4 n0 = *(const GAS f32x4*)(nst + 16 * kc + 8 * hi), n1 = *(const GAS f32x4*)(nst + 16 * kc + 8 * hi + 4); const v4u qw = __builtin_bit_cast(v4u, qf[kc]);
                nq += n0[0] * bflo(qw.x) + n0[1] * bfhi(qw.x) + n0[2] * bflo(qw.y) + n0[3] * bfhi(qw.y) + n1[0] * bflo(qw.z) + n1[1] * bfhi(qw.z) + n1[2] * bflo(qw.w) + n1[3] * bfhi(qw.w); }
            nq += __shfl_xor(nq, 32);
            f32x16 p[2]; float rs = 0.f;
#pragma unroll
            for (int sb = 0; sb < 2; ++sb) { p[sb] = (f32x16){};
                if (sb <= tb) {
#pragma unroll
                    for (int kc = 0; kc < 4; ++kc) p[sb] = __builtin_amdgcn_mfma_f32_32x32x16_bf16(*(const GAS bf16x8*)(MK + (row0 + 32 * sb + pi) * 512 + h * 64 + 16 * kc + 8 * hi), qf[kc], p[sb], 0, 0, 0);
#pragma unroll
                    for (int hf = 0; hf < 2; ++hf) { const int s0 = 32 * sb + 16 * hf + 8 * hi; const f32x4 u0 = *(const LAS f32x4*)(sU + s0), u1 = *(const LAS f32x4*)(sU + s0 + 4);
#pragma unroll
                        for (int e = 0; e < 8; ++e) { const float uu = e < 4 ? u0[e & 3] : u1[e & 3]; const float w = (s0 + e <= t) ? __builtin_amdgcn_exp2f(uu - Wt) : 0.f; const float x = p[sb][8 * hf + e] * w; p[sb][8 * hf + e] = x; rs += x; } } } }
            rs += __shfl_xor(rs, 32);
            const float den = wi * nq + rs, inv = 1.0f / fmaxf(fabsf(den), __builtin_amdgcn_exp2f(-(sBc[t] + Wt)));
            unsigned hp[4][8]; float ssq = 0.f;
            const int gi = l32 & 15;
#pragma unroll
            for (int vq = 0; vq < 4; ++vq) { f32x16 acc = (f32x16){};
#pragma unroll
                for (int kc = 0; kc < 4; ++kc) acc = __builtin_amdgcn_mfma_f32_32x32x16_bf16(*(const GAS bf16x8*)(cst + (32 * vq + l32) * 64 + 16 * kc + 8 * hi), qf[kc], acc, 0, 0, 0);
#pragma unroll
                for (int r = 0; r < 16; ++r) acc[r] *= wi;
                const LAS unsigned char* va = Vt + (8 * hi + (gi >> 2)) * ML_VSTR + (32 * vq + 16 * ((l32 >> 4) & 1) + 4 * (gi & 3)) * 2;
#pragma unroll
                for (int sb = 0; sb < 2; ++sb) if (sb <= tb) {
#pragma unroll
                    for (int ks = 0; ks < 2; ++ks) { const int r0 = 8 * ks; v4u pw;
                        pw.x = cvt_pk_bf16(p[sb][r0], p[sb][r0 + 1]); pw.y = cvt_pk_bf16(p[sb][r0 + 2], p[sb][r0 + 3]); pw.z = cvt_pk_bf16(p[sb][r0 + 4], p[sb][r0 + 5]); pw.w = cvt_pk_bf16(p[sb][r0 + 6], p[sb][r0 + 7]);
                        const v4i16 a0 = __builtin_amdgcn_ds_read_tr16_b64_v4i16((LAS v4i16*)(va + (32 * sb + 16 * ks) * ML_VSTR)), a1 = __builtin_amdgcn_ds_read_tr16_b64_v4i16((LAS v4i16*)(va + (32 * sb + 16 * ks + 4) * ML_VSTR));
                        acc = __builtin_amdgcn_mfma_f32_32x32x16_bf16(mk8(a0, a1), __builtin_bit_cast(bf16x8, pw), acc, 0, 0, 0); } }
#pragma unroll
                for (int r = 0; r < 16; r += 2) { const float h0 = acc[r] * inv, h1 = acc[r + 1] * inv; ssq += h0 * h0 + h1 * h1; hp[vq][r >> 1] = cvt_pk_bf16(h0, h1); } }
            ssq += __shfl_xor(ssq, 32);
            const float rn = 1.0f / sqrtf(ssq * (1.0f / 128.0f) + RMS_EPS);
            const float* hn = inp(F, 17) + h * 128; const GAS bf16* mo = MO + (row0 + t) * 1024 + h * 128; GAS bf16* ao = (GAS bf16*)wsp<bf16>(F, WS_AO) + (row0 + t) * 1024 + h * 128;
#pragma unroll
            for (int vq = 0; vq < 4; ++vq)
#pragma unroll
                for (int r4 = 0; r4 < 4; ++r4) { const int v = 32 * vq + 8 * r4 + 4 * hi; const f32x4 g = *(const GAS f32x4*)(hn + v); const v2u ow = *(const GAS v2u*)(mo + v);
                    const float y0 = bflo(hp[vq][2 * r4]) * rn * g[0] * sigmoidf_(bflo(ow.x)), y1 = bfhi(hp[vq][2 * r4]) * rn * g[1] * sigmoidf_(bfhi(ow.x));
                    const float y2 = bflo(hp[vq][2 * r4 + 1]) * rn * g[2] * sigmoidf_(bflo(ow.y)), y3 = bfhi(hp[vq][2 * r4 + 1]) * rn * g[3] * sigmoidf_(bfhi(ow.y));
                    v2u w; w.x = cvt_pk_bf16(y0, y1); w.y = cvt_pk_bf16(y2, y3); *(GAS v2u*)(ao + v) = w; }
        }
        LDS_WAIT();
    }
}
#ifndef PH_LO
#define PH_LO 0
#endif
#ifndef PH_HI
#define PH_HI 20
#endif
struct Args { const float* in[23]; float* out; unsigned char* ws; int ph_lo, ph_hi; };
constexpr int N_PHASES = 20, KSPLIT_DN = D_FF >= 2048 ? 8 : 2;
__global__ void __launch_bounds__(NTHREADS, 2) mega_fwd(Args args) {
#ifdef EMU
    unsigned char* lds = emu_cur->blk->lds;
#else
    extern __shared__ __attribute__((aligned(16))) unsigned char lds[];
#endif
    Frame F;
    F.lds = (LAS unsigned char*)lds;
    F.MISC = (volatile LAS unsigned*)(F.lds + MISC_OFF);
    F.tid = threadIdx.x; F.lane = F.tid & 63; F.wave = __builtin_amdgcn_readfirstlane(F.tid >> 6);
    F.G = gridDim.x; { const int bx = blockIdx.x; F.vcu = (F.G % 8 == 0) ? (bx % 8) * (F.G / 8) + bx / 8 : bx; }
    F.ws = args.ws; F.out = args.out; F.ctl = (gu32*)(args.ws + WS_CTL);
#ifdef EMU
    F.in = args.in;
#else
    { const unsigned char __attribute__((address_space(4)))* ka = (const unsigned char __attribute__((address_space(4)))*)__builtin_amdgcn_kernarg_segment_ptr();
      F.in = (const float* const*)(const unsigned char*)ka; }
#endif
    for (int u = F.tid; u < (LDS_BYTES - LDSCTL_OFF) / 4; u += NTHREADS) ((LAS unsigned*)(F.lds + LDSCTL_OFF))[u] = 0u;
    __syncthreads();
    XcdBarrier bar = xcd_barrier_post((unsigned*)(F.ctl + CW_BAR), F.MISC + 8, (unsigned)F.wave);
    constexpr int lo = PH_LO, hi = PH_HI;
#ifdef EMU
#define LAUNDER() ((void)0)
#else
#define RFL64(x) (((unsigned long long)(unsigned)__builtin_amdgcn_readfirstlane((int)((x) >> 32)) << 32) | (unsigned long long)(unsigned)__builtin_amdgcn_readfirstlane((int)(x)))
#define LAUNDER() do { unsigned long long a_ = (unsigned long long)F.ws, b_ = (unsigned long long)F.out, c_ = (unsigned long long)F.in; int w_ = F.wave; \
    a_ = RFL64(a_); b_ = RFL64(b_); c_ = RFL64(c_); w_ = __builtin_amdgcn_readfirstlane(w_); asm volatile("" : "+s"(a_), "+s"(b_), "+s"(c_), "+s"(w_)); \
    int l_ = lane_id(); asm volatile("" : "+v"(l_)); F.wave = w_; F.lane = l_; F.tid = w_ * 64 + l_; \
    F.ws = (unsigned char*)a_; F.out = (float*)b_; F.in = (const float* const*)c_; F.ctl = (gu32*)(F.ws + WS_CTL); } while (0)
#endif
#ifndef DUP_MASK
#define DUP_MASK 0u
#endif
#define REP(k) for (int rep_ = 0; rep_ < (((DUP_MASK) >> (k)) & 1u ? 2 : 1); ++rep_, __syncthreads())
#define IN(k) (lo <= (k) && (k) < hi)
#define SEAM(k) do { if (IN(k) && IN((k) + 1)) xcd_barrier(bar); LAUNDER(); } while (0)
    const float* norm_g = inp(F, 9);

    if (IN(0)) REP(0) { p0_prologue(F); compress_prologue(F); } SEAM(0);
    if (IN(1)) REP(1) {
        pg8::Gemm g{wsp<bf16>(F, WS_H), wsp<bf16>(F, WS_WNSAIN), MPAD, NSA_IN_PAD, D}; pg8::StaticOrder S; S.init(MPAD, NSA_IN_PAD, F.G, (int)blockIdx.x);
        EpiNsaIn E{F.ws, F.out};
        pg8::gemm_phase<EpiNsaIn, pg8::StaticOrder, false, true>(F.lds + RING_OFF, g, S, E, F.wave);
    } SEAM(1);
    if (IN(2)) { compress_phase(F, 0); }
    if (IN(3)) { nsa_attn_phase(F, 0); if (AT_PROBE) { __syncthreads(); nsa_attn_phase(F, 1); } } SEAM(3);
#pragma unroll 1
    for (int layer = 0; layer < 2; ++layer) {
        const int pb = layer * 10;
        if (layer == 1) {
            if (IN(10)) REP(10) {
                pg8::Gemm g{wsp<bf16>(F, WS_H), wsp<bf16>(F, WS_WMLIN), MPAD, ML_IN_PAD, D}; pg8::StaticOrder S; S.init(MPAD, ML_IN_PAD, F.G, (int)blockIdx.x);
                EpiMlIn E{F.ws};
                pg8::gemm_phase<EpiMlIn, pg8::StaticOrder, false, true>(F.lds + RING_OFF, g, S, E, F.wave);
            } SEAM(10);
            if (IN(11)) REP(11) { mlstm_phase_a(F); } SEAM(11);
            if (IN(12)) REP(12) { mlstm_phase_b(F); } SEAM(12);
            if (IN(13)) REP(13) { mlstm_phase_c(F); } SEAM(13);
        }
        if (IN(pb + 4)) {
            pg8::Gemm g{wsp<bf16>(F, WS_AO), wsp<bf16>(F, layer ? WS_WMLOUT : WS_WNSAOUT), MPR, D, D}; pg8::StaticOrder S; S.init(MPR, D, F.G, (int)blockIdx.x);
            EpiRmsRes E{F.ws, F.out, norm_g + (size_t)(layer * 4 + 1) * D, norm_g + (size_t)(layer * 4 + 2) * D, F.ctl, layer * 2};
            pg8::gemm_phase<EpiRmsRes, pg8::StaticOrder, false, true>(F.lds + RING_OFF, g, S, E, F.wave);
            mini_gemm(F, wsp<bf16>(F, WS_AO), wsp<bf16>(F, layer ? WS_WMLOUT : WS_WNSAOUT), MPR, MSA, 0, D, D, 4, E);
        } SEAM(pb + 4);
        if (IN(pb + 6)) {
            gu32* gate = F.ctl + CW_SN + 64 * layer;
            norm_phase(F, MPR, wsp<float>(F, WS_Y), wsp<float>(F, WS_YS), 4, norm_g + (size_t)(layer * 4 + 1) * D, norm_g + (size_t)(layer * 4 + 2) * D, wsp<bf16>(F, WS_H), gate, F.G >= 64 + NSN ? 64 : 0); LAUNDER(); gate = F.ctl + CW_SN + 64 * layer;
            REP(6) {
            pg8::Gemm g{wsp<bf16>(F, WS_H), wsp<bf16>(F, WS_WUP) + (size_t)layer * FF2 * D, MPAD, FF2, D}; GatedOrder S; S.init(MPAD, FF2, F.G, (int)blockIdx.x); S.gate = gate; S.tmo = F.ctl + CW_TMO;
            EpiUpConv E{F.ws, F.out, F.in, layer, (LAS float*)(F.lds + RING_OFF + UPX_OFF)};
            pg8::gemm_phase<EpiUpConv, GatedOrder, true, true>(F.lds + RING_OFF, g, S, E, F.wave); }
        } SEAM(pb + 6);
        if (IN(pb + 7)) REP(7) { conv_fix_phase(F, layer); } SEAM(pb + 7);
        if (IN(pb + 8)) {
            pg8::Gemm g{wsp<bf16>(F, WS_ACT), wsp<bf16>(F, WS_WDOWN) + (size_t)layer * D * D_FF, MPR, D, D_FF}; pg8::StaticOrder S; S.init(MPR, D, F.G, (int)blockIdx.x);
            EpiRmsRes E{F.ws, F.out, norm_g + (size_t)(layer * 4 + 3) * D, layer == 0 ? norm_g + (size_t)4 * D : nullptr, F.ctl, layer * 2 + 1};
            pg8::gemm_phase<EpiRmsRes, pg8::StaticOrder, false, false>(F.lds + RING_OFF, g, S, E, F.wave);
            mini_gemm(F, wsp<bf16>(F, WS_ACT), wsp<bf16>(F, WS_WDOWN) + (size_t)layer * D * D_FF, MPR, MSA, 0, D, D_FF, KSPLIT_DN, E);
        } SEAM(pb + 8);
        if (IN(pb + 9)) { norm_phase(F, MPR, wsp<float>(F, WS_Y), wsp<float>(F, WS_YS), KSPLIT_DN, norm_g + (size_t)(layer * 4 + 3) * D, layer == 0 ? norm_g + (size_t)4 * D : nullptr, wsp<bf16>(F, WS_H)); }
        if (layer == 0) SEAM(9);
    }
#undef IN
#undef SEAM
}

extern "C" void kernel_launch(void* const* d_in, const int* in_sizes, int n_in, void* d_out, int out_size, void* d_ws, size_t ws_size, hipStream_t stream) {
    static int grid = 0;
    if (grid == 0) {
        if (n_in != 23 || (size_t)out_size != O_END || ws_size < WS_END) { fprintf(stderr, "kernel_launch: unexpected sizes n_in %d out %d (want %zu) ws %zu (want %zu)\n", n_in, out_size, (size_t)O_END, ws_size, (size_t)WS_END); grid = -1; return; }
        int dev = 0, cus = 0, per_cu = 0;
        if (hipGetDevice(&dev) != hipSuccess || hipDeviceGetAttribute(&cus, hipDeviceAttributeMultiprocessorCount, dev) != hipSuccess) { grid = -1; return; }
        if (hipFuncSetAttribute((const void*)mega_fwd, hipFuncAttributeMaxDynamicSharedMemorySize, LDS_BYTES) != hipSuccess) { fprintf(stderr, "kernel_launch: hipFuncSetAttribute failed\n"); grid = -1; return; }
        if (hipOccupancyMaxActiveBlocksPerMultiprocessor(&per_cu, (const void*)mega_fwd, NTHREADS, LDS_BYTES) != hipSuccess || per_cu < 1) fprintf(stderr, "kernel_launch: occupancy query says %d\n", per_cu);
        (void)hipGetLastError();
        grid = cus;
    }
    if (grid < 0) return;
    (void)hipMemsetAsync((char*)d_ws + WS_CTL, 0, CTL_ZERO_BYTES, stream);
    Args a{};
    for (int i = 0; i < 23; ++i) a.in[i] = (const float*)d_in[i];
    a.out = (float*)d_out; a.ws = (unsigned char*)d_ws; a.ph_lo = PH_LO; a.ph_hi = PH_HI;
    hipLaunchKernelGGL(mega_fwd, dim3(grid), dim3(NTHREADS), LDS_BYTES, stream, a);
}
#ifdef EMU
static void dump_region(const char* dir, const char* name, void* ws, size_t off, size_t bytes) { char p[512]; snprintf(p, sizeof p, "%s/ws_%s.bin", dir, name); FILE* f = fopen(p, "wb"); fwrite((char*)ws + off, 1, bytes, f); fclose(f); }
void emu_dump_ws(const char* dir, void* ws) {
    dump_region(dir, "H", ws, WS_H, (size_t)MPAD * D * 2); dump_region(dir, "Q", ws, WS_Q, (size_t)MPAD * D * 2); dump_region(dir, "KVB", ws, WS_KVB, (size_t)MPAD * D * 2);
    dump_region(dir, "WINB", ws, WS_WINB, (size_t)MPAD * 512 * 2); dump_region(dir, "GATES", ws, WS_GATES, (size_t)MPAD * 48 * 4); dump_region(dir, "AO", ws, WS_AO, (size_t)MPAD * D * 2);
    dump_region(dir, "Y", ws, WS_Y, (size_t)MPAD * D * 4); dump_region(dir, "U", ws, WS_U, (size_t)MPAD * FF2 * 2); dump_region(dir, "ACT", ws, WS_ACT, (size_t)MPAD * D_FF * 2);
    dump_region(dir, "KC", ws, WS_KC, (size_t)32 << 20); dump_region(dir, "MISC", ws, WS_MISC, (size_t)64 << 20);
    dump_region(dir, "MQ", ws, WS_MQ, (size_t)MPAD * 512 * 2); dump_region(dir, "MK", ws, WS_MK, (size_t)MPAD * 512 * 2); dump_region(dir, "MV", ws, WS_MV, (size_t)MPAD * D * 2);
    dump_region(dir, "MO", ws, WS_MO, (size_t)MPAD * D * 2); dump_region(dir, "MG", ws, WS_MG, (size_t)MPAD * 16 * 4);
    dump_region(dir, "WNSAIN", ws, WS_WNSAIN, (size_t)NSA_IN_PAD * D * 2);
    dump_region(dir, "CTL", ws, WS_CTL, 65536);
}
#endif
```

```cpp
#ifndef EMU
#include <hip/hip_runtime.h>
#endif
#include <cstdio>
#include <cstdint>
#ifdef EMU
#define LAS
#define GAS
#define ASMV(...) ((void)0)
#else
#define LAS __attribute__((address_space(3)))
#define GAS __attribute__((address_space(1)))
#define ASMV(...) asm volatile(__VA_ARGS__)
#endif

#ifdef EMU
static inline int lane_id() { return emu_cur->lane; }
#else
__device__ __forceinline__ int lane_id() { unsigned ones = ~0u; asm volatile("" : "+s"(ones)); return (int)__builtin_amdgcn_mbcnt_hi(ones, __builtin_amdgcn_mbcnt_lo(ones, 0u)); }
#endif
#ifdef EMU
static inline int bcast0(int v) { return (int)emu_xchg((unsigned)v, 0); }
#else
__device__ __forceinline__ int bcast0(int v) { return __builtin_amdgcn_readfirstlane(v); }
#endif
#ifdef EMU_CFG_SMALL
#ifndef EMU_DFF
#define EMU_DFF 512
#endif
#ifndef EMU_DECB
#define EMU_DECB 2
#endif
constexpr int BATCH = 1, SEQ = 512, DEC_BATCH = EMU_DECB, PAST_LEN = 512, SEL_TOPK = 4, WINDOW = 128, D_FF = EMU_DFF;
#else
constexpr int BATCH = 4, SEQ = 4096, DEC_BATCH = 32, PAST_LEN = 8192, SEL_TOPK = 16, WINDOW = 512, D_FF = 4096;
#endif
constexpr int DEC_SEQ = 4, PAGE_SIZE = 128, D = 1024, FF2 = 2 * D_FF;
constexpr int MPR = BATCH * SEQ, MSA = DEC_BATCH * DEC_SEQ, MT = MPR + MSA, MPAD = (MT + 255) / 256 * 256;
constexpr int NSA_IN = 2608, NSA_IN_PAD = 2816, ML_IN = 3088, ML_IN_PAD = 3328;
constexpr int N_PAGES = PAST_LEN / PAGE_SIZE, N_USED = DEC_BATCH * N_PAGES, N_PHYS = N_USED + (N_USED / 4 > 1 ? N_USED / 4 : 1);
constexpr int WB_LEN = WINDOW < PAST_LEN ? WINDOW : PAST_LEN, WKEEP = WINDOW < SEQ ? WINDOW : SEQ;
constexpr int NCH_P = SEQ / 16, NC_P = NCH_P - 1, TS = PAST_LEN + DEC_SEQ, NCH_S = TS / 16, NC_S = NCH_S - 1;
constexpr int NSEL_P = SEQ / 64, NSEL_S = (TS + 63) / 64;
constexpr float RMS_EPS = 1e-6f;
constexpr float QSCALE = 0.125f * 1.4426950408889634f;
static_assert(PAST_LEN % 64 == 0 && SEQ % 64 == 0 && DEC_SEQ == 4, "shape assumptions");

constexpr size_t O_Y = 0, O_KV = O_Y + (size_t)MT * D, O_WINP = O_KV + (size_t)MT * D, O_WINS = O_WINP + (size_t)BATCH * WKEEP * 512,
    O_CP = O_WINS + (size_t)DEC_BATCH * WB_LEN * 512, O_CS = O_CP + (size_t)BATCH * 8 * 128 * 64, O_NP = O_CS + (size_t)DEC_BATCH * 8 * 128 * 64,
    O_NS = O_NP + (size_t)BATCH * 8 * 64, O_MP = O_NS + (size_t)DEC_BATCH * 8 * 64, O_MS = O_MP + (size_t)BATCH * 8, O_CVP = O_MS + (size_t)DEC_BATCH * 8,
    O_CVS = O_CVP + (size_t)2 * BATCH * 2 * FF2, O_END = O_CVS + (size_t)2 * DEC_BATCH * 2 * FF2;

constexpr size_t al4k(size_t x) { return (x + 4095) & ~(size_t)4095; }
constexpr size_t WS_CTL = 0, CTL_ZERO_BYTES = 1u << 20;
constexpr size_t WS_WNSAIN = CTL_ZERO_BYTES;
constexpr size_t WS_WNSAOUT = WS_WNSAIN + al4k((size_t)NSA_IN_PAD * D * 2);
constexpr size_t WS_WMLIN = WS_WNSAOUT + al4k((size_t)D * D * 2);
constexpr size_t WS_WMLOUT = WS_WMLIN + al4k((size_t)ML_IN_PAD * D * 2);
constexpr size_t WS_WUP = WS_WMLOUT + al4k((size_t)D * D * 2);
constexpr size_t WS_WDOWN = WS_WUP + al4k((size_t)2 * FF2 * D * 2);
constexpr size_t WS_H = WS_WDOWN + al4k((size_t)2 * D * D_FF * 2);
constexpr size_t WS_Q = WS_H + al4k((size_t)MPAD * D * 2);
constexpr size_t WS_KVB = WS_Q + al4k((size_t)MPAD * D * 2);
constexpr size_t WS_WINB = WS_KVB + al4k((size_t)MPAD * D * 2);
constexpr size_t WS_GATES = WS_WINB + al4k((size_t)MPAD * 512 * 2);
constexpr size_t WS_AO = WS_GATES + al4k((size_t)MPAD * 48 * 4);
constexpr size_t WS_Y = WS_AO + al4k((size_t)MPAD * D * 2);
constexpr size_t WS_U = WS_Y + al4k((size_t)MPAD * D * 4);
constexpr size_t WS_ACT = WS_U + al4k((size_t)MPAD * FF2 * 2);
constexpr size_t WS_KC = WS_ACT + al4k((size_t)MPAD * D_FF * 2);
constexpr size_t KC_P_ELEMS = (size_t)BATCH * 4 * 256 * 64 * (NC_P + 255) / 256 * 1;
constexpr size_t WS_MQ = WS_KC + al4k((size_t)64 << 20);
constexpr size_t WS_MK = WS_MQ + al4k((size_t)MPAD * 512 * 2);
constexpr size_t WS_MV = WS_MK + al4k((size_t)MPAD * 512 * 2);
constexpr size_t WS_MO = WS_MV + al4k((size_t)MPAD * D * 2);
constexpr size_t WS_MG = WS_MO + al4k((size_t)MPAD * D * 2);
constexpr size_t WS_YS = WS_MG + al4k((size_t)MPAD * 16 * 4);
constexpr size_t WS_XS = WS_YS + al4k((size_t)8 * MSA * D * 4);
constexpr size_t WS_UB = WS_XS + al4k((size_t)8 * MPR * 4 * 4) - al4k((size_t)8 * MSA * D * 4) + al4k((size_t)8 * MSA * D * 4);
constexpr size_t WS_MISC = WS_UB + al4k((size_t)(MPR / 256) * 4 * FF2 * 2) - al4k((size_t)8 * MSA * D * 4) + al4k((size_t)8 * MSA * D * 4);
constexpr size_t WS_END = WS_MISC + ((size_t)512 << 20);
constexpr int CW_TMO = 0, CW_BAR = 4096;
namespace pg8 {
typedef unsigned short bf16_t;
typedef short bf16x8 __attribute__((ext_vector_type(8)));
typedef float f32x4 __attribute__((ext_vector_type(4)));
typedef unsigned u32x4 __attribute__((ext_vector_type(4)));
constexpr int BM = 256, BK = 64, HALF = 128, HTB = HALF * BK * 2  , STAGE_BYTES = 8 * HTB, NXCD = 8, WGM = 8;

__host__ __device__ __forceinline__ int lds_byte(int r, int c) { const int st = (r >> 4) * 2 + (c >> 5), rr = r & 15, cc = c & 31, ob = rr * 64 + cc * 2; return st * 1024 + (ob ^ (((ob >> 9) & 1) << 5)); }
__host__ __device__ __forceinline__ void stage_rc(int b, int& R, int& C) { const int st = b / 1024, sb = b % 1024, swz = sb ^ (((sb >> 9) & 1) << 5); R = (st >> 1) * 16 + swz / 64; C = (st & 1) * 32 + (swz % 64) / 2; }
__host__ __device__ __forceinline__ int perm32(int rho) { const int n = rho >> 4, i = rho & 15; return 8 * (i >> 2) + 4 * n + (i & 3); }

struct Unit { int pm, pn; };
struct Gemm { const bf16_t* A; const bf16_t* Bt; int M, N, K; };

struct StaticOrder {
    int nM, nN, nwg, G, c;
    __host__ __device__ void init(int M, int N, int G_, int c_) { nM = M / BM; nN = N / BM; nwg = nM * nN; G = G_; c = c_; }
    __host__ __device__ bool next(int i, Unit& u) const {
        const long L = (long)i * G + c; if (L >= nwg) return false;
        int wgid = (int)L; { const int q = nwg / NXCD, r = nwg % NXCD, xcd = wgid % NXCD, off = wgid / NXCD; wgid = (xcd < r ? xcd * (q + 1) : r * (q + 1) + (xcd - r) * q) + off; }
        const int nig = WGM * nN, gid = wgid / nig, fm = gid * WGM, gsz = (nM - fm) < WGM ? (nM - fm) : WGM;
        u.pm = fm + ((wgid % nig) % gsz); u.pn = (wgid % nig) / gsz; return true;
    }
    __device__ __forceinline__ void a_ready(const Unit&) const {}
    __device__ __forceinline__ void done(const Unit&) const {}
};

#ifdef EMU
__device__ __forceinline__ unsigned cvt_pk_bf16(float lo, float hi) { unsigned a = __builtin_bit_cast(unsigned, lo), b = __builtin_bit_cast(unsigned, hi);
    a = (a + 0x7fffu + ((a >> 16) & 1u)) >> 16; b = (b + 0x7fffu + ((b >> 16) & 1u)) >> 16; return a | (b << 16); }
#else
typedef float cvt_f32x2_t __attribute__((ext_vector_type(2))); typedef __bf16 cvt_bf16x2_t __attribute__((ext_vector_type(2)));
__device__ __forceinline__ unsigned cvt_pk_bf16(float lo, float hi) { const cvt_f32x2_t v = {lo, hi}; const cvt_bf16x2_t b = __builtin_convertvector(v, cvt_bf16x2_t); return __builtin_bit_cast(unsigned, b); }
#endif
template <class Epi, class Sched, bool ALIGN_EPI = false, bool SP2 = false>
__device__ __forceinline__ void gemm_phase(LAS unsigned char* lds, const Gemm g, const Sched& S, const Epi& E, int wave_id) {
    int tid_ = wave_id * 64 + lane_id(); ASMV("" : "+v"(tid_));
    const int tid = tid_, wid = __builtin_amdgcn_readfirstlane(tid >> 6), lane = tid & 63, wr = wid >> 2, wc = wid & 3, fr = lane & 15, fq = lane >> 4;
    const int K = g.K, nt = K / BK;
    unsigned voffA[2], voffB[2];
#pragma unroll
    for (int i = 0; i < 2; ++i) { int R, C; stage_rc(tid * 16 + i * 8192, R, C); const int Rb = Epi::PERM ? ((R & ~31) + perm32(R & 31)) : R;
        voffA[i] = (unsigned)(R * K + C) * 2u; voffB[i] = (unsigned)(Rb * K + C) * 2u; }
    const size_t kstep = (size_t)(BK * 2);
    const size_t hstep = (size_t)HALF * K * 2;
    const size_t tstep = 2 * hstep;
    const unsigned ldsw = (unsigned)wid * 1024u;
    const int aoff = lds_byte(wr * 64 + fr, fq * 8), boff = lds_byte(wc * 32 + fr, fq * 8);
#define PG8_SA(b, h) (((b) * 2 + (h)) * HTB)
#define PG8_SB(b, h) ((4 + (b) * 2 + (h)) * HTB)
#define PG8_STAGE(bufoff, gbase, voff) do { _Pragma("unroll") for (int _i = 0; _i < 2; ++_i) \
        __builtin_amdgcn_global_load_lds((const unsigned*)((const char*)(gbase) + (voff)[_i]), (LAS unsigned*)(lds + (bufoff) + ldsw + _i * 8192), 16, 0, 0); } while (0)
#define PG8_LDA(dst, b, h) do { _Pragma("unroll") for (int m = 0; m < 4; ++m) _Pragma("unroll") for (int k = 0; k < 2; ++k) dst[m][k] = *(const LAS bf16x8*)(lds + PG8_SA(b, h) + aoff + m * 2048 + k * 1024); } while (0)
#define PG8_LDB(dst, b, h) do { _Pragma("unroll") for (int n = 0; n < 2; ++n) _Pragma("unroll") for (int k = 0; k < 2; ++k) dst[n][k] = *(const LAS bf16x8*)(lds + PG8_SB(b, h) + boff + n * 2048 + k * 1024); } while (0)
#define PG8_MMA(ai, bj, At, Bt) do { __builtin_amdgcn_s_setprio(1); _Pragma("unroll") for (int m = 0; m < 4; ++m) _Pragma("unroll") for (int n = 0; n < 2; ++n) _Pragma("unroll") for (int k = 0; k < 2; ++k) \
        acc[ai][bj][m][n] = __builtin_amdgcn_mfma_f32_16x16x32_bf16(Bt[n][k], At[m][k], acc[ai][bj][m][n], 0, 0, 0); __builtin_amdgcn_s_setprio(0); } while (0)
#define PG8_WAIT_V(n) ASMV("s_waitcnt vmcnt(" #n ")" ::: "memory")
#define PG8_WAIT_L(n) ASMV("s_waitcnt lgkmcnt(" #n ")" ::: "memory")
#define PG8_BAR __builtin_amdgcn_s_barrier()
#define PG8_SCHED __builtin_amdgcn_sched_barrier(0)
    Unit cur, nxt; int ui = 0;
    if (!S.next(0, cur)) return;
    f32x4 acc[2][2][4][2];
#pragma unroll
    for (int a = 0; a < 2; ++a)
#pragma unroll
        for (int b = 0; b < 2; ++b)
#pragma unroll
            for (int m = 0; m < 4; ++m)
#pragma unroll
                for (int n = 0; n < 2; ++n) acc[a][b][m][n] = (f32x4){0.f, 0.f, 0.f, 0.f};
    bf16x8 At[4][2], B0[2][2], B1[2][2];
    const char* cA = (const char*)g.A + (size_t)cur.pm * tstep; const char* cB = (const char*)g.Bt + (size_t)cur.pn * tstep;
    S.a_ready(cur);
    if constexpr (SP2) {
        PG8_STAGE(PG8_SB(0, 0), cB, voffB); PG8_STAGE(PG8_SB(0, 1), cB + hstep, voffB); PG8_STAGE(PG8_SA(0, 0), cA, voffA); PG8_STAGE(PG8_SA(0, 1), cA + hstep, voffA);
        if (wr == 1) PG8_BAR;
        PG8_WAIT_V(2); PG8_BAR;
        PG8_STAGE(PG8_SB(1, 0), cB + kstep, voffB); PG8_STAGE(PG8_SA(1, 0), cA + kstep, voffA); PG8_STAGE(PG8_SB(1, 1), cB + hstep + kstep, voffB);
        PG8_WAIT_V(6); PG8_BAR;
    } else {
        PG8_STAGE(PG8_SB(0, 0), cB, voffB); PG8_STAGE(PG8_SA(0, 0), cA, voffA); PG8_STAGE(PG8_SB(0, 1), cB + hstep, voffB); PG8_STAGE(PG8_SA(0, 1), cA + hstep, voffA);
        if (wr == 1) PG8_BAR;
        PG8_WAIT_V(4); PG8_BAR;
        PG8_STAGE(PG8_SB(1, 0), cB + kstep, voffB); PG8_STAGE(PG8_SA(1, 0), cA + kstep, voffA); PG8_STAGE(PG8_SB(1, 1), cB + hstep + kstep, voffB);
        PG8_WAIT_V(6); PG8_BAR;
    }
    for (;;) {
        const bool has_next = S.next(ui + 1, nxt);
        const char* nA = has_next ? (const char*)g.A + (size_t)nxt.pm * tstep : cA; const char* nB = has_next ? (const char*)g.Bt + (size_t)nxt.pn * tstep : cB;
        for (int t = 0; t < nt; t += 2) {
            const bool last = (t == nt - 2);
            const char* a1 = cA + (size_t)(t + 1) * kstep;
            const char* a2 = last ? nA : cA + (size_t)(t + 2) * kstep; const char* b2 = last ? nB : cB + (size_t)(t + 2) * kstep;
            const char* a3 = a2 + kstep; const char* b3 = b2 + kstep;
            if (last && has_next) S.a_ready(nxt);
            if constexpr (SP2) {
            PG8_LDB(B0, 0, 0); PG8_LDB(B1, 0, 1); PG8_SCHED; PG8_LDA(At, 0, 0); PG8_STAGE(PG8_SA(1, 1), a1 + hstep, voffA);
            PG8_WAIT_V(8); PG8_WAIT_L(0); PG8_BAR; PG8_MMA(0, 0, At, B0); PG8_MMA(0, 1, At, B1); PG8_BAR; PG8_SCHED;
            PG8_LDA(At, 0, 1); PG8_STAGE(PG8_SB(0, 0), b2, voffB); PG8_STAGE(PG8_SB(0, 1), b2 + hstep, voffB); PG8_STAGE(PG8_SA(0, 0), a2, voffA);
            PG8_WAIT_V(8); PG8_WAIT_L(0); PG8_BAR; PG8_MMA(1, 0, At, B0); PG8_MMA(1, 1, At, B1); PG8_BAR; PG8_SCHED;
            PG8_LDB(B0, 1, 0); PG8_LDB(B1, 1, 1); PG8_SCHED; PG8_LDA(At, 1, 0); PG8_STAGE(PG8_SA(0, 1), a2 + hstep, voffA);
            PG8_WAIT_V(8); PG8_WAIT_L(0); PG8_BAR; PG8_MMA(0, 0, At, B0); PG8_MMA(0, 1, At, B1); PG8_BAR; PG8_SCHED;
            PG8_LDA(At, 1, 1); PG8_STAGE(PG8_SB(1, 0), b3, voffB); PG8_STAGE(PG8_SB(1, 1), b3 + hstep, voffB); PG8_STAGE(PG8_SA(1, 0), a3, voffA);
            PG8_WAIT_V(8); PG8_WAIT_L(0); PG8_BAR; PG8_MMA(1, 0, At, B0); PG8_MMA(1, 1, At, B1); PG8_BAR; PG8_SCHED;
            } else {
            PG8_LDB(B0, 0, 0); PG8_SCHED; PG8_LDA(At, 0, 0); PG8_STAGE(PG8_SA(1, 1), a1 + hstep, voffA);
            PG8_WAIT_L(8); PG8_BAR; PG8_WAIT_L(0); PG8_MMA(0, 0, At, B0); PG8_BAR; PG8_SCHED;
            PG8_LDB(B1, 0, 1); PG8_STAGE(PG8_SB(0, 0), b2, voffB);
            PG8_BAR; PG8_WAIT_L(0); PG8_MMA(0, 1, At, B1); PG8_BAR;
            PG8_LDA(At, 0, 1); PG8_STAGE(PG8_SA(0, 0), a2, voffA);
            PG8_BAR; PG8_WAIT_L(0); PG8_MMA(1, 0, At, B0); PG8_BAR; PG8_SCHED;
            PG8_STAGE(PG8_SB(0, 1), b2 + hstep, voffB);
            PG8_WAIT_V(6); PG8_BAR; PG8_MMA(1, 1, At, B1); PG8_BAR;
            PG8_LDB(B0, 1, 0); PG8_SCHED; PG8_LDA(At, 1, 0); PG8_STAGE(PG8_SA(0, 1), a2 + hstep, voffA);
            PG8_WAIT_L(8); PG8_BAR; PG8_WAIT_L(0); PG8_MMA(0, 0, At, B0); PG8_BAR; PG8_SCHED;
            PG8_LDB(B1, 1, 1); PG8_STAGE(PG8_SB(1, 0), b3, voffB);
            PG8_BAR; PG8_WAIT_L(0); PG8_MMA(0, 1, At, B1); PG8_BAR;
            PG8_LDA(At, 1, 1); PG8_STAGE(PG8_SA(1, 0), a3, voffA);
            PG8_BAR; PG8_WAIT_L(0); PG8_MMA(1, 0, At, B0); PG8_BAR; PG8_SCHED;
            PG8_STAGE(PG8_SB(1, 1), b3 + hstep, voffB);
            PG8_WAIT_V(6); PG8_BAR; PG8_MMA(1, 1, At, B1); PG8_BAR;
            }
        }
        if constexpr (ALIGN_EPI) { if (wr == 0) PG8_BAR; }
        if constexpr (!Epi::AFTER_DRAIN) { E(acc, cur, wr, wc, fr, fq); S.done(cur); }
        if (!has_next) break;
#pragma unroll
        for (int a = 0; a < 2; ++a)
#pragma unroll
            for (int b = 0; b < 2; ++b)
#pragma unroll
                for (int m = 0; m < 4; ++m)
#pragma unroll
                    for (int n = 0; n < 2; ++n) acc[a][b][m][n] = (f32x4){0.f, 0.f, 0.f, 0.f};
        cur = nxt; cA = nA; cB = nB; ++ui;
        if constexpr (ALIGN_EPI) { if (wr == 1) PG8_BAR; }
    }
    PG8_WAIT_V(0);
    if constexpr (!ALIGN_EPI) { if (wr == 0) PG8_BAR; }
    PG8_BAR;
    if constexpr (Epi::AFTER_DRAIN) { E.fused(acc, cur, wr, wc, fr, fq, lds, wid, lane); S.done(cur); }
#undef PG8_SA
#undef PG8_SB
#undef PG8_STAGE
#undef PG8_LDA
#undef PG8_LDB
#undef PG8_MMA
#undef PG8_WAIT_V
#undef PG8_WAIT_L
#undef PG8_BAR
#undef PG8_SCHED
}
}
typedef unsigned short bf16;
typedef unsigned v4u __attribute__((ext_vector_type(4)));
typedef unsigned v2u __attribute__((ext_vector_type(2)));
typedef float f32x4 __attribute__((ext_vector_type(4)));
typedef float f32x2 __attribute__((ext_vector_type(2)));
typedef float f32x16 __attribute__((ext_vector_type(16)));
typedef short bf16x8 __attribute__((ext_vector_type(8)));
typedef GAS unsigned gu32;
#define RLX_AGENT __ATOMIC_RELAXED, __HIP_MEMORY_SCOPE_AGENT
#ifdef EMU
#define LDS_WAIT() emu_wave_sync()
#else
#define LDS_WAIT() ASMV("s_waitcnt lgkmcnt(0)" ::: "memory")
#endif
#define VM_WAIT() ASMV("s_waitcnt vmcnt(0)" ::: "memory")
using pg8::cvt_pk_bf16;
__device__ __forceinline__ float bf2f(unsigned short h) { return __builtin_bit_cast(float, (unsigned)h << 16); }
__device__ __forceinline__ float bflo(unsigned w) { return __builtin_bit_cast(float, w << 16); }
__device__ __forceinline__ float bfhi(unsigned w) { return __builtin_bit_cast(float, w & 0xffff0000u); }
__device__ __forceinline__ float wave_sum(float v) {
#pragma unroll
    for (int o = 1; o < 64; o <<= 1) v += __shfl_xor(v, o);
    return v;
}
__device__ __forceinline__ float wave_max(float v) {
#pragma unroll
    for (int o = 1; o < 64; o <<= 1) v = fmaxf(v, __shfl_xor(v, o));
    return v;
}
__device__ __forceinline__ float gelu_tanh(float x) {
    constexpr float K1 = -2.0f * 1.4426950408889634f * 0.7978845608028654f, K2 = K1 * 0.044715f;
    const float t = x * __builtin_fmaf(x * x, K2, K1);
    return x * __builtin_amdgcn_rcpf(1.0f + __builtin_amdgcn_exp2f(t));
}
__device__ __forceinline__ float sigmoidf_(float x) { return __builtin_amdgcn_rcpf(1.0f + __builtin_amdgcn_exp2f(-1.4426950408889634f * x)); }
#define XB_TMO      128
#define XB_XCNT(j)  (256  + 64 * (j))
#define XB_XSUB(j)  (1280 + 64 * (j))
#define XB_XGEN(j)  (2304 + 64 * (j))
#define XB_TOP      3328
#define XB_TOPGEN   3392
#define XCD_BAR_WORDS 3456
#define XB_SPIN_CAP (1u << 18)

__device__ __forceinline__ unsigned xb_ld(unsigned* p)              { return __hip_atomic_load(p, __ATOMIC_RELAXED, __HIP_MEMORY_SCOPE_AGENT); }
__device__ __forceinline__ unsigned xb_add(unsigned* p, unsigned v) { return __hip_atomic_fetch_add(p, v, __ATOMIC_RELAXED, __HIP_MEMORY_SCOPE_AGENT); }
__device__ __forceinline__ unsigned xb_xcc_id() { return (unsigned)__builtin_amdgcn_s_getreg((3 << 11) | 20) & 0xFu; }
#define XB_SPIN(cond, bar) do { unsigned _sp = 0; while (cond) { __builtin_amdgcn_s_sleep(1); \
    if ((++_sp & 255u) == 0u) { if (xb_ld(&(bar)[XB_TMO])) break; if (_sp > XB_SPIN_CAP) { atomicAdd(&(bar)[XB_TMO], 1u); break; } } } } while (0)

struct XcdBarrier {
    unsigned* bar; unsigned x; unsigned wv;
    volatile LAS unsigned* st;
};

__device__ __forceinline__ XcdBarrier xcd_barrier_post(unsigned* bar, volatile LAS unsigned* st, unsigned wv) {
    XcdBarrier b; b.bar = bar; b.x = xb_xcc_id(); b.st = st; b.wv = wv;
    if (wv == 0u && lane_id() == 0) (void)xb_add(&bar[XB_XCNT(b.x)], 1u);
    return b;
}
__device__ __forceinline__ void xcd_barrier_complete(unsigned* bar, unsigned x, unsigned& nloc, unsigned& nx) {
    const unsigned G = gridDim.x * gridDim.y * gridDim.z;
    unsigned sum, cnt, mine, sp = 0u;
    for (;;) {
        sum = 0u; cnt = 0u; mine = 0u;
#pragma unroll
        for (unsigned j = 0; j < 16; ++j) { const unsigned c = xb_ld(&bar[XB_XCNT(j)]); sum += c; cnt += (c > 0u) ? 1u : 0u; mine = (j == x) ? c : mine; }
        if (sum == G) break;
        __builtin_amdgcn_s_sleep(1);
        if ((++sp & 255u) == 0u) { if (xb_ld(&bar[XB_TMO])) break; if (sp > XB_SPIN_CAP) { atomicAdd(&bar[XB_TMO], 1u); break; } }
    }
    nloc = mine > 0u ? mine : 1u; nx = cnt > 0u ? cnt : 1u;
}

__device__ __forceinline__ void xcd_barrier(const XcdBarrier& b) {
    ASMV("s_waitcnt vmcnt(0)" ::: "memory");
    __syncthreads();
    if (b.wv == 0u && lane_id() == 0) {
        unsigned* bar = b.bar; unsigned bx_ = b.x;
#ifndef EMU
        { unsigned long long p_ = (unsigned long long)bar; asm volatile("" : "+s"(p_), "+s"(bx_)); bar = (unsigned*)p_; }
#endif
        __builtin_amdgcn_s_waitcnt(0);
        unsigned nloc = b.st[0], nx = b.st[1];
        if (nloc == 0u) { xcd_barrier_complete(bar, bx_, nloc, nx); b.st[0] = nloc; b.st[1] = nx; }
        const unsigned old = xb_add(&bar[XB_XSUB(bx_)], 1u);
        const unsigned gen = old / nloc;
        if (old + 1u == (gen + 1u) * nloc) {
            __builtin_amdgcn_fence(__ATOMIC_RELEASE, "agent");
            ASMV("s_waitcnt vmcnt(0)" ::: "memory");
            const unsigned og = xb_add(&bar[XB_TOP], 1u);
            const unsigned tg = og / nx;
            if (og + 1u == (tg + 1u) * nx) xb_add(&bar[XB_TOPGEN], 1u);
            else XB_SPIN(xb_ld(&bar[XB_TOPGEN]) == tg, bar);
            __builtin_amdgcn_fence(__ATOMIC_ACQUIRE, "agent");
            xb_add(&bar[XB_XGEN(bx_)], 1u);
            ASMV("s_waitcnt vmcnt(0)" ::: "memory");
        } else {
            XB_SPIN(xb_ld(&bar[XB_XGEN(bx_)]) == gen, bar);
            __builtin_amdgcn_fence(__ATOMIC_ACQUIRE, "agent");
            ASMV("s_waitcnt vmcnt(0)" ::: "memory");
        }
    }
    __syncthreads();
}
constexpr int NWAVES = 8, NTHREADS = 512;
constexpr int RING_OFF = 0, RING_BYTES = 147456;
constexpr int LDSCTL_OFF = RING_BYTES, MISC_OFF = LDSCTL_OFF + 320;
constexpr int LDS_BYTES = 149504;
static_assert(MISC_OFF + 128 <= LDS_BYTES, "LDS map");
struct Frame {
    LAS unsigned char* lds;
    volatile LAS unsigned* MISC;
    gu32* ctl;
    int tid, lane, wave, vcu, G;
    const float* const* in;
    float* out;
    unsigned char* ws;
};
#ifdef EMU
#define AS_GLOBAL(T, p) ((T*)(p))
#else
#define AS_GLOBAL(T, p) ((T*)(GAS T*)(p))
#endif
template <class T> __device__ __forceinline__ T* wsp(const Frame& F, size_t off) { return AS_GLOBAL(T, F.ws + off); }
__device__ __forceinline__ const float* inp(const Frame& F, int i) { return AS_GLOBAL(const float, F.in[i]); }
__device__ __forceinline__ float* outp(const Frame& F) { return AS_GLOBAL(float, F.out); }

__device__ __forceinline__ int up_orig_col(int np) { return (np >> 8) * 128 + (np & 127) + ((np >> 7) & 1) * D_FF; }
__device__ __forceinline__ void st_bf16x8(bf16* p, const f32x4& a, const f32x4& b, float s) {
    v4u w; w.x = cvt_pk_bf16(a[0] * s, a[1] * s); w.y = cvt_pk_bf16(a[2] * s, a[3] * s); w.z = cvt_pk_bf16(b[0] * s, b[1] * s); w.w = cvt_pk_bf16(b[2] * s, b[3] * s);
    *(GAS v4u*)p = w;
}
#define EPI_BIG_LOOP \
    __device__ __forceinline__ void operator()(const f32x4 (&acc)[2][2][4][2], const pg8::Unit& u, int wr, int wc, int fr, int fq) const { \
    _Pragma("unroll") for (int ai = 0; ai < 2; ++ai) _Pragma("unroll") for (int m = 0; m < 4; ++m) { const int row = u.pm * 256 + ai * 128 + wr * 64 + m * 16 + fr; if (row < MT) { \
    _Pragma("unroll") for (int bj = 0; bj < 2; ++bj) put(row, u.pn * 256 + bj * 128 + wc * 32 + 8 * fq, u.pn, 0, acc[ai][bj][m][0], acc[ai][bj][m][1]); } } }

struct EpiNsaIn {
    static constexpr bool PERM = true, AFTER_DRAIN = false;
    unsigned char* ws; float* out;
    __device__ __forceinline__ void put(int row, int col, int pn, int ks, const f32x4& v0, const f32x4& v1) const {
            bf16* const Q = AS_GLOBAL(bf16, ws + WS_Q); bf16* const KVB = AS_GLOBAL(bf16, ws + WS_KVB); bf16* const WINB = AS_GLOBAL(bf16, ws + WS_WINB); float* const GATES = AS_GLOBAL(float, ws + WS_GATES);
            if (pn < 4) { st_bf16x8(Q + (size_t)row * 1024 + col, v0, v1, QSCALE); }
            else if (pn < 8) { const int c = col - 1024; st_bf16x8(KVB + (size_t)row * 1024 + c, v0, v1, 1.f);
                float* o = AS_GLOBAL(float, out) + O_KV + (size_t)row * 1024 + c; *(GAS f32x4*)o = v0; *(GAS f32x4*)(o + 4) = v1; }
            else if (pn < 10) { const int c = col - 2048; st_bf16x8(WINB + (size_t)row * 512 + c, v0, v1, 1.f);
                float* o = nullptr;
                if (row < MPR) { const int b = row / SEQ, t = row % SEQ; if (t >= SEQ - WKEEP) o = AS_GLOBAL(float, out) + O_WINP + ((size_t)b * WKEEP + (t - (SEQ - WKEEP))) * 512 + c; }
                else { const int r = row - MPR, b = r / DEC_SEQ, t = r % DEC_SEQ; o = AS_GLOBAL(float, out) + O_WINS + ((size_t)b * WB_LEN + (WB_LEN - DEC_SEQ + t)) * 512 + c; }
                if (o) { *(GAS f32x4*)o = v0; *(GAS f32x4*)(o + 4) = v1; } }
            else { const int c = col - 2560; if (c < 48) { float* o = GATES + (size_t)row * 48 + c; *(GAS f32x4*)o = v0; *(GAS f32x4*)(o + 4) = v1; } }
            }
    EPI_BIG_LOOP
};
struct EpiF32 {
    static constexpr bool PERM = true, AFTER_DRAIN = false;
    unsigned char* ws;
    __device__ __forceinline__ void put(int row, int col, int pn, int ks, const f32x4& v0, const f32x4& v1) const {
            float* const Y = AS_GLOBAL(float, ws + WS_Y); float* const YS = AS_GLOBAL(float, ws + WS_YS); constexpr int ldc = D;
            float* o = row < MPR ? Y + (size_t)row * ldc + col : YS + ((size_t)ks * MSA + (row - MPR)) * ldc + col; *(GAS f32x4*)o = v0; *(GAS f32x4*)(o + 4) = v1;
            }
    EPI_BIG_LOOP
};
constexpr int UPX_OFF = 131072;
constexpr int UPT_OFF = UPX_OFF + 4 * 2 * 256 * 4;
static_assert(UPT_OFF + 4 * 256 * 4 <= RING_BYTES && pg8::STAGE_BYTES <= UPX_OFF, "exchange region");
template <int N> __device__ __forceinline__ f32x4 ror4(const f32x4& v) {
    f32x4 r;
#pragma unroll
    for (int e = 0; e < 4; ++e) { const float x = v[e]; r[e] = __builtin_bit_cast(float, __builtin_amdgcn_update_dpp(0, __builtin_bit_cast(int, x), 0x120 + N, 0xf, 0xf, false)); }
    return r; }
__device__ __forceinline__ f32x4 shfl4(const f32x4& v, int src) { f32x4 r; r[0] = __shfl(v[0], src); r[1] = __shfl(v[1], src); r[2] = __shfl(v[2], src); r[3] = __shfl(v[3], src); return r; }
struct EpiUpConv {
    static constexpr bool PERM = true, AFTER_DRAIN = false;
    unsigned char* ws; float* out; const float* const* in; int layer; LAS float* exch;
    __device__ __forceinline__ void st4(bf16* p, const f32x4& v) const { v2u w; w.x = cvt_pk_bf16(v[0], v[1]); w.y = cvt_pk_bf16(v[2], v[3]); *(GAS v2u*)p = w; }
    __device__ __forceinline__ void put(int row, int col, int pn, int ks, const f32x4& v0, const f32x4& v1) const {
        bf16* const U = AS_GLOBAL(bf16, ws + WS_U); const int oc = up_orig_col(col), r = row - MPR, b = r / DEC_SEQ, t = r % DEC_SEQ;
        st4(U + (size_t)row * FF2 + oc, v0); st4(U + (size_t)row * FF2 + oc + 4, v1);
        if (t >= DEC_SEQ - 2) { float* o = AS_GLOBAL(float, out) + O_CVS + (((size_t)layer * DEC_BATCH + b) * 2 + (t - (DEC_SEQ - 2))) * FF2 + oc; *(GAS f32x4*)o = v0; *(GAS f32x4*)(o + 4) = v1; }
    }
    __device__ __forceinline__ void operator()(const f32x4 (&acc)[2][2][4][2], const pg8::Unit& u, int wr, int wc, int fr, int fq) const {
        const int lane = fq * 16 + fr, gcol0 = 128 * u.pn + 32 * wc + 8 * fq;
        bf16* const ACT = AS_GLOBAL(bf16, ws + WS_ACT); bf16* const U = AS_GLOBAL(bf16, ws + WS_U); bf16* const UB = AS_GLOBAL(bf16, ws + WS_UB);
        if (u.pm >= MPR / 256) {
#pragma unroll
            for (int ai = 0; ai < 2; ++ai)
#pragma unroll
                for (int m = 0; m < 4; ++m) { const int row = u.pm * 256 + ai * 128 + wr * 64 + m * 16 + fr; if (row < MT) { const int r = row - MPR, b = r / DEC_SEQ, t = r % DEC_SEQ;
#pragma unroll
                    for (int bj = 0; bj < 2; ++bj)
#pragma unroll
                        for (int n = 0; n < 2; ++n) { const int col = bj * D_FF + gcol0 + 4 * n; st4(U + (size_t)row * FF2 + col, acc[ai][bj][m][n]);
                            if (t >= DEC_SEQ - 2) *(GAS f32x4*)(AS_GLOBAL(float, out) + O_CVS + (((size_t)layer * DEC_BATCH + b) * 2 + (t - (DEC_SEQ - 2))) * FF2 + col) = acc[ai][bj][m][n]; } } }
            return;
        }
        LAS float* taps = exch + 4 * 2 * 256;
        { const int tid = (wr * 4 + wc) * 64 + lane, ci = tid & 255, hf = tid >> 8, oc = (ci >> 7) * D_FF + 128 * u.pn + (ci & 127);
          const float* cw = AS_GLOBAL(const float, in[20]) + (size_t)layer * 3 * FF2; const float* cb = AS_GLOBAL(const float, in[21]) + (size_t)layer * FF2;
          taps[(2 * hf) * 256 + ci] = hf ? cw[2 * FF2 + oc] : cw[oc]; taps[(2 * hf + 1) * 256 + ci] = hf ? cb[oc] : cw[FF2 + oc]; }
        if (fr >= 14) {
#pragma unroll
            for (int ai = 0; ai < 2; ++ai)
#pragma unroll
                for (int bj = 0; bj < 2; ++bj)
#pragma unroll
                    for (int n = 0; n < 2; ++n) *(LAS f32x4*)(exch + ((ai * 2 + wr) * 2 + (fr - 14)) * 256 + 128 * bj + 32 * wc + 8 * fq + 4 * n) = acc[ai][bj][3][n]; }
        LDS_WAIT(); __builtin_amdgcn_s_barrier(); ASMV("" ::: "memory");
        const int s1 = (lane & 48) | ((lane - 1) & 15), s2 = (lane & 48) | ((lane - 2) & 15);
        constexpr int TPS = SEQ / 256;
        const bool seq_last = (u.pm % TPS) == TPS - 1; const int bseq = u.pm / TPS;
#pragma unroll
        for (int n = 0; n < 2; ++n) {
            f32x4 w0[2], w1[2], w2[2], bb[2];
#pragma unroll
            for (int bj = 0; bj < 2; ++bj) { const LAS float* tp = taps + 128 * bj + 32 * wc + 8 * fq + 4 * n; w0[bj] = *(const LAS f32x4*)tp; w1[bj] = *(const LAS f32x4*)(tp + 256); w2[bj] = *(const LAS f32x4*)(tp + 512); bb[bj] = *(const LAS f32x4*)(tp + 768); }
#pragma unroll
            for (int ai = 0; ai < 2; ++ai) {
                const int gp = ai * 2 + wr - 1; f32x4 h62[2], h63[2];
#pragma unroll
                for (int bj = 0; bj < 2; ++bj) { const int gpc = gp < 0 ? 0 : gp; const LAS float* hp = exch + (gpc * 2) * 256 + 128 * bj + 32 * wc + 8 * fq + 4 * n; h62[bj] = *(const LAS f32x4*)hp; h63[bj] = *(const LAS f32x4*)(hp + 256); }
#pragma unroll
                for (int m = 0; m < 4; ++m) { f32x4 c[2];
#pragma unroll
                    for (int bj = 0; bj < 2; ++bj) { const f32x4 cur = acc[ai][bj][m][n];
                        f32x4 p1, p2; if (m == 0) { p1 = h63[bj]; p2 = fr == 14 ? h62[bj] : h63[bj]; } else { p1 = acc[ai][bj][m > 0 ? m - 1 : 0][n]; p2 = p1; }
                        const f32x4 x1 = shfl4(fr == 15 ? p1 : cur, s1), x2 = shfl4(fr >= 14 ? p2 : cur, s2);
                        c[bj] = bb[bj] + w0[bj] * x2 + w1[bj] * x1 + w2[bj] * cur; }
                    const int row = u.pm * 256 + ai * 128 + wr * 64 + m * 16 + fr;
                    if (!(gp < 0 && m == 0 && fr < 2)) { f32x4 a; a[0] = gelu_tanh(c[0][0]) * c[1][0]; a[1] = gelu_tanh(c[0][1]) * c[1][1]; a[2] = gelu_tanh(c[0][2]) * c[1][2]; a[3] = gelu_tanh(c[0][3]) * c[1][3];
                        st4(ACT + (size_t)row * D_FF + gcol0 + 4 * n, a); }
                }
            }
            __builtin_amdgcn_sched_barrier(0);
#pragma unroll
            for (int bj = 0; bj < 2; ++bj) { const int col = bj * D_FF + gcol0 + 4 * n;
                if (wr == 0 && fr < 2) st4(UB + ((size_t)u.pm * 4 + fr) * FF2 + col, acc[0][bj][0][n]);
                if (wr == 1 && fr >= 14) { st4(UB + ((size_t)u.pm * 4 + 2 + (fr - 14)) * FF2 + col, acc[1][bj][3][n]);
                    if (seq_last) *(GAS f32x4*)(AS_GLOBAL(float, out) + O_CVP + (((size_t)layer * BATCH + bseq) * 2 + (fr - 14)) * FF2 + col) = acc[1][bj][3][n]; } }
            __builtin_amdgcn_sched_barrier(0);
        }
    }
};
struct EpiMlIn {
    static constexpr bool PERM = true, AFTER_DRAIN = false;
    unsigned char* ws;
    __device__ __forceinline__ void put(int row, int col, int pn, int ks, const f32x4& v0, const f32x4& v1) const {
            bf16* const MQ = AS_GLOBAL(bf16, ws + WS_MQ); bf16* const MK = AS_GLOBAL(bf16, ws + WS_MK); bf16* const MV = AS_GLOBAL(bf16, ws + WS_MV); bf16* const MO = AS_GLOBAL(bf16, ws + WS_MO); float* const MG = AS_GLOBAL(float, ws + WS_MG);
            if (pn < 2) st_bf16x8(MQ + (size_t)row * 512 + col, v0, v1, 1.f);
            else if (pn < 4) st_bf16x8(MK + (size_t)row * 512 + (col - 512), v0, v1, 0.125f);
            else if (pn < 8) st_bf16x8(MV + (size_t)row * 1024 + (col - 1024), v0, v1, 1.f);
            else if (pn < 12) st_bf16x8(MO + (size_t)row * 1024 + (col - 2048), v0, v1, 1.f);
            else { const int c = col - 3072; if (c < 16) { float* o = MG + (size_t)row * 16 + c; *(GAS f32x4*)o = v0; *(GAS f32x4*)(o + 4) = v1; } }
            }
    EPI_BIG_LOOP
};

constexpr int CW_PAN = 16384;
struct EpiRmsRes {
    static constexpr bool PERM = true, AFTER_DRAIN = true;
    unsigned char* ws; float* out; const float* ga; const float* gb; gu32* ctl; int site;
    __device__ __forceinline__ bool stats(const f32x4 (&v)[2][2][4][2], const pg8::Unit& u, int wr, int wc, int fr, int fq, LAS unsigned char* lds, int wid, int lane, int e) const {
        LAS float* P = (LAS float*)lds; LAS float* S = (LAS float*)(lds + 4096); LAS unsigned* flag = (LAS unsigned*)(lds + 4096 + 1024);
        GAS float* slots = (GAS float*)AS_GLOBAL(float, ws + WS_XS) + (size_t)(site * 2 + e) * MPR * 4; gu32* cnt = ctl + CW_PAN + ((site * 2 + e) * 64 + u.pm) * 64;
#pragma unroll
        for (int ai = 0; ai < 2; ++ai)
#pragma unroll
            for (int m = 0; m < 4; ++m) { float q = 0.f;
#pragma unroll
                for (int bj = 0; bj < 2; ++bj)
#pragma unroll
                    for (int n = 0; n < 2; ++n) { const f32x4 x = v[ai][bj][m][n]; q += (x[0] * x[0] + x[1] * x[1]) + (x[2] * x[2] + x[3] * x[3]); }
                q += __shfl_xor(q, 16); q += __shfl_xor(q, 32);
                if (fq == 0) P[(ai * 128 + wr * 64 + m * 16 + fr) * 4 + wc] = q; }
        LDS_WAIT(); __builtin_amdgcn_s_barrier(); ASMV("" ::: "memory");
        const int row = wid * 32 + (lane & 31);
        if (lane < 32) { const float tot = (P[row * 4] + P[row * 4 + 1]) + (P[row * 4 + 2] + P[row * 4 + 3]);
            __hip_atomic_store((GAS unsigned*)(slots + ((size_t)u.pm * 256 + row) * 4 + u.pn), __builtin_bit_cast(unsigned, tot), __ATOMIC_RELAXED, __HIP_MEMORY_SCOPE_AGENT); }
        ASMV("s_waitcnt vmcnt(0)" ::: "memory");
        if (lane == 0) __hip_atomic_fetch_add(cnt, 1u, __ATOMIC_RELAXED, __HIP_MEMORY_SCOPE_AGENT);
        if (wid == 0) { bool dead = false; unsigned spins = 0;
            for (;;) { if ((unsigned)__builtin_amdgcn_readfirstlane((int)__hip_atomic_load(cnt, __ATOMIC_RELAXED, __HIP_MEMORY_SCOPE_AGENT)) >= 32u) break;
                if (++spins > (1u << 22)) { if (lane == 0) __hip_atomic_store(ctl + CW_TMO, 1u, __ATOMIC_RELAXED, __HIP_MEMORY_SCOPE_AGENT); dead = true; break; }
                __builtin_amdgcn_s_sleep(2); }
            __builtin_amdgcn_fence(__ATOMIC_ACQUIRE, "agent");
            if (lane == 0) flag[0] = dead ? 1u : 0u; }
        ASMV("s_waitcnt vmcnt(0) lgkmcnt(0)" ::: "memory"); LDS_WAIT(); __builtin_amdgcn_s_barrier(); ASMV("" ::: "memory");
        const bool bad = flag[0] != 0u;
        if (lane < 32) { const GAS unsigned* sp = (const GAS unsigned*)(slots + ((size_t)u.pm * 256 + row) * 4); float q = 0.f;
#pragma unroll
            for (int t = 0; t < 4; ++t) q += __builtin_bit_cast(float, __hip_atomic_load(sp + t, __ATOMIC_RELAXED, __HIP_MEMORY_SCOPE_AGENT));
            S[row] = 1.0f / sqrtf(q * (1.0f / D) + RMS_EPS); }
        LDS_WAIT(); __builtin_amdgcn_s_barrier(); ASMV("" ::: "memory");
        return bad;
    }
    __device__ __forceinline__ void fused(f32x4 (&acc)[2][2][4][2], const pg8::Unit& u, int wr, int wc, int fr, int fq, LAS unsigned char* lds, int wid, int lane) const {
        const LAS float* S = (const LAS float*)(lds + 4096); const int col0 = u.pn * 256 + wc * 32 + 8 * fq;
        GAS float* xres = (GAS float*)AS_GLOBAL(float, out) + O_Y; const float qnan = __builtin_nanf("");
        bool bad = stats(acc, u, wr, wc, fr, fq, lds, wid, lane, 0);
        f32x4 g[2][2];
#pragma unroll
        for (int bj = 0; bj < 2; ++bj)
#pragma unroll
            for (int n = 0; n < 2; ++n) g[bj][n] = *(const GAS f32x4*)(ga + col0 + bj * 128 + 4 * n);
#pragma unroll
        for (int ai = 0; ai < 2; ++ai)
#pragma unroll
            for (int m = 0; m < 4; ++m) { const int r = ai * 128 + wr * 64 + m * 16 + fr; const float rs = S[r]; GAS float* xp = xres + (size_t)(u.pm * 256 + r) * D + col0;
#pragma unroll
                for (int bj = 0; bj < 2; ++bj)
#pragma unroll
                    for (int n = 0; n < 2; ++n) { const f32x4 x = *(const GAS f32x4*)(xp + bj * 128 + 4 * n); f32x4 o = x + acc[ai][bj][m][n] * rs * g[bj][n];
                        if (bad) o = (f32x4){qnan, qnan, qnan, qnan}; acc[ai][bj][m][n] = o; if (!gb) *(GAS f32x4*)(xp + bj * 128 + 4 * n) = o; }
                ASMV("" : "+v"(acc[ai][0][m][0]), "+v"(acc[ai][0][m][1]), "+v"(acc[ai][1][m][0]), "+v"(acc[ai][1][m][1]));
                if (m & 1) ASMV("" ::: "memory"); }
        if (!gb) return;
        bad = stats(acc, u, wr, wc, fr, fq, lds, wid, lane, 1) || bad;
#pragma unroll
        for (int bj = 0; bj < 2; ++bj)
#pragma unroll
            for (int n = 0; n < 2; ++n) g[bj][n] = *(const GAS f32x4*)(gb + col0 + bj * 128 + 4 * n);
        GAS bf16* H = (GAS bf16*)AS_GLOBAL(bf16, ws + WS_H);
#pragma unroll
        for (int ai = 0; ai < 2; ++ai)
#pragma unroll
            for (int m = 0; m < 4; ++m) { const int r = ai * 128 + wr * 64 + m * 16 + fr; const float rs = bad ? qnan : S[r]; const size_t ro = (size_t)(u.pm * 256 + r) * D + col0;
#pragma unroll
                for (int bj = 0; bj < 2; ++bj) { const f32x4 a = acc[ai][bj][m][0], b = acc[ai][bj][m][1];
                    *(GAS f32x4*)(xres + ro + bj * 128) = a; *(GAS f32x4*)(xres + ro + bj * 128 + 4) = b;
                    const f32x4 ha = a * rs * g[bj][0], hb = b * rs * g[bj][1]; v4u w; w.x = cvt_pk_bf16(ha[0], ha[1]); w.y = cvt_pk_bf16(ha[2], ha[3]); w.z = cvt_pk_bf16(hb[0], hb[1]); w.w = cvt_pk_bf16(hb[2], hb[3]);
                    *(GAS v4u*)(H + ro + bj * 128) = w; }
                ASMV("" ::: "memory"); }
    }
    __device__ __forceinline__ void put(int row, int col, int pn, int ks, const f32x4& v0, const f32x4& v1) const {
        float* o = AS_GLOBAL(float, ws + WS_YS) + ((size_t)ks * MSA + (row - MPR)) * D + col; *(GAS f32x4*)o = v0; *(GAS f32x4*)(o + 4) = v1; }
};
template <class Epi> __device__ __forceinline__ void mini_gemm(const Frame& F, const bf16* A, const bf16* Bt, int row_lo, int nrows, int col_lo, int ncols, int K, int ksplit, const Epi& E) {
    const int lane = F.lane, fr = lane & 15, fq = lane >> 4, gw = F.vcu * NWAVES + F.wave, NGW = F.G * NWAVES;
    const int nct = ncols / 32, nrt = (nrows + 15) / 16, ntile = nrt * nct, klen = K / ksplit;
    for (int un = gw; un < ntile * ksplit; un += NGW) {
        const int ks = un / ntile, t = un % ntile, rt = t / nct, ct = t % nct, row = row_lo + rt * 16 + fr, colb = col_lo + ct * 32;
        const GAS bf16* ap = (const GAS bf16*)A + (size_t)(row < row_lo + nrows ? row : row_lo) * K + ks * klen + fq * 8;
        const GAS bf16* bp0 = (const GAS bf16*)Bt + (size_t)(colb + 8 * (fr >> 2) + (fr & 3)) * K + ks * klen + fq * 8; const GAS bf16* bp1 = bp0 + (size_t)4 * K;
        f32x4 acc0 = (f32x4){0.f, 0.f, 0.f, 0.f}, acc1 = acc0;
        for (int k0 = 0; k0 < klen; k0 += 256) {
            bf16x8 a[8], b0[8], b1[8];
#pragma unroll
            for (int i = 0; i < 8; ++i) { a[i] = *(const GAS bf16x8*)(ap + k0 + 32 * i); b0[i] = *(const GAS bf16x8*)(bp0 + k0 + 32 * i); b1[i] = *(const GAS bf16x8*)(bp1 + k0 + 32 * i); }
#pragma unroll
            for (int i = 0; i < 8; ++i) { acc0 = __builtin_amdgcn_mfma_f32_16x16x32_bf16(b0[i], a[i], acc0, 0, 0, 0); acc1 = __builtin_amdgcn_mfma_f32_16x16x32_bf16(b1[i], a[i], acc1, 0, 0, 0); }
        }
        if (row < row_lo + nrows) E.put(row, colb + 8 * fq, colb >> 8, ks, acc0, acc1);
    }
}
__device__ __forceinline__ void transpose_item(const float* W, int K, int N, int Npad, bf16* WT, LAS float* scr, int item, int lane, bool upmap = false) {
    const int nblk = Npad / 32, kb = item / nblk, nb = item % nblk, k0 = 64 * kb, n0 = 32 * nb;
    const int nn = (upmap ? up_orig_col(n0) : n0) + (lane & 31);
#pragma unroll
    for (int hb = 0; hb < 2; ++hb) { float tv[16];
#pragma unroll
        for (int i = 0; i < 16; ++i) { const int kk = 2 * (16 * hb + i) + (lane >> 5); tv[i] = nn < N ? ((const GAS float*)W)[(size_t)(k0 + kk) * N + nn] : 0.f; }
#pragma unroll
        for (int i = 0; i < 16; ++i) scr[(2 * (16 * hb + i) + (lane >> 5)) * 33 + (lane & 31)] = tv[i]; }
    LDS_WAIT(); ASMV("" ::: "memory");
    const int c = lane & 7;
#pragma unroll
    for (int j = 0; j < 4; ++j) { const int n = (lane >> 3) + 8 * j; const LAS float* s = scr + (8 * c) * 33 + n;
        v4u o; o.x = cvt_pk_bf16(s[0 * 33], s[1 * 33]); o.y = cvt_pk_bf16(s[2 * 33], s[3 * 33]); o.z = cvt_pk_bf16(s[4 * 33], s[5 * 33]); o.w = cvt_pk_bf16(s[6 * 33], s[7 * 33]);
        *(GAS v4u*)(WT + (size_t)(n0 + n) * K + k0 + 8 * c) = o; }
    LDS_WAIT(); ASMV("" ::: "memory");
}
__device__ __forceinline__ const float* x_in_row(const Frame& F, int m) { return m < MPR ? inp(F, 0) + (size_t)m * D : inp(F, 1) + (size_t)(m - MPR) * D; }
__device__ __forceinline__ void rms_rows2_to_bf16(const Frame& F, int m0, int m1, bool two, const float* g) {
    typedef const GAS f32x4* gcp; const int mm[2] = {m0, two ? m1 : m0}; f32x4 v[2][4];
#pragma unroll
    for (int q = 0; q < 2; ++q) { gcp xr = (gcp)x_in_row(F, mm[q]) + F.lane;
#pragma unroll
        for (int j = 0; j < 4; ++j) v[q][j] = xr[64 * j]; }
#pragma unroll
    for (int q = 0; q < 2; ++q) { if (q == 1 && !two) break; const int m = mm[q]; float s = 0.f;
#pragma unroll
        for (int j = 0; j < 4; ++j) s += (v[q][j].x * v[q][j].x + v[q][j].y * v[q][j].y) + (v[q][j].z * v[q][j].z + v[q][j].w * v[q][j].w);
        const float rstd = 1.f / sqrtf(wave_sum(s) * (1.f / D) + RMS_EPS);
        GAS v2u* o8 = (GAS v2u*)(wsp<bf16>(F, WS_H) + (size_t)m * D) + F.lane; GAS f32x4* xc = (GAS f32x4*)(outp(F) + O_Y + (size_t)m * D) + F.lane;
#pragma unroll
        for (int j = 0; j < 4; ++j) { const f32x4 gg = ((gcp)g + F.lane)[64 * j]; xc[64 * j] = v[q][j];
            v2u w; w.x = cvt_pk_bf16(v[q][j].x * rstd * gg.x, v[q][j].y * rstd * gg.y); w.y = cvt_pk_bf16(v[q][j].z * rstd * gg.z, v[q][j].w * rstd * gg.w); o8[64 * j] = w; } }
}
__device__ __forceinline__ void p0_prologue(Frame& F) {
    LAS float* scr = (LAS float*)(F.lds + RING_OFF + F.wave * 16384);
    const int gw = F.vcu * NWAVES + F.wave, NGW = F.G * NWAVES;
    constexpr int I_NI = (D / 64) * (NSA_IN_PAD / 32), I_DD = (D / 64) * (D / 32), I_MI = (D / 64) * (ML_IN_PAD / 32), I_UP = (D / 64) * (FF2 / 32), I_DN = (D_FF / 64) * (D / 32);
    constexpr int NITEMS = I_NI + 2 * I_DD + I_MI + 2 * I_UP + 2 * I_DN;
    for (int it = gw; it < NITEMS; it += NGW) {
        int r = it;
        if (r < I_NI) { transpose_item(inp(F, 10), D, NSA_IN, NSA_IN_PAD, wsp<bf16>(F, WS_WNSAIN), scr, r, F.lane); continue; } r -= I_NI;
        if (r < I_DD) { transpose_item(inp(F, 11), D, D, D, wsp<bf16>(F, WS_WNSAOUT), scr, r, F.lane); continue; } r -= I_DD;
        if (r < I_MI) { transpose_item(inp(F, 15), D, ML_IN, ML_IN_PAD, wsp<bf16>(F, WS_WMLIN), scr, r, F.lane); continue; } r -= I_MI;
        if (r < I_DD) { transpose_item(inp(F, 18), D, D, D, wsp<bf16>(F, WS_WMLOUT), scr, r, F.lane); continue; } r -= I_DD;
        if (r < 2 * I_UP) { const int l = r / I_UP; transpose_item(inp(F, 19) + (size_t)l * D * FF2, D, FF2, FF2, wsp<bf16>(F, WS_WUP) + (size_t)l * FF2 * D, scr, r % I_UP, F.lane, true); continue; } r -= 2 * I_UP;
        { const int l = r / I_DN; transpose_item(inp(F, 22) + (size_t)l * D_FF * D, D_FF, D, D, wsp<bf16>(F, WS_WDOWN) + (size_t)l * D * D_FF, scr, r % I_DN, F.lane); }
    }
    for (int m = gw; m < MT; m += 2 * NGW) rms_rows2_to_bf16(F, m, m + NGW, m + NGW < MT, inp(F, 9));
    { const size_t per_b = (size_t)(WB_LEN - DEC_SEQ) * 512 / 4, total = per_b * DEC_BATCH;
      for (size_t i = (size_t)blockIdx.x * NTHREADS + F.tid; i < total; i += (size_t)F.G * NTHREADS) { const size_t b = i / per_b, r = i % per_b;
          ((f32x4*)(outp(F) + O_WINS + b * WB_LEN * 512))[r] = ((const f32x4*)(inp(F, 3) + b * WB_LEN * 512 + DEC_SEQ * 512))[r]; } }
}
constexpr int NSN = (MSA + NWAVES - 1) / NWAVES, CW_SN = 60000;
__device__ __forceinline__ void norm_phase(Frame& F, int row_lo, const float* Y, const float* YS, int ksplit, const float* ga, const float* gb, bf16* H, gu32* gate = nullptr, int wg_base = 0) {
    const int vrel = (int)blockIdx.x - wg_base;
    if (gate && (vrel < 0 || vrel >= NSN)) return;
    const int gw = row_lo + (gate ? vrel : F.vcu) * NWAVES + F.wave, NGW = (gate ? NSN : F.G) * NWAVES;
    typedef const GAS f32x4* gcp; typedef GAS f32x4* gp4;
    f32x4 gA[4], gB[4];
#pragma unroll
    for (int j = 0; j < 4; ++j) { gA[j] = ((gcp)ga + F.lane)[64 * j]; gB[j] = gb ? ((gcp)gb + F.lane)[64 * j] : (f32x4){0.f, 0.f, 0.f, 0.f}; }
    for (int m0 = gw; m0 < MT; m0 += 2 * NGW) {
        const int m1 = m0 + NGW; const bool two = m1 < MT; const int mm[2] = {m0, two ? m1 : m0};
        f32x4 y[2][4], x[2][4];
#pragma unroll
        for (int q = 0; q < 2; ++q) { const int m = mm[q]; gcp yr = (gcp)(Y + (size_t)m * D) + F.lane; gcp xr = (gcp)(outp(F) + O_Y + (size_t)m * D) + F.lane;
#pragma unroll
            for (int j = 0; j < 4; ++j) { y[q][j] = yr[64 * j]; x[q][j] = xr[64 * j]; } }
#pragma unroll
        for (int q = 0; q < 2; ++q) { const int m = mm[q];
            if (m >= MPR) {
#pragma unroll
                for (int j = 0; j < 4; ++j) { y[q][j] = (f32x4){0.f, 0.f, 0.f, 0.f}; for (int k = 0; k < ksplit; ++k) y[q][j] = y[q][j] + ((gcp)(YS + ((size_t)k * MSA + (m - MPR)) * D) + F.lane)[64 * j]; } } }
#pragma unroll
        for (int q = 0; q < 2; ++q) { const int m = mm[q]; if (q == 1 && !two) break;
            float s = 0.f;
#pragma unroll
            for (int j = 0; j < 4; ++j) s += (y[q][j].x * y[q][j].x + y[q][j].y * y[q][j].y) + (y[q][j].z * y[q][j].z + y[q][j].w * y[q][j].w);
            const float r1 = 1.f / sqrtf(wave_sum(s) * (1.f / D) + RMS_EPS); float s2 = 0.f; gp4 xw = (gp4)(outp(F) + O_Y + (size_t)m * D) + F.lane;
#pragma unroll
            for (int j = 0; j < 4; ++j) { x[q][j] = x[q][j] + y[q][j] * r1 * gA[j]; xw[64 * j] = x[q][j];
                s2 += (x[q][j].x * x[q][j].x + x[q][j].y * x[q][j].y) + (x[q][j].z * x[q][j].z + x[q][j].w * x[q][j].w); }
            if (gb) { const float r2 = 1.f / sqrtf(wave_sum(s2) * (1.f / D) + RMS_EPS); GAS v2u* o8 = (GAS v2u*)(H + (size_t)m * D) + F.lane;
#pragma unroll
                for (int j = 0; j < 4; ++j) { v2u w; w.x = cvt_pk_bf16(x[q][j].x * r2 * gB[j].x, x[q][j].y * r2 * gB[j].y); w.y = cvt_pk_bf16(x[q][j].z * r2 * gB[j].z, x[q][j].w * r2 * gB[j].w);
                    if (gate) __hip_atomic_store((GAS unsigned long long*)(o8 + 64 * j), ((unsigned long long)w.y << 32) | w.x, __ATOMIC_RELAXED, __HIP_MEMORY_SCOPE_AGENT); else o8[64 * j] = w; } }
        }
        if (gate) { ASMV("s_waitcnt vmcnt(0)" ::: "memory"); if (F.lane == 0) __hip_atomic_fetch_add(gate, two ? 2u : 1u, __ATOMIC_RELAXED, __HIP_MEMORY_SCOPE_AGENT); }
    }
}
struct GatedOrder : pg8::StaticOrder {
    gu32* gate; gu32* tmo;
    __device__ __forceinline__ void a_ready(const pg8::Unit& u) const {
        if (u.pm == MPR / 256) { unsigned spins = 0;
            while (__hip_atomic_load(gate, __ATOMIC_RELAXED, __HIP_MEMORY_SCOPE_AGENT) < (unsigned)MSA) { __builtin_amdgcn_s_sleep(2); if (++spins > (1u << 22)) { __hip_atomic_store(tmo, 1u, __ATOMIC_RELAXED, __HIP_MEMORY_SCOPE_AGENT); break; } }
            __builtin_amdgcn_fence(__ATOMIC_ACQUIRE, "agent"); } }
};
__device__ __forceinline__ void conv_fix_phase(Frame& F, int layer) {
    constexpr int NCB = D_FF / 512, NPT = MPR / 256, TPS = SEQ / 256, UNITS_P = NPT * NCB, UNITS_S = DEC_BATCH * NCB;
    const bf16* U = wsp<bf16>(F, WS_U); const bf16* UB = wsp<bf16>(F, WS_UB); bf16* ACT = wsp<bf16>(F, WS_ACT);
    const float* cw = inp(F, 20) + (size_t)layer * 3 * FF2; const float* cb = inp(F, 21) + (size_t)layer * FF2; const float* sbuf = inp(F, 7) + (size_t)layer * DEC_BATCH * 2 * FF2;
    const int gw = F.vcu * NWAVES + F.wave, NGW = F.G * NWAVES;
    for (int un = gw; un < UNITS_P + UNITS_S; un += NGW) {
        const bool samp = un >= UNITS_P; const int q = samp ? un - UNITS_P : un, cbk = q % NCB, id = q / NCB, j0 = cbk * 512 + F.lane * 8;
        const int nrows = samp ? DEC_SEQ : 2, row0 = samp ? MPR + id * DEC_SEQ : id * 256;
        float w[3][2][8], bb[2][8], p2[2][8], p1[2][8];
#pragma unroll
        for (int h = 0; h < 2; ++h) { const int c0 = j0 + h * D_FF;
#pragma unroll
            for (int e = 0; e < 8; ++e) { bb[h][e] = cb[c0 + e]; w[0][h][e] = cw[c0 + e]; w[1][h][e] = cw[FF2 + c0 + e]; w[2][h][e] = cw[2 * FF2 + c0 + e]; p2[h][e] = 0.f; p1[h][e] = 0.f; }
            if (samp) {
#pragma unroll
                for (int e = 0; e < 8; ++e) { p2[h][e] = sbuf[((size_t)id * 2 + 0) * FF2 + c0 + e]; p1[h][e] = sbuf[((size_t)id * 2 + 1) * FF2 + c0 + e]; } }
            else if (id % TPS != 0) { const v4u a = *(const GAS v4u*)(UB + ((size_t)(id - 1) * 4 + 2) * FF2 + c0), b = *(const GAS v4u*)(UB + ((size_t)(id - 1) * 4 + 3) * FF2 + c0);
#pragma unroll
                for (int e = 0; e < 4; ++e) { p2[h][2 * e] = bflo(a[e]); p2[h][2 * e + 1] = bfhi(a[e]); p1[h][2 * e] = bflo(b[e]); p1[h][2 * e + 1] = bfhi(b[e]); } }
        }
        v4u ur[DEC_SEQ][2];
#pragma unroll
        for (int r = 0; r < DEC_SEQ; ++r) { const int rr = r < nrows ? r : 0;
#pragma unroll
            for (int h = 0; h < 2; ++h) ur[r][h] = samp ? *(const GAS v4u*)(U + (size_t)(row0 + rr) * FF2 + j0 + h * D_FF) : *(const GAS v4u*)(UB + ((size_t)id * 4 + rr) * FF2 + j0 + h * D_FF); }
#pragma unroll
        for (int r = 0; r < DEC_SEQ; ++r) { if (r >= nrows) break;
            float cv[2][8];
#pragma unroll
            for (int h = 0; h < 2; ++h) { const v4u a = ur[r][h];
#pragma unroll
                for (int e = 0; e < 4; ++e) { const float u0 = bflo(a[e]), u1 = bfhi(a[e]);
                    cv[h][2 * e] = bb[h][2 * e] + w[0][h][2 * e] * p2[h][2 * e] + w[1][h][2 * e] * p1[h][2 * e] + w[2][h][2 * e] * u0;
                    cv[h][2 * e + 1] = bb[h][2 * e + 1] + w[0][h][2 * e + 1] * p2[h][2 * e + 1] + w[1][h][2 * e + 1] * p1[h][2 * e + 1] + w[2][h][2 * e + 1] * u1;
                    p2[h][2 * e] = p1[h][2 * e]; p2[h][2 * e + 1] = p1[h][2 * e + 1]; p1[h][2 * e] = u0; p1[h][2 * e + 1] = u1; } }
            v4u o;
#pragma unroll
            for (int e = 0; e < 4; ++e) o[e] = cvt_pk_bf16(gelu_tanh(cv[0][2 * e]) * cv[1][2 * e], gelu_tanh(cv[0][2 * e + 1]) * cv[1][2 * e + 1]);
            *(GAS v4u*)(ACT + (size_t)(row0 + r) * D_FF + j0) = o;
        }
    }
}
constexpr int NCPAD_P = (NC_P + 63) / 64 * 64, NCPAD_S = (NC_S + 63) / 64 * 64;
constexpr size_t KC_P_OFF = 0, VC_P_OFF = KC_P_OFF + (size_t)BATCH * 4 * NCPAD_P * 64 * 2, KC_S_OFF = VC_P_OFF + (size_t)BATCH * 4 * NCPAD_P * 64 * 2,
    VC_S_OFF = KC_S_OFF + (size_t)DEC_BATCH * 4 * NCPAD_S * 64 * 2, W1T_OFF = VC_S_OFF + (size_t)DEC_BATCH * 4 * NCPAD_S * 64 * 2,
    W2T_OFF = W1T_OFF + (size_t)2 * 64 * 2048 * 2,
    CB_OFF = W2T_OFF + (size_t)2 * 64 * 64 * 2, KC_END = CB_OFF + 2 * 64 * 4;
static_assert(KC_END <= ((size_t)64 << 20), "KC region");
__device__ __forceinline__ void compress_prologue(Frame& F) {
    LAS float* scr = (LAS float*)(F.lds + RING_OFF + F.wave * 16384);
    const int gw = F.vcu * NWAVES + F.wave, NGW = F.G * NWAVES;
    constexpr int I2 = (64 / 64) * (64 / 32);
    for (int it = gw; it < 2 * I2; it += NGW) { const int c = it / I2, r = it % I2;
        transpose_item(inp(F, 13) + (size_t)c * 64 * 64, 64, 64, 64, wsp<bf16>(F, WS_KC + W2T_OFF) + (size_t)c * 64 * 64, scr, r, F.lane); }
    for (int p = (int)blockIdx.x * NTHREADS + F.tid; p < 2 * 16 * 4 * 4 * 64; p += F.G * NTHREADS) {
        const int ln = p & 63, rh = (p >> 6) & 3, s4 = (p >> 8) & 3, l = (p >> 10) & 15, c = p >> 14; const int h = 32 * (rh & 1) + (ln & 31), d0 = 16 * s4 + 8 * (ln >> 5);
        const float* src = inp(F, 12) + (((size_t)c * 32 + 16 * (rh >> 1) + l) * 64 + d0) * 64 + h;
        v4u w; w.x = cvt_pk_bf16(src[0], src[64]); w.y = cvt_pk_bf16(src[128], src[192]); w.z = cvt_pk_bf16(src[256], src[320]); w.w = cvt_pk_bf16(src[384], src[448]);
        *(GAS v4u*)(wsp<bf16>(F, WS_KC + W1T_OFF) + (size_t)p * 8) = w; }
    const int cb = F.G - 1 - (int)blockIdx.x;
    if (cb >= 0 && cb < 2) { __syncthreads();
        const int c = cb, h4 = F.tid & 15, seg = F.tid >> 4; const float* w1 = inp(F, 12) + (size_t)c * 2048 * 64; const float* pos = inp(F, 14);
        LAS float* red = (LAS float*)(F.lds + RING_OFF); LAS float* P = red + 2048;
        for (int i = F.tid; i < 2048; i += NTHREADS) P[i] = pos[((i >> 6) * 2 + c) * 64 + (i & 63)];
        __syncthreads();
        f32x4 s = (f32x4){0.f, 0.f, 0.f, 0.f};
        for (int kk = 0; kk < 64; kk += 16) { f32x4 w[16];
#pragma unroll
            for (int j = 0; j < 16; ++j) w[j] = *(const GAS f32x4*)(w1 + (size_t)(seg * 64 + kk + j) * 64 + 4 * h4);
#pragma unroll
            for (int j = 0; j < 16; ++j) { const float pv = P[seg * 64 + kk + j]; s[0] += pv * w[j][0]; s[1] += pv * w[j][1]; s[2] += pv * w[j][2]; s[3] += pv * w[j][3]; } }
        *(LAS f32x4*)(red + seg * 64 + 4 * h4) = s; __syncthreads();
        if (F.tid < 64) { float t = 0.f;
#pragma unroll
            for (int i = 0; i < 32; ++i) t += red[i * 64 + F.tid];
            wsp<float>(F, WS_KC + CB_OFF)[c * 64 + F.tid] = t; }
        __syncthreads(); }
}
__device__ __forceinline__ bf16x8 ld_bf8_f32(const float* p) { const f32x4 a = *(const GAS f32x4*)p, b = *(const GAS f32x4*)(p + 4);
    v4u w; w.x = cvt_pk_bf16(a[0], a[1]); w.y = cvt_pk_bf16(a[2], a[3]); w.z = cvt_pk_bf16(b[0], b[1]); w.w = cvt_pk_bf16(b[2], b[3]); return __builtin_bit_cast(bf16x8, w); }
constexpr int CW_CMPQ = 2048;
constexpr int CMP_RSTR = 144, CMP_WBUF = 32 * CMP_RSTR, CMP_WOFF = NWAVES * 2 * 32 * 144 + 64;
static_assert(CMP_WOFF % 16 == 0 && CMP_WOFF + 65536 <= RING_BYTES, "compress LDS map");
constexpr int CMP_RSTR_ = 144, CMP_WBUF_ = 32 * CMP_RSTR;
template <bool SAMP> __device__ __forceinline__ void compress_unit(Frame& F, int b, int tile, int g, int c) {
    const int lane = F.lane, l32 = lane & 31, hi = lane >> 5;
    const bf16* W1F = wsp<bf16>(F, WS_KC + W1T_OFF); const bf16* W2T = wsp<bf16>(F, WS_KC + W2T_OFF); const float* CB = wsp<float>(F, WS_KC + CB_OFF);
    LAS unsigned char* stg = F.lds + RING_OFF + F.wave * (2 * CMP_WBUF);
    constexpr int nch = SAMP ? NCH_S : NCH_P, nc = SAMP ? NC_S : NC_P, ncpad = SAMP ? NCPAD_S : NCPAD_P;
    constexpr int NLD = SAMP ? 8 : 4, LPS = SAMP ? 16 : 8;
    const int ch0 = 31 * tile;
    const char* src[NLD];
#pragma unroll
    for (int i = 0; i < NLD; ++i) { int chn = ch0 + i * (64 / LPS) + lane / LPS; if (chn > nch - 1) chn = nch - 1; const int tok = 16 * chn;
        if (SAMP) { const int page = ((const int*)inp(F, 8))[b * N_PAGES + tok / PAGE_SIZE]; src[i] = (const char*)(inp(F, 2) + ((size_t)page * PAGE_SIZE + tok % PAGE_SIZE) * 1024 + c * 256 + g * 64) + (lane % LPS) * 16; }
        else src[i] = (const char*)(wsp<bf16>(F, WS_KVB) + (size_t)(b * SEQ + tok) * 1024 + c * 256 + g * 64) + (lane % LPS) * 16; }
    constexpr int TOKB = SAMP ? 4096 : 2048;
    f32x16 acc[2][2];
#pragma unroll
    for (int r = 0; r < 2; ++r)
#pragma unroll
        for (int hb = 0; hb < 2; ++hb) acc[r][hb] = (f32x16){};
    v4u nx[NLD];
#pragma unroll
    for (int i = 0; i < NLD; ++i) nx[i] = *(const GAS v4u*)(src[i]);
    LAS unsigned char* WB = F.lds + RING_OFF + CMP_WOFF; const int tid = F.wave * 64 + lane;
    const GAS unsigned char* w1b = (const GAS unsigned char*)W1F;
    v4u wpre[4];
#pragma unroll
    for (int j = 0; j < 4; ++j) { const int o = j * 8192 + tid * 16; wpre[j] = *(const GAS v4u*)(w1b + (size_t)(((o >> 14) * 16 + 0) * 16) * 1024 + (o & 16383)); }
#pragma unroll
    for (int j = 0; j < 4; ++j) *(LAS v4u*)(WB + j * 8192 + tid * 16) = wpre[j];
    LDS_WAIT(); __syncthreads();
#pragma unroll 1
    for (int l = 0; l < 16; ++l) {
        LAS unsigned char* sb = stg + (l & 1) * CMP_WBUF;
#pragma unroll
        for (int i = 0; i < NLD; ++i) { const int row = i * (64 / LPS) + lane / LPS;
            if (SAMP) { const f32x4 f = __builtin_bit_cast(f32x4, nx[i]); v2u w; w.x = cvt_pk_bf16(f[0], f[1]); w.y = cvt_pk_bf16(f[2], f[3]); *(LAS v2u*)(sb + row * CMP_RSTR + (lane % LPS) * 8) = w; }
            else *(LAS v4u*)(sb + row * CMP_RSTR + (lane % LPS) * 16) = nx[i]; }
        const int ln = l < 15 ? l + 1 : 15;
#pragma unroll
        for (int j = 0; j < 4; ++j) { const int o = j * 8192 + tid * 16; wpre[j] = *(const GAS v4u*)(w1b + (size_t)(((o >> 14) * 16 + ln) * 16) * 1024 + (o & 16383)); }
        ASMV("" ::: "memory");
#pragma unroll
        for (int i = 0; i < NLD; ++i) nx[i] = *(const GAS v4u*)(src[i] + (size_t)ln * TOKB);
        LDS_WAIT();
        const LAS unsigned char* wb = WB + (l & 1) * 32768 + c * 16384 + lane * 16;
#pragma unroll
        for (int s4 = 0; s4 < 4; ++s4) { const bf16x8 kv = *(const LAS bf16x8*)(sb + l32 * CMP_RSTR + s4 * 32 + hi * 16);
            bf16x8 wf4[4];
#pragma unroll
            for (int rh = 0; rh < 4; ++rh) wf4[rh] = *(const LAS bf16x8*)(wb + (s4 * 4 + rh) * 1024);
#pragma unroll
            for (int rh = 0; rh < 4; ++rh)
                acc[rh >> 1][rh & 1] = __builtin_amdgcn_mfma_f32_32x32x16_bf16(wf4[rh], kv, acc[rh >> 1][rh & 1], 0, 0, 0); }
#pragma unroll
        for (int j = 0; j < 4; ++j) *(LAS v4u*)(WB + ((l + 1) & 1) * 32768 + j * 8192 + tid * 16) = wpre[j];
        LDS_WAIT(); __syncthreads();
    }
    f32x16 o[2]; o[0] = (f32x16){}; o[1] = (f32x16){};
#pragma unroll
    for (int hb = 0; hb < 2; ++hb) {
        float gv[16];
#pragma unroll
        for (int r = 0; r < 16; ++r) { const int h = 32 * hb + (r & 3) + 8 * (r >> 2) + 4 * hi; gv[r] = gelu_tanh(acc[0][hb][r] + __shfl(acc[1][hb][r], (lane + 1) & 63) + CB[c * 64 + h]); }
#pragma unroll
        for (int s = 0; s < 2; ++s) {
            v4u pw; pw.x = cvt_pk_bf16(gv[8 * s + 0], gv[8 * s + 1]); pw.y = cvt_pk_bf16(gv[8 * s + 2], gv[8 * s + 3]); pw.z = cvt_pk_bf16(gv[8 * s + 4], gv[8 * s + 5]); pw.w = cvt_pk_bf16(gv[8 * s + 6], gv[8 * s + 7]);
            const bf16x8 gf = __builtin_bit_cast(bf16x8, pw);
#pragma unroll
            for (int db = 0; db < 2; ++db) {
                const bf16* wp = W2T + (size_t)c * 64 * 64 + (size_t)(32 * db + l32) * 64 + 32 * hb + 16 * s + 4 * hi;
                const v2u a0 = *(const GAS v2u*)wp, a1 = *(const GAS v2u*)(wp + 8); v4u aw; aw.x = a0.x; aw.y = a0.y; aw.z = a1.x; aw.w = a1.y;
                o[db] = __builtin_amdgcn_mfma_f32_32x32x16_bf16(__builtin_bit_cast(bf16x8, aw), gf, o[db], 0, 0, 0);
            }
        }
    }
    const int j = ch0 + l32;
    if (l32 < 31 && j < ncpad) {
        bf16* dst = wsp<bf16>(F, WS_KC + (SAMP ? (c ? VC_S_OFF : KC_S_OFF) : (c ? VC_P_OFF : KC_P_OFF))) + ((size_t)(b * 4 + g) * ncpad + j) * 64;
        const bool live = j < nc;
#pragma unroll
        for (int db = 0; db < 2; ++db)
#pragma unroll
            for (int r4 = 0; r4 < 4; ++r4) { v2u w; w.x = live ? cvt_pk_bf16(o[db][4 * r4], o[db][4 * r4 + 1]) : 0u; w.y = live ? cvt_pk_bf16(o[db][4 * r4 + 2], o[db][4 * r4 + 3]) : 0u;
                __hip_atomic_store((GAS unsigned long long*)(dst + 32 * db + 8 * r4 + 4 * hi), ((unsigned long long)w.y << 32) | w.x, __ATOMIC_RELAXED, __HIP_MEMORY_SCOPE_AGENT); }
    }
}
constexpr int CW_CMPC = 8192;
constexpr int CMP_NT_P = (NCPAD_P + 30) / 31, CMP_NT_S = (NCPAD_S + 30) / 31;
__device__ __forceinline__ void compress_phase(Frame& F, int rep = 0) {
    constexpr int UN_S = DEC_BATCH * CMP_NT_S, UN_P = BATCH * CMP_NT_P;
    LAS unsigned* qslot = (LAS unsigned*)(F.lds + RING_OFF + NWAVES * 2 * CMP_WBUF);
    const int g = F.wave & 3, c = F.wave >> 2;
    for (;;) {
        __syncthreads();
        if (F.tid == 0) *qslot = __hip_atomic_fetch_add(F.ctl + CW_CMPQ + 64 * rep, 1u, __ATOMIC_RELAXED, __HIP_MEMORY_SCOPE_AGENT);
        __syncthreads();
        const int un = (int)*qslot;
        if (un >= UN_S + UN_P) break;
        int cw;
        if (un < UN_P) { compress_unit<false>(F, un / CMP_NT_P, un % CMP_NT_P, g, c); cw = CW_CMPC + 64 * (un / CMP_NT_P); }
        else { const int v = un - UN_P; compress_unit<true>(F, v / CMP_NT_S, v % CMP_NT_S, g, c); cw = CW_CMPC + 64 * (BATCH + v / CMP_NT_S); }
        ASMV("s_waitcnt vmcnt(0)" ::: "memory");
        __syncthreads();
        if (F.tid == 0) __hip_atomic_fetch_add(F.ctl + cw, 1u, __ATOMIC_RELAXED, __HIP_MEMORY_SCOPE_AGENT);
    }
}
#ifndef AT_PROBE
#define AT_PROBE 0
#endif
typedef short v4i16 __attribute__((ext_vector_type(4)));
constexpr int AT_KSTR = 144, AT_TILE = 64 * AT_KSTR;
constexpr int AT_VSTR = 192, AT_VTILE = 64 * AT_VSTR;
constexpr int AT_K = 0, AT_V = 2 * AT_TILE, AT_IMP = 2 * AT_TILE + 2 * AT_VTILE, IMPW_P = 65, IMPW_S = 132, AT_IMP_BYTES = 64 * IMPW_P * 4 + 256;
constexpr int AT_SEL = AT_IMP + AT_IMP_BYTES, AT_SC = AT_SEL + 64 * 3 * 8, AT_UNI = AT_SC + 8 * 192 * 4, AT_OACC = AT_UNI + 64, AT_END = AT_OACC + 32 * NTHREADS * 4;
static_assert((AT_OACC % 16) == 0 && AT_END <= RING_BYTES && 4 * IMPW_S * 4 <= AT_IMP_BYTES && (AT_IMP % 16) == 0 && (AT_SEL % 8) == 0, "attention LDS map");
constexpr float NEG_BIG = -1.0e30f;
struct AtUnit { bool samp; int b, g, t0, row0, ntok; };

struct AtPiece { v4u a, b; int kind; };
template <int BRX, bool SAMP> __device__ __forceinline__ AtPiece at_load_raw(const Frame& F, const AtUnit& u, int ti, int isv) {
    constexpr int BR = BRX & 15;
    int t_ = F.tid; ASMV("" : "+v"(t_));
    if (AT_PROBE == 5 && BRX >= 16) { AtPiece Z; Z.a = (v4u){0u,0u,0u,0u}; Z.b = Z.a; Z.kind = 1; return Z; }
    const int row = t_ >> 3, ch = t_ & 7; AtPiece P; P.b = (v4u){0u, 0u, 0u, 0u};
    if (!SAMP) { const bf16* pb;
        if (BR == 0) pb = wsp<bf16>(F, WS_KC + (isv ? VC_P_OFF : KC_P_OFF)) + ((size_t)(u.b * 4 + u.g) * NCPAD_P + 64 * ti + row) * 64 + ch * 8;
        else if (BR == 1) pb = wsp<bf16>(F, WS_KVB) + (size_t)(u.b * SEQ + 64 * ti + row) * 1024 + 512 + isv * 256 + u.g * 64 + ch * 8;
        else pb = wsp<bf16>(F, WS_WINB) + (size_t)(u.b * SEQ + 64 * ti + row) * 512 + isv * 256 + u.g * 64 + ch * 8;
        P.a = *(const GAS v4u*)pb; P.kind = 1; return P; }
    if (BR == 0) { P.a = *(const GAS v4u*)(wsp<bf16>(F, WS_KC + (isv ? VC_S_OFF : KC_S_OFF)) + ((size_t)(u.b * 4 + u.g) * NCPAD_S + 64 * ti + row) * 64 + ch * 8); P.kind = 1; return P; }
    const char* p; int kind;
    if (BR == 1) { const int co = 512 + isv * 256 + u.g * 64 + ch * 8;
        if (ti < PAST_LEN / 64) { const int page = ((const GAS int*)inp(F, 8))[u.b * N_PAGES + (64 * ti) / PAGE_SIZE]; p = (const char*)(inp(F, 2) + ((size_t)page * PAGE_SIZE + (64 * ti) % PAGE_SIZE + row) * 1024 + co); kind = 2; }
        else { const int rr = row < DEC_SEQ ? row : 0; p = (const char*)(wsp<bf16>(F, WS_KVB) + (size_t)(MPR + u.b * DEC_SEQ + rr) * 1024 + co); kind = row < DEC_SEQ ? 1 : 0; } }
    else { const int co = isv * 256 + u.g * 64 + ch * 8, i = 64 * ti + row;
        const char* pc = (const char*)(inp(F, 3) + ((size_t)u.b * WB_LEN + (i < WB_LEN ? i : 0)) * 512 + co);
        const int rr = (i >= WB_LEN && i < WB_LEN + DEC_SEQ) ? i - WB_LEN : 0; const char* pn = (const char*)(wsp<bf16>(F, WS_WINB) + (size_t)(MPR + u.b * DEC_SEQ + rr) * 512 + co);
        p = i < WB_LEN ? pc : pn; kind = i < WB_LEN ? 2 : (i < WB_LEN + DEC_SEQ ? 1 : 0); }
    P.a = *(const GAS v4u*)p; P.b = *(const GAS v4u*)(p + (kind == 2 ? 16 : 0)); P.kind = kind; return P;
}
template <bool SAMP> __device__ __forceinline__ AtPiece at_load_rt(const Frame& F, const AtUnit& u, int br, int ti, int isv) {
    int t_ = F.tid; ASMV("" : "+v"(t_));
    const int row = t_ >> 3, ch = t_ & 7; AtPiece P; P.b = (v4u){0u, 0u, 0u, 0u};
    if (!SAMP) {
        const bf16* b0 = wsp<bf16>(F, WS_KC + (isv ? VC_P_OFF : KC_P_OFF)) + (size_t)(u.b * 4 + u.g) * NCPAD_P * 64;
        const bf16* b1 = wsp<bf16>(F, WS_KVB) + (size_t)u.b * SEQ * 1024 + 512 + isv * 256 + u.g * 64;
        const bf16* b2 = wsp<bf16>(F, WS_WINB) + (size_t)u.b * SEQ * 512 + isv * 256 + u.g * 64;
        const bf16* base = br == 0 ? b0 : (br == 1 ? b1 : b2); const int stride = br == 0 ? 64 : (br == 1 ? 1024 : 512);
        P.a = *(const GAS v4u*)(base + (size_t)(64 * ti + row) * stride + ch * 8); P.kind = 1; return P; }
    const char* p; int kind;
    if (br == 0) { p = (const char*)(wsp<bf16>(F, WS_KC + (isv ? VC_S_OFF : KC_S_OFF)) + ((size_t)(u.b * 4 + u.g) * NCPAD_S + 64 * ti + row) * 64 + ch * 8); kind = 1; }
    else if (br == 1) { const int co = 512 + isv * 256 + u.g * 64 + ch * 8;
        if (ti < PAST_LEN / 64) { const int page = ((const GAS int*)inp(F, 8))[u.b * N_PAGES + (64 * ti) / PAGE_SIZE]; p = (const char*)(inp(F, 2) + ((size_t)page * PAGE_SIZE + (64 * ti) % PAGE_SIZE + row) * 1024 + co); kind = 2; }
        else { const int rr = row < DEC_SEQ ? row : 0; p = (const char*)(wsp<bf16>(F, WS_KVB) + (size_t)(MPR + u.b * DEC_SEQ + rr) * 1024 + co); kind = row < DEC_SEQ ? 1 : 0; } }
    else { const int co = isv * 256 + u.g * 64 + ch * 8, i = 64 * ti + row;
        const char* pc = (const char*)(inp(F, 3) + ((size_t)u.b * WB_LEN + (i < WB_LEN ? i : 0)) * 512 + co);
        const int rr = (i >= WB_LEN && i < WB_LEN + DEC_SEQ) ? i - WB_LEN : 0; const char* pn = (const char*)(wsp<bf16>(F, WS_WINB) + (size_t)(MPR + u.b * DEC_SEQ + rr) * 512 + co);
        p = i < WB_LEN ? pc : pn; kind = i < WB_LEN ? 2 : (i < WB_LEN + DEC_SEQ ? 1 : 0); }
    P.a = *(const GAS v4u*)p; P.b = *(const GAS v4u*)(p + (kind == 2 ? 16 : 0)); P.kind = kind; return P;
}
__device__ __forceinline__ v4u at_piece_bf16(const AtPiece& P) {
    const f32x4 a = __builtin_bit_cast(f32x4, P.a), b = __builtin_bit_cast(f32x4, P.b); v4u w; w.x = cvt_pk_bf16(a[0], a[1]); w.y = cvt_pk_bf16(a[2], a[3]); w.z = cvt_pk_bf16(b[0], b[1]); w.w = cvt_pk_bf16(b[2], b[3]);
    return P.kind == 2 ? w : (P.kind == 1 ? P.a : (v4u){0u, 0u, 0u, 0u});
}
#ifdef EMU
__device__ __forceinline__ int at_bits_below(unsigned long long e, int lane) { return __popcll(e & ((1ull << lane) - 1ull)); }
#else
__device__ __forceinline__ int at_bits_below(unsigned long long e, int lane) { (void)lane; return (int)__builtin_amdgcn_mbcnt_hi((unsigned)(e >> 32), __builtin_amdgcn_mbcnt_lo((unsigned)e, 0u)); }
#endif
struct AtLane { int t; float slope2; bool rowok; int l32, hi; };
template <int MODE, int KSTEP, bool INTERIOR = false, int PROBE = 0> __device__ __forceinline__ void at_tile(const LAS unsigned char* Kt, const LAS unsigned char* Vt, const bf16x8 (&qf)[4], const AtLane& L,
        int kpos0, bool selok, int wlimit, float& m, float& l, f32x16 (&o)[2], float inv_l, LAS unsigned* imp_row, int j8base, int impw) {
    if (PROBE == 6) return;
    const int l32 = L.l32, hi = L.hi; const int pi = (l32 & 19) | ((l32 >> 1) & 4) | ((l32 << 1) & 8);
    f32x16 p[2];
#pragma unroll
    for (int kb = 0; kb < 2; ++kb) { p[kb] = (f32x16){};
        const LAS unsigned char* kr = Kt + (32 * kb + pi) * AT_KSTR + hi * 16;
        if (PROBE != 3)
#pragma unroll
        for (int kc = 0; kc < 4; ++kc) p[kb] = __builtin_amdgcn_mfma_f32_32x32x16_bf16(*(const LAS bf16x8*)(kr + kc * 32), qf[kc], p[kb], 0, 0, 0); }
    float ls = 0.f;
    if (PROBE != 1) {
    const bool rok = selok && L.rowok;
    int dbase = L.t - kpos0 - KSTEP * 8 * hi; ASMV("" : "+v"(dbase));
    if (INTERIOR) {
        const float sk = L.slope2 * (float)KSTEP, off = -L.slope2 * (float)dbase; float mx = NEG_BIG;
#pragma unroll
        for (int kb = 0; kb < 2; ++kb)
#pragma unroll
            for (int r = 0; r < 16; ++r) { const float s = p[kb][r] + sk * (float)(32 * kb + 16 * (r >> 3) + (r & 7)); p[kb][r] = s; mx = fmaxf(mx, s); }
        mx = rok ? mx + off : NEG_BIG; mx = fmaxf(mx, __shfl_xor(mx, 32));
        const float mn = fmaxf(m, mx);
        if (__any(mn > m)) { const float alpha = __builtin_amdgcn_exp2f(m - mn); l *= alpha;
#pragma unroll
            for (int db = 0; db < 2; ++db)
#pragma unroll
                for (int r = 0; r < 16; ++r) o[db][r] *= alpha; }
        m = mn; const float mref = rok ? mn - off : 1.0e30f;
#pragma unroll
        for (int kb = 0; kb < 2; ++kb)
#pragma unroll
            for (int r = 0; r < 16; ++r) { const float e = __builtin_amdgcn_exp2f(p[kb][r] - mref); p[kb][r] = e; ls += e; }
    } else {
    float mx = NEG_BIG;
#pragma unroll
    for (int kb = 0; kb < 2; ++kb)
#pragma unroll
        for (int r = 0; r < 16; ++r) { const int dist = dbase - KSTEP * (32 * kb + 16 * (r >> 3) + (r & 7));
            const bool ok = rok && dist >= 0 && dist < wlimit; const float s = ok ? p[kb][r] - L.slope2 * (float)dist : NEG_BIG; p[kb][r] = s; mx = fmaxf(mx, s); }
    float mref = m;
    if (MODE != 1) { mx = fmaxf(mx, __shfl_xor(mx, 32)); const float mn = fmaxf(m, mx); mref = mn;
        if (__any(mn > m)) { const float alpha = __builtin_amdgcn_exp2f(m - mn); l *= alpha;
            if (MODE == 2) {
#pragma unroll
                for (int db = 0; db < 2; ++db)
#pragma unroll
                    for (int r = 0; r < 16; ++r) o[db][r] *= alpha; } }
        m = mn; }
#pragma unroll
    for (int kb = 0; kb < 2; ++kb)
#pragma unroll
        for (int r = 0; r < 16; ++r) { const float s = p[kb][r]; float e = (s > -1.0e29f) ? __builtin_amdgcn_exp2f(s - mref) : 0.f; if (MODE == 1) e *= inv_l; p[kb][r] = e; ls += e; }
    }
    }
    if (MODE != 1) l += ls;
    if (MODE == 0) return;
    if (MODE == 1) {
#pragma unroll
        for (int kb = 0; kb < 2; ++kb)
#pragma unroll
            for (int hf = 0; hf < 2; ++hf) { const int na = (j8base + 32 * kb + 16 * hf + 8 * hi) >> 2; const int r0 = 8 * hf;
                const float a = (p[kb][r0] + p[kb][r0 + 1]) + (p[kb][r0 + 2] + p[kb][r0 + 3]), b = (p[kb][r0 + 4] + p[kb][r0 + 5]) + (p[kb][r0 + 6] + p[kb][r0 + 7]) + p[kb][r0 + 3], c = p[kb][r0 + 7];
                if (L.rowok) { __hip_atomic_fetch_add(imp_row + na, (unsigned)(a * 67108864.f + 0.5f), __ATOMIC_RELAXED, __HIP_MEMORY_SCOPE_WORKGROUP);
                    if (na + 1 < impw) __hip_atomic_fetch_add(imp_row + na + 1, (unsigned)(b * 67108864.f + 0.5f), __ATOMIC_RELAXED, __HIP_MEMORY_SCOPE_WORKGROUP);
                    if (na + 2 < impw) __hip_atomic_fetch_add(imp_row + na + 2, (unsigned)(c * 67108864.f + 0.5f), __ATOMIC_RELAXED, __HIP_MEMORY_SCOPE_WORKGROUP); } }
    }
    if (PROBE == 2) return;
    const int gi = L.l32 & 15;
    const LAS unsigned char* vbase = Vt + (8 * hi + (gi >> 2)) * AT_VSTR + (16 * ((L.l32 >> 4) & 1) + 4 * (gi & 3)) * 2;
#pragma unroll
    for (int kb = 0; kb < 2; ++kb)
#pragma unroll
        for (int s = 0; s < 2; ++s) { v4u pw; const int r0 = 8 * s;
            pw.x = cvt_pk_bf16(p[kb][r0], p[kb][r0 + 1]); pw.y = cvt_pk_bf16(p[kb][r0 + 2], p[kb][r0 + 3]); pw.z = cvt_pk_bf16(p[kb][r0 + 4], p[kb][r0 + 5]); pw.w = cvt_pk_bf16(p[kb][r0 + 6], p[kb][r0 + 7]);
            const bf16x8 pf = __builtin_bit_cast(bf16x8, pw);
#pragma unroll
            for (int db = 0; db < 2; ++db) { const LAS unsigned char* vp = vbase + (32 * kb + 16 * s) * AT_VSTR + 64 * db;
                const v4i16 lo = __builtin_amdgcn_ds_read_tr16_b64_v4i16((LAS v4i16*)vp), hh = __builtin_amdgcn_ds_read_tr16_b64_v4i16((LAS v4i16*)(vp + 4 * AT_VSTR));
                const bf16x8 vf = (bf16x8){lo[0], lo[1], lo[2], lo[3], hh[0], hh[1], hh[2], hh[3]};
                o[db] = __builtin_amdgcn_mfma_f32_32x32x16_bf16(vf, pf, o[db], 0, 0, 0); } }
}
#define AT_STAGE(bufi, kreg, vreg) do { int _t = F.tid; ASMV("" : "+v"(_t)); const int _o = (_t >> 3) * AT_KSTR + (_t & 7) * 16; *(LAS v4u*)(lds + AT_K + (bufi) * AT_TILE + _o) = SAMP ? at_piece_bf16(kreg) : (kreg).a; *(LAS v4u*)(lds + AT_V + (bufi) * AT_VTILE + (_t >> 3) * AT_VSTR + (_t & 7) * 16) = SAMP ? at_piece_bf16(vreg) : (vreg).a; } while (0)

template <bool SAMP, int PROBE = 0> __device__ __forceinline__ void nsa_attn_unit(Frame& F, const AtUnit& u) {
    LAS unsigned char* lds = F.lds + RING_OFF;
    LAS unsigned* imp = (LAS unsigned*)(lds + AT_IMP); LAS unsigned long long* selm = (LAS unsigned long long*)(lds + AT_SEL); LAS unsigned* scw = (LAS unsigned*)(lds + AT_SC) + F.wave * 192;
    int lane_ = F.lane; ASMV("" : "+v"(lane_));
    const int lane = lane_, l32 = lane & 31, hi = lane >> 5, hh = F.wave >> 1, th = F.wave & 1;
        const int impw = SAMP ? IMPW_S : IMPW_P, nsel = SAMP ? NSEL_S : NSEL_P, keff = SEL_TOPK < nsel ? SEL_TOPK : nsel;
        AtLane L; L.l32 = l32; L.hi = hi; const int tk = 32 * th + l32; L.rowok = tk < u.ntok; L.t = u.t0 + (L.rowok ? tk : 0);
        L.slope2 = __builtin_amdgcn_exp2f(-0.5f * (float)(u.g * 4 + hh + 1)) * 1.4426950408889634f;
        const int qrow = u.row0 + (L.rowok ? tk : 0);
        bf16x8 qf[4];
        { const bf16* qp = wsp<bf16>(F, WS_Q) + (size_t)qrow * 1024 + u.g * 256 + hh * 64 + hi * 8;
#pragma unroll
          for (int kc = 0; kc < 4; ++kc) qf[kc] = *(const GAS bf16x8*)(qp + kc * 16); }
        for (int i = F.tid; i < AT_IMP_BYTES / 4; i += NTHREADS) imp[i] = 0u;
        if (F.tid < 3) ((LAS unsigned long long*)(lds + AT_UNI))[F.tid] = 0ull;
        LAS unsigned* imp_row = imp + (L.rowok ? tk : 0) * impw;
        f32x16 o[2]; LAS float* oacc = (LAS float*)(lds + AT_OACC) + F.wave * 2048 + lane;
        const float* gp = wsp<float>(F, WS_GATES) + (size_t)qrow * 48 + u.g * 12 + hh * 3;
        const float g0 = sigmoidf_(gp[0]), g1 = sigmoidf_(gp[1]), g2 = sigmoidf_(gp[2]);
        constexpr int PD = SAMP ? 1 : 2;
        const int nct = SAMP ? NCPAD_S / 64 : ((((u.t0 + 32) >> 4) >> 6) + 1 < NCPAD_P / 64 ? (((u.t0 + 32) >> 4) >> 6) + 1 : NCPAD_P / 64);
        int tfirst, tlast, kp0;
        if (SAMP) { tfirst = 0; tlast = (WB_LEN + DEC_SEQ + 63) / 64 - 1; kp0 = PAST_LEN - WB_LEN; }
        else { const int lo = u.t0 - WINDOW + 1; tfirst = lo > 0 ? lo >> 6 : 0; tlast = u.t0 >> 6; kp0 = 0; }
        const int nw = tlast - tfirst + 1;
        float m = NEG_BIG, l = 0.f, inv_l = 0.f; int buf = 0;
        AtPiece k2, v2;
        {
#define AT_CW(ii2, br, ti) const int _q = (ii2), br = _q < 2 * nct ? 0 : 2, ti = _q < 2 * nct ? (_q < nct ? _q : _q - nct) : tfirst + (_q - 2 * nct < nw ? _q - 2 * nct : nw - 1)
            { AT_CW(0, br0, ti0); const AtPiece k1 = at_load_rt<SAMP>(F, u, br0, ti0, 0), v1 = at_load_rt<SAMP>(F, u, br0, ti0, 1); k2 = k1; v2 = v1;
              if (!SAMP) { AT_CW(1, br1, ti1); k2 = at_load_rt<SAMP>(F, u, br1, ti1, 0); v2 = at_load_rt<SAMP>(F, u, br1, ti1, 1); }
              __syncthreads();
              AT_STAGE(0, k1, v1); __syncthreads(); }
            for (int ii = 0; ii < 2 * nct; ++ii) {
                AT_CW(ii + PD, br3, ti3);
                const AtPiece k3 = at_load_rt<SAMP>(F, u, br3, ti3, 0), v3 = at_load_rt<SAMP>(F, u, br3, ti3, 1);
                if (ii == nct) { l += __shfl_xor(l, 32); inv_l = l > 0.f ? 1.0f / l : 0.f; o[0] = (f32x16){}; o[1] = (f32x16){}; }
                const int i = ii < nct ? ii : ii - nct;
                const LAS unsigned char* Kt = lds + AT_K + buf * AT_TILE; const LAS unsigned char* Vt = lds + AT_V + buf * AT_VTILE;
                if (ii < nct) at_tile<0, 16, false, PROBE>(Kt, Vt, qf, L, 16 * 64 * i + 31, true, 0x7fffffff, m, l, o, 0.f, imp_row, 0, impw);
                else at_tile<1, 16, false, PROBE>(Kt, Vt, qf, L, 16 * 64 * i + 31, true, 0x7fffffff, m, l, o, inv_l, imp_row, 64 * i, impw);
                if (SAMP) AT_STAGE(buf ^ 1, k3, v3); else AT_STAGE(buf ^ 1, k2, v2);
                buf ^= 1;
                __syncthreads();
                if (!SAMP) { k2 = k3; v2 = v3; }
            }
#undef AT_CW
        }
#pragma unroll
        for (int db = 0; db < 2; ++db)
#pragma unroll
            for (int r = 0; r < 16; ++r) oacc[(16 * db + r) * 64] = g0 * o[db][r];
        for (int tkk = F.wave; tkk < u.ntok; tkk += NWAVES) {
            const int t = u.t0 + tkk, cur = t >> 6; unsigned sc[3];
#pragma unroll
            for (int i = 0; i < 3; ++i) { const int n = lane + 64 * i; unsigned s = 0u;
                if (n < nsel && 64 * n <= t) { s = imp[tkk * impw + n] + 1u; if (n == 0 || n == cur || n == cur - 1) s += 0x80000000u; }
                sc[i] = s; }
            constexpr int NSELC = SAMP ? NSEL_S : NSEL_P, NW = (NSELC + 63) / 64;
            unsigned T = 0u;
            for (int bit = 31; bit >= 0; --bit) { const unsigned cand = T | (1u << bit); int cnt = 0;
#pragma unroll
                for (int i = 0; i < NW; ++i) cnt += __popcll(__ballot(sc[i] >= cand));
                if (cnt >= keff) T = cand; }
            int need = keff;
#pragma unroll
            for (int i = 0; i < NW; ++i) need -= __popcll(__ballot(sc[i] > T));
#pragma unroll
            for (int i = 0; i < 3; ++i) { unsigned long long bal = 0ull;
                if (i < NW) { const unsigned long long e = __ballot(sc[i] == T && T != 0u); const int pre = at_bits_below(e, lane);
                    bal = __ballot(sc[i] > T || (sc[i] == T && T != 0u && pre < need)); need -= __popcll(e); }
                if (lane == 0) { selm[tkk * 3 + i] = bal; if (bal) __hip_atomic_fetch_or((LAS unsigned long long*)(lds + AT_UNI) + i, bal, __ATOMIC_RELAXED, __HIP_MEMORY_SCOPE_WORKGROUP); } }
            LDS_WAIT();
        }
        __syncthreads();
        const LAS unsigned long long* uni = (const LAS unsigned long long*)(lds + AT_UNI); int wi = 0; unsigned long long rem = uni[0]; int n = -1;
        auto next_tile = [&]() { while (rem == 0ull && wi < 2) { ++wi; rem = uni[wi]; } if (rem == 0ull) { n = -1; return; } const int bpos = __ffsll(rem) - 1; rem &= rem - 1ull; n = 64 * wi + bpos; };
        next_tile(); const int nA = n >= 0 ? n : 0; next_tile(); int nB = n >= 0 ? n : nA; next_tile(); int nC = n >= 0 ? n : nB;
        const int left = __popcll(uni[0]) + __popcll(uni[1]) + __popcll(uni[2]);
        {
            m = NEG_BIG; l = 0.f; o[0] = (f32x16){}; o[1] = (f32x16){};
            if (!SAMP && nw == 1) { k2 = at_load_rt<SAMP>(F, u, 1, nA, 0); v2 = at_load_rt<SAMP>(F, u, 1, nA, 1); }
            for (int j = 0; j < nw; ++j) {
                const int j2 = j + PD, br3 = j2 < nw ? 2 : 1, ti3 = j2 < nw ? tfirst + j2 : (j2 == nw ? nA : nB);
                const AtPiece k3 = at_load_rt<SAMP>(F, u, br3, ti3, 0), v3 = at_load_rt<SAMP>(F, u, br3, ti3, 1);
                { const int kq = kp0 + 64 * (tfirst + j), tmax = u.t0 + u.ntok - 1;
                  if (kq + 63 <= u.t0 && tmax - kq < WINDOW) at_tile<2, 1, true, PROBE>(lds + AT_K + buf * AT_TILE, lds + AT_V + buf * AT_VTILE, qf, L, kq, true, WINDOW, m, l, o, 0.f, imp_row, 0, impw);
                  else at_tile<2, 1, false, PROBE>(lds + AT_K + buf * AT_TILE, lds + AT_V + buf * AT_VTILE, qf, L, kq, true, WINDOW, m, l, o, 0.f, imp_row, 0, impw); }
                if (SAMP) AT_STAGE(buf ^ 1, k3, v3); else AT_STAGE(buf ^ 1, k2, v2);
                buf ^= 1;
                __syncthreads();
                if (!SAMP) { k2 = k3; v2 = v3; }
            }
            l += __shfl_xor(l, 32); const float sc2 = l > 0.f ? g2 / l : 0.f;
#pragma unroll
            for (int db = 0; db < 2; ++db)
#pragma unroll
                for (int r = 0; r < 16; ++r) oacc[(16 * db + r) * 64] += sc2 * o[db][r];
        }
        {
            m = NEG_BIG; l = 0.f; o[0] = (f32x16){}; o[1] = (f32x16){};
            int ncur = nA;
            for (int j = 0; j < left; ++j) {
                const AtPiece k3 = at_load_rt<SAMP>(F, u, 1, SAMP ? nB : nC, 0), v3 = at_load_rt<SAMP>(F, u, 1, SAMP ? nB : nC, 1);
                const bool selok = L.rowok && ((selm[tk * 3 + (ncur >> 6)] >> (ncur & 63)) & 1ull);
                if (__any(selok)) { if (64 * ncur + 63 <= u.t0) at_tile<2, 1, true, PROBE>(lds + AT_K + buf * AT_TILE, lds + AT_V + buf * AT_VTILE, qf, L, 64 * ncur, selok, 0x7fffffff, m, l, o, 0.f, imp_row, 0, impw);
                    else at_tile<2, 1, false, PROBE>(lds + AT_K + buf * AT_TILE, lds + AT_V + buf * AT_VTILE, qf, L, 64 * ncur, selok, 0x7fffffff, m, l, o, 0.f, imp_row, 0, impw); }
                if (SAMP) AT_STAGE(buf ^ 1, k3, v3); else AT_STAGE(buf ^ 1, k2, v2);
                buf ^= 1;
                __syncthreads();
                if (!SAMP) { k2 = k3; v2 = v3; } ncur = nB; nB = nC; next_tile(); if (n >= 0) nC = n;
            }
            l += __shfl_xor(l, 32); const float sc1 = l > 0.f ? g1 / l : 0.f;
#pragma unroll
            for (int db = 0; db < 2; ++db)
#pragma unroll
                for (int r = 0; r < 16; ++r) o[db][r] = oacc[(16 * db + r) * 64] + sc1 * o[db][r];
        }
        if (L.rowok) { bf16* op = wsp<bf16>(F, PROBE ? WS_MISC + ((size_t)300 << 20) : WS_AO) + (size_t)qrow * 1024 + u.g * 256 + hh * 64 + 4 * hi;
#pragma unroll
            for (int db = 0; db < 2; ++db)
#pragma unroll
                for (int r4 = 0; r4 < 4; ++r4) { v2u w; w.x = cvt_pk_bf16(o[db][4 * r4], o[db][4 * r4 + 1]); w.y = cvt_pk_bf16(o[db][4 * r4 + 2], o[db][4 * r4 + 3]); *(GAS v2u*)(op + 32 * db + 8 * r4) = w; } }
        __syncthreads();
}
constexpr int CW_ATQ = 2560;
__device__ __forceinline__ void nsa_attn_phase(Frame& F, int rep = 0) {
    constexpr int NQT = SEQ / 64, NBG = BATCH * 4, UNITS_S = DEC_BATCH * 4;
    LAS unsigned* qslot = (LAS unsigned*)(F.lds + RING_OFF + AT_UNI + 32);
    const int xcd = (int)(xb_xcc_id() & 7u);
    unsigned long long cdone = 0ull;
    static_assert(BATCH + DEC_BATCH <= 64, "cdone mask");
    for (int xo = 0; xo < 8; ++xo) { const int x = (xcd + xo) & 7;
        const int ns = x < UNITS_S ? (UNITS_S - x + 7) / 8 : 0, nb = x < NBG ? (NBG - x + 7) / 8 : 0, total = ns + nb * NQT;
        for (;;) {
            __syncthreads();
            if (F.tid == 0) {
                const int k0 = (int)__hip_atomic_fetch_add(F.ctl + CW_ATQ + 64 * (rep * 8 + x), 1u, __ATOMIC_RELAXED, __HIP_MEMORY_SCOPE_AGENT);
                if (k0 < total) { const bool us = k0 < ns; const int ub = us ? (x + 8 * k0) >> 2 : (x + 8 * ((k0 - ns) % nb)) >> 2, ci = us ? BATCH + ub : ub;
                    if (!((cdone >> ci) & 1ull)) { gu32* cw = F.ctl + CW_CMPC + 64 * ci; const unsigned want = us ? (unsigned)CMP_NT_S : (unsigned)CMP_NT_P; unsigned spins = 0;
                        while (__hip_atomic_load(cw, __ATOMIC_RELAXED, __HIP_MEMORY_SCOPE_AGENT) < want) { __builtin_amdgcn_s_sleep(2); if (++spins > (1u << 22)) { __hip_atomic_store(F.ctl + CW_TMO, 1u, __ATOMIC_RELAXED, __HIP_MEMORY_SCOPE_AGENT); break; } }
                        cdone |= 1ull << ci; } }
                *qslot = (unsigned)k0; }
            __syncthreads();
            const int k = (int)*qslot;
            if (k >= total) break;
            if (AT_PROBE == 8 && rep && k >= ns) break;
            if (AT_PROBE == 9 && rep && k < ns) continue;
            AtUnit u;
            __builtin_amdgcn_fence(__ATOMIC_ACQUIRE, "agent"); ASMV("s_waitcnt vmcnt(0)" ::: "memory");
            if (k < ns) { const int sidx = x + 8 * k; u.samp = true; u.b = sidx >> 2; u.g = sidx & 3; u.t0 = PAST_LEN; u.row0 = MPR + u.b * DEC_SEQ; u.ntok = DEC_SEQ; { if (AT_PROBE && rep) nsa_attn_unit<true, AT_PROBE>(F, u); else nsa_attn_unit<true>(F, u); } }
            else { const int v = k - ns, bg = x + 8 * (v % nb), qt = NQT - 1 - v / nb; u.samp = false; u.b = bg >> 2; u.g = bg & 3; u.t0 = 64 * qt; u.row0 = u.b * SEQ + u.t0; u.ntok = 64; { if (AT_PROBE && rep) nsa_attn_unit<false, AT_PROBE>(F, u); else nsa_attn_unit<false>(F, u); } }
        }
    }
}
constexpr int NCK = SEQ / 64, NBH = BATCH * 8;
constexpr size_t MS_M = 0, MS_D = MS_M + al4k((size_t)NBH * (NCK + 1) * 4), MS_DC = MS_D + al4k((size_t)NBH * NCK * 4), MS_DN = MS_DC + al4k((size_t)NBH * NCK * 8192 * 4),
    MS_CST = MS_DN + al4k((size_t)NBH * NCK * 64 * 4), MS_NST = MS_CST + al4k((size_t)NBH * NCK * 8192 * 2), MS_END = MS_NST + al4k((size_t)NBH * NCK * 64 * 4);
static_assert(MS_END <= ((size_t)512 << 20), "mLSTM scratch");
constexpr float LOG2E = 1.4426950408889634f;
__device__ __forceinline__ float log_sigmoidf_(float x) { return fminf(x, 0.f) - 0.6931471805599453f * __builtin_amdgcn_logf(1.0f + __builtin_amdgcn_exp2f(-fabsf(x) * LOG2E)); }
__device__ __forceinline__ float expf_(float x) { return __builtin_amdgcn_exp2f(x * LOG2E); }
__device__ __forceinline__ float wave_incl_sum(float v, int lane) {
#pragma unroll
    for (int o = 1; o < 64; o <<= 1) { const float t = __shfl(v, lane - o < 0 ? 0 : lane - o); if (lane >= o) v += t; }
    return v;
}
__device__ __forceinline__ float wave_incl_max(float v, int lane) {
#pragma unroll
    for (int o = 1; o < 64; o <<= 1) { const float t = __shfl(v, lane - o < 0 ? 0 : lane - o); if (lane >= o) v = fmaxf(v, t); }
    return v;
}
constexpr int ML_KSTR = 144, ML_VSTR = 272;
__device__ __forceinline__ bf16x8 mk8(v4i16 a, v4i16 b) { return (bf16x8){a[0], a[1], a[2], a[3], b[0], b[1], b[2], b[3]}; }
__device__ __forceinline__ void mlstm_phase_a(Frame& F) {
    LAS unsigned char* lds = F.lds + RING_OFF;
    LAS float* sB = (LAS float*)lds; LAS float* sA = sB + NCK; LAS float* sM = sA + NCK;
    LAS unsigned char* Kt = lds + 4096; LAS unsigned char* Vt = Kt + 64 * ML_KSTR;
    static_assert((3 * NCK + 1) * 4 <= 4096 && 4096 + 64 * ML_KSTR + 64 * ML_VSTR <= RING_BYTES, "phase A LDS");
    const GAS float* MG = (const GAS float*)wsp<float>(F, WS_MG); const GAS bf16* MK = (const GAS bf16*)wsp<bf16>(F, WS_MK); const GAS bf16* MV = (const GAS bf16*)wsp<bf16>(F, WS_MV);
    GAS float* MSTm = (GAS float*)wsp<float>(F, WS_MISC + MS_M); GAS float* MSTd = (GAS float*)wsp<float>(F, WS_MISC + MS_D); GAS float* DC = (GAS float*)wsp<float>(F, WS_MISC + MS_DC); GAS float* DN = (GAS float*)wsp<float>(F, WS_MISC + MS_DN);
    const int lane = F.lane, l32 = lane & 31, hi = lane >> 5;
    constexpr int NCG = NCK / 8, UNITS = NBH * NCG;
    for (int un = F.vcu; un < UNITS; un += F.G) {
        const int bh = un / NCG, cg = un % NCG, b = bh >> 3, h = bh & 7, cend = 8 * cg + 8;
        const float bi = inp(F, 16)[h], bfg = inp(F, 16)[8 + h];
        __syncthreads();
        for (int j0 = F.wave; j0 < cend; j0 += 4 * NWAVES) {
            float igr[4], fgr[4];
#pragma unroll
            for (int q = 0; q < 4; ++q) { const int j = j0 + q * NWAVES, jj = j < cend ? j : j0; const size_t row = (size_t)b * SEQ + 64 * jj + lane; igr[q] = MG[row * 16 + h]; fgr[q] = MG[row * 16 + 8 + h]; }
#pragma unroll
            for (int q = 0; q < 4; ++q) { const int j = j0 + q * NWAVES; const float ig = igr[q] + bi, fg = log_sigmoidf_(fgr[q] + bfg);
                const float bb = wave_incl_sum(fg, lane), Bj = __shfl(bb, 63), aj = wave_max(Bj - bb + ig);
                if (lane == 0 && j < cend) { sB[j] = Bj; sA[j] = aj; } } }
        __syncthreads();
        if (F.tid == 0) { float m = 0.f; sM[0] = 0.f; for (int j = 0; j < cend; ++j) { m = fmaxf(sB[j] + m, sA[j]); sM[j + 1] = m; } }
        __syncthreads();
        if (F.tid < 8) { const int c = 8 * cg + F.tid; MSTm[bh * (NCK + 1) + c] = sM[c]; MSTd[bh * NCK + c] = expf_(sB[c] + sM[c] - sM[c + 1]);
            if (c == NCK - 1) { MSTm[bh * (NCK + 1) + NCK] = sM[NCK]; F.out[O_MP + bh] = sM[NCK]; } }
        float n_ig, n_fg; v4u n_kk, n_v0, n_v1;
#define ML_A_LOAD(cx) do { const size_t r0_ = (size_t)b * SEQ + 64 * (size_t)(8 * cg + (cx)); n_ig = MG[(r0_ + lane) * 16 + h]; n_fg = MG[(r0_ + lane) * 16 + 8 + h]; \
            n_kk = *(const GAS v4u*)(MK + (r0_ + (F.tid >> 3)) * 512 + h * 64 + (F.tid & 7) * 8); \
            n_v0 = *(const GAS v4u*)(MV + (r0_ + (F.tid >> 4)) * 1024 + h * 128 + (F.tid & 15) * 8); n_v1 = *(const GAS v4u*)(MV + (r0_ + (F.tid >> 4) + 32) * 1024 + h * 128 + (F.tid & 15) * 8); } while (0)
        ML_A_LOAD(0);
        for (int cc = 0; cc < 8; ++cc) { const int c = 8 * cg + cc;
            const float c_ig = n_ig, c_fg = n_fg; const v4u kk = n_kk, cv0 = n_v0, cv1 = n_v1;
            ML_A_LOAD(cc < 7 ? cc + 1 : 7);
            const float ig = c_ig + bi, fg = log_sigmoidf_(c_fg + bfg);
            const float bb = wave_incl_sum(fg, lane), Bc = __shfl(bb, 63); const float ws = expf_(Bc - bb + ig - sM[c + 1]);
            { const int r = F.tid >> 3, ch = F.tid & 7; const float wr = __shfl(ws, r & 63);
              v4u o;
#pragma unroll
              for (int e = 0; e < 4; ++e) o[e] = cvt_pk_bf16(bflo(kk[e]) * wr, bfhi(kk[e]) * wr);
              *(LAS v4u*)(Kt + r * ML_KSTR + ch * 16) = o;
              *(LAS v4u*)(Vt + (F.tid >> 4) * ML_VSTR + (F.tid & 15) * 16) = cv0; *(LAS v4u*)(Vt + ((F.tid >> 4) + 32) * ML_VSTR + (F.tid & 15) * 16) = cv1; }
            __syncthreads();
            { const int vb = F.wave >> 1, db = F.wave & 1, gi = l32 & 15; f32x16 acc = (f32x16){};
              const LAS unsigned char* va = Vt + (8 * hi + (gi >> 2)) * ML_VSTR + (32 * vb + 16 * ((l32 >> 4) & 1) + 4 * (gi & 3)) * 2;
              const LAS unsigned char* ka = Kt + (8 * hi + (gi >> 2)) * ML_KSTR + (32 * db + 16 * ((l32 >> 4) & 1) + 4 * (gi & 3)) * 2;
#pragma unroll
              for (int ks = 0; ks < 4; ++ks) {
                  const v4i16 a0 = __builtin_amdgcn_ds_read_tr16_b64_v4i16((LAS v4i16*)(va + 16 * ks * ML_VSTR)), a1 = __builtin_amdgcn_ds_read_tr16_b64_v4i16((LAS v4i16*)(va + (16 * ks + 4) * ML_VSTR));
                  const v4i16 b0 = __builtin_amdgcn_ds_read_tr16_b64_v4i16((LAS v4i16*)(ka + 16 * ks * ML_KSTR)), b1 = __builtin_amdgcn_ds_read_tr16_b64_v4i16((LAS v4i16*)(ka + (16 * ks + 4) * ML_KSTR));
                  acc = __builtin_amdgcn_mfma_f32_32x32x16_bf16(mk8(a0, a1), mk8(b0, b1), acc, 0, 0, 0); }
              GAS float* dc = DC + ((size_t)bh * NCK + c) * 8192 + (32 * vb + 4 * hi) * 64 + 32 * db + l32;
#pragma unroll
              for (int r = 0; r < 16; ++r) dc[((r & 3) + 8 * (r >> 2)) * 64] = acc[r];
              if (F.tid < 64) { float s = 0.f; for (int r = 0; r < 64; ++r) s += bf2f(*(const LAS unsigned short*)(Kt + r * ML_KSTR + F.tid * 2)); DN[((size_t)bh * NCK + c) * 64 + F.tid] = s; } }
            __syncthreads();
        }
    }
}
#undef ML_A_LOAD
__device__ __forceinline__ void mlstm_phase_b(Frame& F) {
    LAS float* part = (LAS float*)(F.lds + RING_OFF);
    const GAS float* MG = (const GAS float*)wsp<float>(F, WS_MG); const GAS bf16* MQ = (const GAS bf16*)wsp<bf16>(F, WS_MQ); const GAS bf16* MK = (const GAS bf16*)wsp<bf16>(F, WS_MK); const GAS bf16* MV = (const GAS bf16*)wsp<bf16>(F, WS_MV); const GAS bf16* MO = (const GAS bf16*)wsp<bf16>(F, WS_MO);
    for (int un = F.vcu; un < DEC_BATCH * 8; un += F.G) {
        const int b = un >> 3, h = un & 7, v = F.tid >> 2, dq = F.tid & 3; const size_t r0 = (size_t)MPR + b * DEC_SEQ;
        const float bi = inp(F, 16)[h], bfg = inp(F, 16)[8 + h], m0 = inp(F, 6)[un];
        float ig[4], bb[4], mt[4]; float run = 0.f;
#pragma unroll
        for (int t = 0; t < 4; ++t) { ig[t] = MG[(r0 + t) * 16 + h] + bi; run += log_sigmoidf_(MG[(r0 + t) * 16 + 8 + h] + bfg); bb[t] = run; }
#pragma unroll
        for (int t = 0; t < 4; ++t) { float mx = bb[t] + m0;
#pragma unroll
            for (int s = 0; s <= t; ++s) mx = fmaxf(mx, bb[t] - bb[s] + ig[s]); mt[t] = mx; }
        float qk[4][4], nq[4] = {0.f, 0.f, 0.f, 0.f};
#pragma unroll
        for (int t = 0; t < 4; ++t)
#pragma unroll
            for (int s = 0; s < 4; ++s) qk[t][s] = 0.f;
        const float* n0 = inp(F, 5) + (size_t)un * 64;
#pragma unroll 2
        for (int dc = 0; dc < 8; ++dc) {
            v4u qv[4], kv[4]; f32x4 na, nb;
#pragma unroll
            for (int t = 0; t < 4; ++t) { qv[t] = *(const GAS v4u*)(MQ + (r0 + t) * 512 + h * 64 + 8 * dc); kv[t] = *(const GAS v4u*)(MK + (r0 + t) * 512 + h * 64 + 8 * dc); }
            na = *(const GAS f32x4*)(n0 + 8 * dc); nb = *(const GAS f32x4*)(n0 + 8 * dc + 4);
#pragma unroll
            for (int e = 0; e < 8; ++e) { float q[4], k[4];
#pragma unroll
                for (int t = 0; t < 4; ++t) { const unsigned qw = qv[t][e >> 1], kw = kv[t][e >> 1]; q[t] = (e & 1) ? bfhi(qw) : bflo(qw); k[t] = (e & 1) ? bfhi(kw) : bflo(kw); }
                const float nn = e < 4 ? na[e & 3] : nb[e & 3];
#pragma unroll
                for (int t = 0; t < 4; ++t) { nq[t] += nn * q[t];
#pragma unroll
                    for (int s2 = 0; s2 <= t; ++s2) qk[t][s2] += q[t] * k[s2]; } } }
        const float* C0 = inp(F, 4) + ((size_t)un * 128 + v) * 64 + 16 * dq;
        float c0[16], cq[4] = {0.f, 0.f, 0.f, 0.f};
        v4u qd[4][2], kd[4][2];
#pragma unroll
        for (int t = 0; t < 4; ++t)
#pragma unroll
            for (int i = 0; i < 2; ++i) { qd[t][i] = *(const GAS v4u*)(MQ + (r0 + t) * 512 + h * 64 + 16 * dq + 8 * i); kd[t][i] = *(const GAS v4u*)(MK + (r0 + t) * 512 + h * 64 + 16 * dq + 8 * i); }
#pragma unroll
        for (int e = 0; e < 16; e += 4) { const f32x4 cc = *(const GAS f32x4*)(C0 + e); c0[e] = cc[0]; c0[e + 1] = cc[1]; c0[e + 2] = cc[2]; c0[e + 3] = cc[3]; }
#pragma unroll
        for (int t = 0; t < 4; ++t) {
#pragma unroll
            for (int e = 0; e < 16; ++e) { const unsigned w = qd[t][e >> 3][(e & 7) >> 1]; cq[t] += c0[e] * ((e & 1) ? bfhi(w) : bflo(w)); }
            cq[t] += __shfl_xor(cq[t], 1); cq[t] += __shfl_xor(cq[t], 2); }
        float vv[4], hv[4], ssq[4];
#pragma unroll
        for (int t = 0; t < 4; ++t) vv[t] = bf2f(MV[(r0 + t) * 1024 + h * 128 + v]);
#pragma unroll
        for (int t = 0; t < 4; ++t) { const float wi = expf_(bb[t] + m0 - mt[t]); float num = wi * cq[t], den = wi * nq[t];
#pragma unroll
            for (int s = 0; s <= t; ++s) { const float S = qk[t][s] * expf_(bb[t] - bb[s] + ig[s] - mt[t]); num += S * vv[s]; den += S; }
            hv[t] = num / fmaxf(fabsf(den), expf_(-mt[t])); float q2 = (dq == 0) ? hv[t] * hv[t] : 0.f;
#pragma unroll
            for (int o = 1; o < 64; o <<= 1) q2 += __shfl_xor(q2, o);
            ssq[t] = q2; }
        __syncthreads();
        if (F.lane == 0) {
#pragma unroll
            for (int t = 0; t < 4; ++t) part[F.wave * 4 + t] = ssq[t]; }
        __syncthreads();
        if (dq == 0) {
#pragma unroll
            for (int t = 0; t < 4; ++t) { float tot = 0.f;
#pragma unroll
                for (int w = 0; w < 8; ++w) tot += part[w * 4 + t];
                const float rn = 1.0f / sqrtf(tot * (1.0f / 128.0f) + RMS_EPS);
                const float o = hv[t] * rn * inp(F, 17)[h * 128 + v] * sigmoidf_(bf2f(MO[(r0 + t) * 1024 + h * 128 + v]));
                wsp<bf16>(F, WS_AO)[(r0 + t) * 1024 + h * 128 + v] = (bf16)(cvt_pk_bf16(o, 0.f) & 0xffffu); } }
        const float mL = mt[3], decay = expf_(bb[3] + m0 - mL); float wsv[4];
#pragma unroll
        for (int s = 0; s < 4; ++s) wsv[s] = expf_(bb[3] - bb[s] + ig[s] - mL);
        float* Co = outp(F) + O_CS + ((size_t)un * 128 + v) * 64 + 16 * dq;
#pragma unroll
        for (int e = 0; e < 16; ++e) { float a = decay * c0[e];
#pragma unroll
            for (int s = 0; s < 4; ++s) { const unsigned w = kd[s][e >> 3][(e & 7) >> 1]; a += wsv[s] * vv[s] * ((e & 1) ? bfhi(w) : bflo(w)); }
            Co[e] = a; }
        if (F.tid < 64) { float a = decay * n0[F.tid];
#pragma unroll
            for (int s = 0; s < 4; ++s) a += wsv[s] * bf2f(MK[(r0 + s) * 512 + h * 64 + F.tid]);
            F.out[O_NS + (size_t)un * 64 + F.tid] = a; }
        if (F.tid == 0) F.out[O_MS + un] = mL;
    }
    const GAS float* MSTd = (const GAS float*)wsp<float>(F, WS_MISC + MS_D); const GAS float* DC = (const GAS float*)wsp<float>(F, WS_MISC + MS_DC); const GAS float* DN = (const GAS float*)wsp<float>(F, WS_MISC + MS_DN);
    GAS bf16* CST = (GAS bf16*)wsp<bf16>(F, WS_MISC + MS_CST); GAS float* NST = (GAS float*)wsp<float>(F, WS_MISC + MS_NST);
    const int gt = F.vcu * NTHREADS + F.tid, NGT = F.G * NTHREADS;
    constexpr int SB = NCK < 8 ? NCK : 8;
    for (int it = gt; it < NBH * 4096; it += NGT) { const int bh = it >> 12, e2 = (it & 4095) * 2; f32x2 C = (f32x2){0.f, 0.f};
        for (int c0 = 0; c0 < NCK; c0 += SB) { f32x2 d[SB]; float dcy[SB];
#pragma unroll
            for (int i = 0; i < SB; ++i) { d[i] = *(const GAS f32x2*)(DC + ((size_t)bh * NCK + c0 + i) * 8192 + e2); dcy[i] = MSTd[bh * NCK + c0 + i]; }
#pragma unroll
            for (int i = 0; i < SB; ++i) { *(GAS unsigned*)(CST + ((size_t)bh * NCK + c0 + i) * 8192 + e2) = cvt_pk_bf16(C.x, C.y); C = C * dcy[i] + d[i]; } }
        *(GAS f32x2*)(outp(F) + O_CP + (size_t)bh * 8192 + e2) = C; }
    for (int it = gt; it < NBH * 64; it += NGT) { const int bh = it >> 6, d = it & 63; float n = 0.f;
        for (int c0 = 0; c0 < NCK; c0 += SB) { float dn[SB], dcy[SB];
#pragma unroll
            for (int i = 0; i < SB; ++i) { dn[i] = DN[((size_t)bh * NCK + c0 + i) * 64 + d]; dcy[i] = MSTd[bh * NCK + c0 + i]; }
#pragma unroll
            for (int i = 0; i < SB; ++i) { NST[((size_t)bh * NCK + c0 + i) * 64 + d] = n; n = n * dcy[i] + dn[i]; } }
        *(GAS float*)(outp(F) + O_NP + (size_t)bh * 64 + d) = n; }
}
__device__ __forceinline__ void mlstm_phase_c(Frame& F) {
    constexpr int WAREA = 64 * ML_VSTR + 1024;
    static_assert(WAREA * 8 <= RING_BYTES, "phase C LDS");
    LAS unsigned char* wl = F.lds + RING_OFF + F.wave * WAREA; LAS unsigned char* Vt = wl; LAS float* sU = (LAS float*)(wl + 64 * ML_VSTR); LAS float* sW = sU + 64; LAS float* sBc = sW + 64;
    const GAS float* MG = (const GAS float*)wsp<float>(F, WS_MG); const GAS bf16* MQ = (const GAS bf16*)wsp<bf16>(F, WS_MQ); const GAS bf16* MK = (const GAS bf16*)wsp<bf16>(F, WS_MK); const GAS bf16* MV = (const GAS bf16*)wsp<bf16>(F, WS_MV); const GAS bf16* MO = (const GAS bf16*)wsp<bf16>(F, WS_MO);
    const GAS float* MSTm = (const GAS float*)wsp<float>(F, WS_MISC + MS_M); const GAS bf16* CST = (const GAS bf16*)wsp<bf16>(F, WS_MISC + MS_CST); const GAS float* NST = (const GAS float*)wsp<float>(F, WS_MISC + MS_NST);
    const int lane = F.lane, l32 = lane & 31, hi = lane >> 5, gw = F.vcu * NWAVES + F.wave, NGW = F.G * NWAVES;
    const int pi = (l32 & 19) | ((l32 >> 1) & 4) | ((l32 << 1) & 8);
    for (int un = gw; un < NBH * NCK; un += NGW) {
        const int bh = un / NCK, c = un % NCK, b = bh >> 3, h = bh & 7; const size_t row0 = (size_t)b * SEQ + 64 * c;
        const float mc = MSTm[bh * (NCK + 1) + c];
        { const float ig = MG[(row0 + lane) * 16 + h] + inp(F, 16)[h], fg = log_sigmoidf_(MG[(row0 + lane) * 16 + 8 + h] + inp(F, 16)[8 + h]);
          const float bb = wave_incl_sum(fg, lane), uu = ig - bb, gg = wave_incl_max(uu, lane);
          sU[lane] = uu * LOG2E; sW[lane] = fmaxf(mc, gg) * LOG2E; sBc[lane] = bb * LOG2E; }
        { LAS unsigned char* vd = Vt + (lane >> 4) * ML_VSTR + (lane & 15) * 16; const GAS bf16* vs = MV + (row0 + (lane >> 4)) * 1024 + h * 128 + (lane & 15) * 8;
#pragma unroll
          for (int i = 0; i < 16; ++i) *(LAS v4u*)(vd + i * 4 * ML_VSTR) = *(const GAS v4u*)(vs + (size_t)i * 4 * 1024); }
        LDS_WAIT();
        const GAS float* nst = NST + ((size_t)bh * NCK + c) * 64; const GAS bf16* cst = CST + ((size_t)bh * NCK + c) * 8192;
#pragma unroll
        for (int tb = 0; tb < 2; ++tb) {
            const int t = 32 * tb + l32; const float Wt = sW[t], wi = __builtin_amdgcn_exp2f(mc * LOG2E - Wt);
            bf16x8 qf[4]; float nq = 0.f;
#pragma unroll
            for (int kc = 0; kc < 4; ++kc) { qf[kc] = *(const GAS bf16x8*)(MQ + (row0 + t) * 512 + h * 64 + 16 * kc + 8 * hi);
                const f32x4 n0 = *(const GAS f32x4*)(nst + 16 * kc + 8 * hi), n1 = *(const GAS f32x4*)(nst + 16 * kc + 8 * hi + 4); const v4u qw = __builtin_bit_cast(v4u, qf[kc]);
                nq += n0[0] * bflo(qw.x) + n0[1] * bfhi(qw.x) + n0[2] * bflo(qw.y) + n0[3] * bfhi(qw.y) + n1[0] * bflo(qw.z) + n1[1] * bfhi(qw.z) + n1[2] * bflo(qw.w) + n1[3] * bfhi(qw.w); }
            nq += __shfl_xor(nq, 32);
            f32x16 p[2]; float rs = 0.f;
#pragma unroll
            for (int sb = 0; sb < 2; ++sb) { p[sb] = (f32x16){};
                if (sb <= tb) {
#pragma unroll
                    for (int kc = 0; kc < 4; ++kc) p[sb] = __builtin_amdgcn_mfma_f32_32x32x16_bf16(*(const GAS bf16x8*)(MK + (row0 + 32 * sb + pi) * 512 + h * 64 + 16 * kc + 8 * hi), qf[kc], p[sb], 0, 0, 0);
#pragma unroll
                    for (int hf = 0; hf < 2; ++hf) { const int s0 = 32 * sb + 16 * hf + 8 * hi; const f32x4 u0 = *(const LAS f32x4*)(sU + s0), u1 = *(const LAS f32x4*)(sU + s0 + 4);
#pragma unroll
                        for (int e = 0; e < 8; ++e) { const float uu = e < 4 ? u0[e & 3] : u1[e & 3]; const float w = (s0 + e <= t) ? __builtin_amdgcn_exp2f(uu - Wt) : 0.f; const float x = p[sb][8 * hf + e] * w; p[sb][8 * hf + e] = x; rs += x; } } } }
            rs += __shfl_xor(rs, 32);
            const float den = wi * nq + rs, inv = 1.0f / fmaxf(fabsf(den), __builtin_amdgcn_exp2f(-(sBc[t] + Wt)));
            unsigned hp[4][8]; float ssq = 0.f;
            const int gi = l32 & 15;
#pragma unroll
            for (int vq = 0; vq < 4; ++vq) { f32x16 acc = (f32x16){};
#pragma unroll
                for (int kc = 0; kc < 4; ++kc) acc = __builtin_amdgcn_mfma_f32_32x32x16_bf16(*(const GAS bf16x8*)(cst + (32 * vq + l32) * 64 + 16 * kc + 8 * hi), qf[kc], acc, 0, 0, 0);
#pragma unroll
                for (int r = 0; r < 16; ++r) acc[r] *= wi;
                const LAS unsigned char* va = Vt + (8 * hi + (gi >> 2)) * ML_VSTR + (32 * vq + 16 * ((l32 >> 4) & 1) + 4 * (gi & 3)) * 2;
#pragma unroll
                for (int sb = 0; sb < 2; ++sb) if (sb <= tb) {
#pragma unroll
                    for (int ks = 0; ks < 2; ++ks) { const int r0 = 8 * ks; v4u pw;
                        pw.x = cvt_pk_bf16(p[sb][r0], p[sb][r0 + 1]); pw.y = cvt_pk_bf16(p[sb][r0 + 2], p[sb][r0 + 3]); pw.z = cvt_pk_bf16(p[sb][r0 + 4], p[sb][r0 + 5]); pw.w = cvt_pk_bf16(p[sb][r0 + 6], p[sb][r0 + 7]);
                        const v4i16 a0 = __builtin_amdgcn_ds_read_tr16_b64_v4i16((LAS v4i16*)(va + (32 * sb + 16 * ks) * ML_VSTR)), a1 = __builtin_amdgcn_ds_read_tr16_b64_v4i16((LAS v4i16*)(va + (32 * sb + 16 * ks + 4) * ML_VSTR));
                        acc = __builtin_amdgcn_mfma_f32_32x32x16_bf16(mk8(a0, a1), __builtin_bit_cast(bf16x8, pw), acc, 0, 0, 0); } }
#pragma unroll
                for (int r = 0; r < 16; r += 2) { const float h0 = acc[r] * inv, h1 = acc[r + 1] * inv; ssq += h0 * h0 + h1 * h1; hp[vq][r >> 1] = cvt_pk_bf16(h0, h1); } }
            ssq += __shfl_xor(ssq, 32);
            const float rn = 1.0f / sqrtf(ssq * (1.0f / 128.0f) + RMS_EPS);
            const float* hn = inp(F, 17) + h * 128; const GAS bf16* mo = MO + (row0 + t) * 1024 + h * 128; GAS bf16* ao = (GAS bf16*)wsp<bf16>(F, WS_AO) + (row0 + t) * 1024 + h * 128;
#pragma unroll
            for (int vq = 0; vq < 4; ++vq)
#pragma unroll
                for (int r4 = 0; r4 < 4; ++r4) { const int v = 32 * vq + 8 * r4 + 4 * hi; const f32x4 g = *(const GAS f32x4*)(hn + v); const v2u ow = *(const GAS v2u*)(mo + v);
                    const float y0 = bflo(hp[vq][2 * r4]) * rn * g[0] * sigmoidf_(bflo(ow.x)), y1 = bfhi(hp[vq][2 * r4]) * rn * g[1] * sigmoidf_(bfhi(ow.x));
                    const float y2 = bflo(hp[vq][2 * r4 + 1]) * rn * g[2] * sigmoidf_(bflo(ow.y)), y3 = bfhi(hp[vq][2 * r4 + 1]) * rn * g[3] * sigmoidf_(bfhi(ow.y));
                    v2u w; w.x = cvt_pk_bf16(y0, y1); w.y = cvt_pk_bf16(y2, y3); *(GAS v2u*)(ao + v) = w; }
        }
        LDS_WAIT();
    }
}
#ifndef PH_LO
#define PH_LO 0
#endif
#ifndef PH_HI
#define PH_HI 20
#endif
struct Args { const float* in[23]; float* out; unsigned char* ws; int ph_lo, ph_hi; };
constexpr int N_PHASES = 20, KSPLIT_DN = D_FF >= 2048 ? 8 : 2;
__global__ void __launch_bounds__(NTHREADS, 2) mega_fwd(Args args) {
#ifdef EMU
    unsigned char* lds = emu_cur->blk->lds;
#else
    extern __shared__ __attribute__((aligned(16))) unsigned char lds[];
#endif
    Frame F;
    F.lds = (LAS unsigned char*)lds;
    F.MISC = (volatile LAS unsigned*)(F.lds + MISC_OFF);
    F.tid = threadIdx.x; F.lane = F.tid & 63; F.wave = __builtin_amdgcn_readfirstlane(F.tid >> 6);
    F.G = gridDim.x; { const int bx = blockIdx.x; F.vcu = (F.G % 8 == 0) ? (bx % 8) * (F.G / 8) + bx / 8 : bx; }
    F.ws = args.ws; F.out = args.out; F.ctl = (gu32*)(args.ws + WS_CTL);
#ifdef EMU
    F.in = args.in;
#else
    { const unsigned char __attribute__((address_space(4)))* ka = (const unsigned char __attribute__((address_space(4)))*)__builtin_amdgcn_kernarg_segment_ptr();
      F.in = (const float* const*)(const unsigned char*)ka; }
#endif
    for (int u = F.tid; u < (LDS_BYTES - LDSCTL_OFF) / 4; u += NTHREADS) ((LAS unsigned*)(F.lds + LDSCTL_OFF))[u] = 0u;
    __syncthreads();
    XcdBarrier bar = xcd_barrier_post((unsigned*)(F.ctl + CW_BAR), F.MISC + 8, (unsigned)F.wave);
    constexpr int lo = PH_LO, hi = PH_HI;
#ifdef EMU
#define LAUNDER() ((void)0)
#else
#define RFL64(x) (((unsigned long long)(unsigned)__builtin_amdgcn_readfirstlane((int)((x) >> 32)) << 32) | (unsigned long long)(unsigned)__builtin_amdgcn_readfirstlane((int)(x)))
#define LAUNDER() do { unsigned long long a_ = (unsigned long long)F.ws, b_ = (unsigned long long)F.out, c_ = (unsigned long long)F.in; int w_ = F.wave; \
    a_ = RFL64(a_); b_ = RFL64(b_); c_ = RFL64(c_); w_ = __builtin_amdgcn_readfirstlane(w_); asm volatile("" : "+s"(a_), "+s"(b_), "+s"(c_), "+s"(w_)); \
    int l_ = lane_id(); asm volatile("" : "+v"(l_)); F.wave = w_; F.lane = l_; F.tid = w_ * 64 + l_; \
    F.ws = (unsigned char*)a_; F.out = (float*)b_; F.in = (const float* const*)c_; F.ctl = (gu32*)(F.ws + WS_CTL); } while (0)
#endif
#ifndef DUP_MASK
#define DUP_MASK 0u
#endif
#define REP(k) for (int rep_ = 0; rep_ < (((DUP_MASK) >> (k)) & 1u ? 2 : 1); ++rep_, __syncthreads())
#define IN(k) (lo <= (k) && (k) < hi)
#define SEAM(k) do { if (IN(k) && IN((k) + 1)) xcd_barrier(bar); LAUNDER(); } while (0)
    const float* norm_g = inp(F, 9);

    if (IN(0)) REP(0) { p0_prologue(F); compress_prologue(F); } SEAM(0);
    if (IN(1)) REP(1) {
        pg8::Gemm g{wsp<bf16>(F, WS_H), wsp<bf16>(F, WS_WNSAIN), MPAD, NSA_IN_PAD, D}; pg8::StaticOrder S; S.init(MPAD, NSA_IN_PAD, F.G, (int)blockIdx.x);
        EpiNsaIn E{F.ws, F.out};
        pg8::gemm_phase<EpiNsaIn, pg8::StaticOrder, true, true>(F.lds + RING_OFF, g, S, E, F.wave);
    } SEAM(1);
    if (IN(2)) { compress_phase(F, 0); }
    if (IN(3)) { nsa_attn_phase(F, 0); if (AT_PROBE) { __syncthreads(); nsa_attn_phase(F, 1); } } SEAM(3);
#pragma unroll 1
    for (int layer = 0; layer < 2; ++layer) {
        const int pb = layer * 10;
        if (layer == 1) {
            if (IN(10)) REP(10) {
                pg8::Gemm g{wsp<bf16>(F, WS_H), wsp<bf16>(F, WS_WMLIN), MPAD, ML_IN_PAD, D}; pg8::StaticOrder S; S.init(MPAD, ML_IN_PAD, F.G, (int)blockIdx.x);
                EpiMlIn E{F.ws};
                pg8::gemm_phase<EpiMlIn, pg8::StaticOrder, true, true>(F.lds + RING_OFF, g, S, E, F.wave);
            } SEAM(10);
            if (IN(11)) REP(11) { mlstm_phase_a(F); } SEAM(11);
            if (IN(12)) REP(12) { mlstm_phase_b(F); } SEAM(12);
            if (IN(13)) REP(13) { mlstm_phase_c(F); } SEAM(13);
        }
        if (IN(pb + 4)) {
            pg8::Gemm g{wsp<bf16>(F, WS_AO), wsp<bf16>(F, layer ? WS_WMLOUT : WS_WNSAOUT), MPR, D, D}; pg8::StaticOrder S; S.init(MPR, D, F.G, (int)blockIdx.x);
            EpiRmsRes E{F.ws, F.out, norm_g + (size_t)(layer * 4 + 1) * D, norm_g + (size_t)(layer * 4 + 2) * D, F.ctl, layer * 2};
            pg8::gemm_phase<EpiRmsRes, pg8::StaticOrder, false, true>(F.lds + RING_OFF, g, S, E, F.wave);
            mini_gemm(F, wsp<bf16>(F, WS_AO), wsp<bf16>(F, layer ? WS_WMLOUT : WS_WNSAOUT), MPR, MSA, 0, D, D, 4, E);
        } SEAM(pb + 4);
        if (IN(pb + 6)) {
            gu32* gate = F.ctl + CW_SN + 64 * layer;
            norm_phase(F, MPR, wsp<float>(F, WS_Y), wsp<float>(F, WS_YS), 4, norm_g + (size_t)(layer * 4 + 1) * D, norm_g + (size_t)(layer * 4 + 2) * D, wsp<bf16>(F, WS_H), gate, F.G >= 64 + NSN ? 64 : 0); LAUNDER(); gate = F.ctl + CW_SN + 64 * layer;
            REP(6) {
            pg8::Gemm g{wsp<bf16>(F, WS_H), wsp<bf16>(F, WS_WUP) + (size_t)layer * FF2 * D, MPAD, FF2, D}; GatedOrder S; S.init(MPAD, FF2, F.G, (int)blockIdx.x); S.gate = gate; S.tmo = F.ctl + CW_TMO;
            EpiUpConv E{F.ws, F.out, F.in, layer, (LAS float*)(F.lds + RING_OFF + UPX_OFF)};
            pg8::gemm_phase<EpiUpConv, GatedOrder, true, true>(F.lds + RING_OFF, g, S, E, F.wave); }
        } SEAM(pb + 6);
        if (IN(pb + 7)) REP(7) { conv_fix_phase(F, layer); } SEAM(pb + 7);
        if (IN(pb + 8)) {
            pg8::Gemm g{wsp<bf16>(F, WS_ACT), wsp<bf16>(F, WS_WDOWN) + (size_t)layer * D * D_FF, MPR, D, D_FF}; pg8::StaticOrder S; S.init(MPR, D, F.G, (int)blockIdx.x);
            EpiRmsRes E{F.ws, F.out, norm_g + (size_t)(layer * 4 + 3) * D, layer == 0 ? norm_g + (size_t)4 * D : nullptr, F.ctl, layer * 2 + 1};
            pg8::gemm_phase<EpiRmsRes, pg8::StaticOrder, false, false>(F.lds + RING_OFF, g, S, E, F.wave);
            mini_gemm(F, wsp<bf16>(F, WS_ACT), wsp<bf16>(F, WS_WDOWN) + (size_t)layer * D * D_FF, MPR, MSA, 0, D, D_FF, KSPLIT_DN, E);
        } SEAM(pb + 8);
        if (IN(pb + 9)) { norm_phase(F, MPR, wsp<float>(F, WS_Y), wsp<float>(F, WS_YS), KSPLIT_DN, norm_g + (size_t)(layer * 4 + 3) * D, layer == 0 ? norm_g + (size_t)4 * D : nullptr, wsp<bf16>(F, WS_H)); }
        if (layer == 0) SEAM(9);
    }
#undef IN
#undef SEAM
}

extern "C" void kernel_launch(void* const* d_in, const int* in_sizes, int n_in, void* d_out, int out_size, void* d_ws, size_t ws_size, hipStream_t stream) {
    static int grid = 0;
    if (grid == 0) {
        if (n_in != 23 || (size_t)out_size != O_END || ws_size < WS_END) { fprintf(stderr, "kernel_launch: unexpected sizes n_in %d out %d (want %zu) ws %zu (want %zu)\n", n_in, out_size, (size_t)O_END, ws_size, (size_t)WS_END); grid = -1; return; }
        int dev = 0, cus = 0, per_cu = 0;
        if (hipGetDevice(&dev) != hipSuccess || hipDeviceGetAttribute(&cus, hipDeviceAttributeMultiprocessorCount, dev) != hipSuccess) { grid = -1; return; }
        if (hipFuncSetAttribute((const void*)mega_fwd, hipFuncAttributeMaxDynamicSharedMemorySize, LDS_BYTES) != hipSuccess) { fprintf(stderr, "kernel_launch: hipFuncSetAttribute failed\n"); grid = -1; return; }
        if (hipOccupancyMaxActiveBlocksPerMultiprocessor(&per_cu, (const void*)mega_fwd, NTHREADS, LDS_BYTES) != hipSuccess || per_cu < 1) fprintf(stderr, "kernel_launch: occupancy query says %d\n", per_cu);
        (void)hipGetLastError();
        grid = cus;
    }
    if (grid < 0) return;
    (void)hipMemsetAsync((char*)d_ws + WS_CTL, 0, CTL_ZERO_BYTES, stream);
    Args a{};
    for (int i = 0; i < 23; ++i) a.in[i] = (const float*)d_in[i];
    a.out = (float*)d_out; a.ws = (unsigned char*)d_ws; a.ph_lo = PH_LO; a.ph_hi = PH_HI;
    hipLaunchKernelGGL(mega_fwd, dim3(grid), dim3(NTHREADS), LDS_BYTES, stream, a);
}
#ifdef EMU
static void dump_region(const char* dir, const char* name, void* ws, size_t off, size_t bytes) { char p[512]; snprintf(p, sizeof p, "%s/ws_%s.bin", dir, name); FILE* f = fopen(p, "wb"); fwrite((char*)ws + off, 1, bytes, f); fclose(f); }
void emu_dump_ws(const char* dir, void* ws) {
    dump_region(dir, "H", ws, WS_H, (size_t)MPAD * D * 2); dump_region(dir, "Q", ws, WS_Q, (size_t)MPAD * D * 2); dump_region(dir, "KVB", ws, WS_KVB, (size_t)MPAD * D * 2);
    dump_region(dir, "WINB", ws, WS_WINB, (size_t)MPAD * 512 * 2); dump_region(dir, "GATES", ws, WS_GATES, (size_t)MPAD * 48 * 4); dump_region(dir, "AO", ws, WS_AO, (size_t)MPAD * D * 2);
    dump_region(dir, "Y", ws, WS_Y, (size_t)MPAD * D * 4); dump_region(dir, "U", ws, WS_U, (size_t)MPAD * FF2 * 2); dump_region(dir, "ACT", ws, WS_ACT, (size_t)MPAD * D_FF * 2);
    dump_region(dir, "KC", ws, WS_KC, (size_t)32 << 20); dump_region(dir, "MISC", ws, WS_MISC, (size_t)64 << 20);
    dump_region(dir, "MQ", ws, WS_MQ, (size_t)MPAD * 512 * 2); dump_region(dir, "MK", ws, WS_MK, (size_t)MPAD * 512 * 2); dump_region(dir, "MV", ws, WS_MV, (size_t)MPAD * D * 2);
    dump_region(dir, "MO", ws, WS_MO, (size_t)MPAD * D * 2); dump_region(dir, "MG", ws, WS_MG, (size_t)MPAD * 16 * 4);
    dump_region(dir, "WNSAIN", ws, WS_WNSAIN, (size_t)NSA_IN_PAD * D * 2);
    dump_region(dir, "CTL", ws, WS_CTL, 65536);
}
#endif
```
